# Optimizing an MI355X kernel written in HIP

```python
import jax, jax.numpy as jnp
from jax import lax
import numpy as np

D_MODEL = 1024
BATCH = 2
SEQ = 8192
DEPTH = 4
DEC_BATCH = 128
DEC_SEQ = 1
PAST_LEN = 8192
PAGE_SIZE = 128

HEAD_DIM = 64
A_HEADS = (D_MODEL // 2) // HEAD_DIM
A_KV_HEADS = 2
A_GROUP = A_HEADS // A_KV_HEADS
WINDOW = 128
ROPE_THETA = 10000.0
A_Q = A_HEADS * HEAD_DIM
A_KV = A_KV_HEADS * HEAD_DIM
A_PROJ = A_Q + 2 * A_KV
B_HEAD_DIM = 64
B_WIDTH = D_MODEL // 2
B_HEADS = B_WIDTH // B_HEAD_DIM
DECAY_RANK = 64
ICLR_RANK = 64
GATE_RANK = 128
B_PROJ = 3 * B_WIDTH + DECAY_RANK + ICLR_RANK + GATE_RANK
DECAY_SCALE = 0.606531
GN_EPS = 64e-5
EVEN_PROJ = A_PROJ + B_PROJ
EVEN_OUT = A_Q + B_WIDTH
CHUNK = 128
C_WIDTH = D_MODEL
C_HEADS = 8
C_HEAD_DIM = C_WIDTH // C_HEADS
D_FF = 2816
CONV_W = 3
N_EVEN = (DEPTH + 1) // 2
N_ODD = DEPTH // 2
RMS_EPS = 1e-6
LN_EPS = 1e-5
NEG = -1e30

kernel_name = "hybrid_swa_rwkv7_gmlp_convffn_step"


def rmsnorm(x, g):
    xf = x.astype(jnp.float32)
    y = xf * lax.rsqrt(jnp.mean(xf * xf, axis=-1, keepdims=True) + RMS_EPS)
    return (y * g.astype(jnp.float32)).astype(x.dtype)


def layernorm(x, g, b):
    xf = x.astype(jnp.float32)
    mu = jnp.mean(xf, axis=-1, keepdims=True)
    var = jnp.mean(jnp.square(xf - mu), axis=-1, keepdims=True)
    return ((xf - mu) * lax.rsqrt(var + LN_EPS) * g.astype(jnp.float32) + b.astype(jnp.float32)).astype(x.dtype)


def rope(x, pos):
    half = x.shape[-1] // 2
    inv = ROPE_THETA ** (-jnp.arange(half, dtype=jnp.float32) / half)
    ang = pos.astype(jnp.float32)[:, None] * inv[None, :]
    shape = (1, pos.shape[0]) + (1,) * (x.ndim - 3) + (half,)
    cos, sin = jnp.cos(ang).reshape(shape), jnp.sin(ang).reshape(shape)
    xf = x.astype(jnp.float32)
    x1, x2 = xf[..., :half], xf[..., half:]
    return jnp.concatenate([x1 * cos - x2 * sin, x2 * cos + x1 * sin], axis=-1).astype(x.dtype)


def sink_attention(q, k, v, mask, sinks):
    s = jnp.einsum('...qkgd,...skd->...kgqs', q, k).astype(jnp.float32) * (HEAD_DIM ** -0.5)
    s = jnp.where(mask, s, NEG)
    sink = sinks.astype(jnp.float32).reshape(A_KV_HEADS, A_GROUP, 1, 1)
    m = jnp.maximum(jnp.max(s, axis=-1, keepdims=True), sink)
    p = jnp.exp(s - m)
    p = p / (jnp.sum(p, axis=-1, keepdims=True) + jnp.exp(sink - m))
    return jnp.einsum('...kgqs,...skd->...qkgd', p.astype(v.dtype), v)


def banded_window_attention(q, k, v, sinks):
    n, t = q.shape[:2]
    nb = t // WINDOW
    qb = q.reshape(n, nb, WINDOW, A_KV_HEADS, A_GROUP, HEAD_DIM)
    kb = k.reshape(n, nb, WINDOW, A_KV_HEADS, HEAD_DIM)
    vb = v.reshape(n, nb, WINDOW, A_KV_HEADS, HEAD_DIM)
    shift = lambda u: jnp.concatenate([jnp.zeros_like(u[:, :1]), u[:, :-1]], axis=1)
    kk = jnp.concatenate([shift(kb), kb], axis=2)
    vv = jnp.concatenate([shift(vb), vb], axis=2)
    qi = jnp.arange(WINDOW)[:, None]
    kj = jnp.arange(2 * WINDOW)[None, :]
    diff = WINDOW + qi - kj
    blk = jnp.arange(nb)[:, None, None]
    mask = (diff >= 0) & (diff <= WINDOW) & ((blk > 0) | (kj >= WINDOW))
    o = sink_attention(qb, kk, vv, mask[:, None, None], sinks)
    return o.reshape(n, t, A_KV_HEADS, A_GROUP, HEAD_DIM)


def cached_window_attention(q, k, v, k_buf, v_buf, sinks):
    t = q.shape[1]
    wb = k_buf.shape[1]
    kk = jnp.concatenate([k_buf.astype(k.dtype), k], axis=1)
    vv = jnp.concatenate([v_buf.astype(v.dtype), v], axis=1)
    q_pos = PAST_LEN + jnp.arange(t)
    k_pos = jnp.concatenate([PAST_LEN - wb + jnp.arange(wb), q_pos])
    diff = q_pos[:, None] - k_pos[None, :]
    mask = (diff >= 0) & (diff <= WINDOW)
    return sink_attention(q, kk, vv, mask, sinks)


def rwkv7_mix(zb, shift, wkv, mu, w0, w2, a0, a2, g2, k_k, k_a, r_k, gn_g, gn_b):
    f32 = jnp.float32
    n, t, _ = zb.shape
    prev = jnp.concatenate([shift[:, None].astype(zb.dtype), zb[:, :-1]], axis=1)
    zs = zb + (prev - zb) * mu
    o1, o2, o3 = B_WIDTH, 2 * B_WIDTH, 3 * B_WIDTH
    o4, o5 = o3 + DECAY_RANK, o3 + DECAY_RANK + ICLR_RANK
    r, k, v = zs[..., :o1], zs[..., o1:o2], zs[..., o2:o3]
    wd, ad, gd = zs[..., o3:o4], zs[..., o4:o5], zs[..., o5:]
    decay = jnp.exp(-DECAY_SCALE * jax.nn.sigmoid((w0 + jnp.tanh(wd) @ w2).astype(f32)))
    a = jax.nn.sigmoid((a0 + ad @ a2).astype(f32))
    g = jax.nn.sigmoid(gd) @ g2
    heads = lambda u: u.astype(f32).reshape(n, t, B_HEADS, B_HEAD_DIM)
    kk = heads(k * k_k)
    kk = kk / jnp.maximum(jnp.sqrt(jnp.sum(kk * kk, axis=-1, keepdims=True)), 1e-12)
    k = heads(k.astype(f32) * (1.0 + (a - 1.0) * k_a.astype(f32)))
    r, v, decay, a = heads(r), heads(v), heads(decay), heads(a)

    def step(s, inp):
        r_t, w_t, k_t, v_t, kk_t, a_t = inp
        sa = jnp.einsum('bhij,bhj->bhi', s, -kk_t)
        s = (s * w_t[:, :, None, :] + sa[..., None] * (kk_t * a_t)[:, :, None, :]
             + v_t[..., None] * k_t[:, :, None, :])
        return s, jnp.einsum('bhij,bhj->bhi', s, r_t)

    xs = tuple(jnp.moveaxis(u, 1, 0) for u in (r, decay, k, v, kk, a))
    s_last, o = lax.scan(step, wkv.astype(f32), xs)
    o = jnp.moveaxis(o, 0, 1)
    mean = jnp.mean(o, axis=-1, keepdims=True)
    var = jnp.mean(jnp.square(o - mean), axis=-1, keepdims=True)
    o = ((o - mean) * lax.rsqrt(var + GN_EPS)).reshape(n, t, B_WIDTH) * gn_g.astype(f32) + gn_b.astype(f32)
    bonus = jnp.sum(r * k * r_k.astype(f32), axis=-1, keepdims=True) * v
    o = (o + bonus.reshape(n, t, B_WIDTH)) * g.astype(f32)
    return o.astype(zb.dtype), zb[:, -1], s_last.astype(wkv.dtype)


def even_mix(xn, pos, k_buf, v_buf, shift, wkv, w_in, sinks, mu, w0, w2, a0, a2, g2, k_k, k_a, r_k, gn_g, gn_b, w_out):
    n, t, _ = xn.shape
    z = xn @ w_in
    q = z[..., :A_Q].reshape(n, t, A_KV_HEADS, A_GROUP, HEAD_DIM)
    k = z[..., A_Q:A_Q + A_KV].reshape(n, t, A_KV_HEADS, HEAD_DIM)
    v = z[..., A_Q + A_KV:A_PROJ].reshape(n, t, A_KV_HEADS, HEAD_DIM)
    q, k = rope(q, pos), rope(k, pos)
    if k_buf is None:
        o_a = banded_window_attention(q, k, v, sinks)
    else:
        o_a = cached_window_attention(q, k, v, k_buf, v_buf, sinks)
    o_b, new_shift, new_wkv = rwkv7_mix(z[..., A_PROJ:], shift, wkv, mu, w0, w2, a0, a2, g2, k_k, k_a, r_k, gn_g, gn_b)
    o = jnp.concatenate([o_a.reshape(n, t, A_Q), o_b], axis=-1) @ w_out
    return o, k, v, new_shift, new_wkv


def chunk_gmlp_mix(xn, w_in, ln_g, ln_b, w_s, b_s, w_out):
    n, t, _ = xn.shape
    z = jax.nn.gelu(xn @ w_in, approximate=False)
    u, v = z[..., :C_WIDTH], z[..., C_WIDTH:]
    v = layernorm(v, ln_g, ln_b)
    L = min(t, CHUNK)
    vc = v.reshape(n, t // L, L, C_HEADS, C_HEAD_DIM)
    ws = jnp.tril(w_s[:, :L, :L])
    mixed = jnp.einsum('hts,bnshc->bnthc', ws, vc) + b_s[:, :L].T[None, None, :, :, None]
    y = u * mixed.reshape(n, t, C_WIDTH)
    return y @ w_out, v


def conv_ffn(xn, conv_state, w_gate, w_up, conv_w, conv_b, w_down):
    t = xn.shape[1]
    gpre = xn @ w_gate
    ext = jnp.concatenate([conv_state.astype(gpre.dtype), gpre], axis=1)
    conv = conv_b + conv_w[CONV_W - 1] * ext[:, CONV_W - 1:CONV_W - 1 + t]
    for j in range(CONV_W - 1):
        conv = conv + conv_w[j] * ext[:, j:j + t]
    h = jax.nn.gelu(conv, approximate=True) * (xn @ w_up)
    return h @ w_down, ext[:, -(CONV_W - 1):]


def setup_inputs(seed: int = 0) -> dict:
    key = jax.random.key(seed)
    ks = iter(jax.random.split(key, 40))
    nrm = lambda shape, scale=1.0: scale * jax.random.normal(next(ks), shape, jnp.float32)
    unif = lambda shape, lo, hi: jax.random.uniform(next(ks), shape, jnp.float32, lo, hi)
    w_buf = min(WINDOW, PAST_LEN)
    return {
        "x_prompt": nrm((BATCH, SEQ, D_MODEL)),
        "x_sample": nrm((DEC_BATCH, DEC_SEQ, D_MODEL)),
        "cache_win_k": nrm((N_EVEN, DEC_BATCH, w_buf, A_KV_HEADS, HEAD_DIM)),
        "cache_win_v": nrm((N_EVEN, DEC_BATCH, w_buf, A_KV_HEADS, HEAD_DIM)),
        "state_wkv": nrm((N_EVEN, DEC_BATCH, B_HEADS, B_HEAD_DIM, B_HEAD_DIM), 0.5),
        "state_shift": nrm((N_EVEN, DEC_BATCH, B_PROJ)),
        "state_ffn_conv": nrm((DEPTH, DEC_BATCH, CONV_W - 1, D_FF)),
        "norm_mix_pre": 1.0 + nrm((DEPTH, D_MODEL), 0.05),
        "norm_mix_post": 1.0 + nrm((DEPTH, D_MODEL), 0.05),
        "norm_ffn_pre": 1.0 + nrm((DEPTH, D_MODEL), 0.05),
        "norm_ffn_post": 1.0 + nrm((DEPTH, D_MODEL), 0.05),
        "w_in_even": nrm((N_EVEN, D_MODEL, EVEN_PROJ), D_MODEL ** -0.5),
        "attn_sinks": nrm((N_EVEN, A_HEADS), 0.5),
        "shift_mu": unif((N_EVEN, B_PROJ), 0.0, 1.0),
        "decay_w0": unif((N_EVEN, B_WIDTH), -4.0, 1.0),
        "decay_w2": nrm((N_EVEN, DECAY_RANK, B_WIDTH), 0.1),
        "iclr_a0": nrm((N_EVEN, B_WIDTH), 0.1),
        "iclr_a2": nrm((N_EVEN, ICLR_RANK, B_WIDTH), 0.5 * ICLR_RANK ** -0.5),
        "gate_g2": nrm((N_EVEN, GATE_RANK, B_WIDTH), 2.0 * GATE_RANK ** -0.5),
        "key_k": 1.0 + nrm((N_EVEN, B_WIDTH), 0.1),
        "key_a": 1.0 + nrm((N_EVEN, B_WIDTH), 0.1),
        "bonus_r_k": nrm((N_EVEN, B_HEADS, B_HEAD_DIM), 0.1),
        "gn_gain": 1.0 + nrm((N_EVEN, B_WIDTH), 0.05),
        "gn_bias": nrm((N_EVEN, B_WIDTH), 0.02),
        "w_out_even": nrm((N_EVEN, EVEN_OUT, D_MODEL), EVEN_OUT ** -0.5),
        "w_in_odd": nrm((N_ODD, D_MODEL, 2 * C_WIDTH), D_MODEL ** -0.5),
        "sgu_ln_gain": 1.0 + nrm((N_ODD, C_WIDTH), 0.05),
        "sgu_ln_bias": nrm((N_ODD, C_WIDTH), 0.02),
        "sgu_w": nrm((N_ODD, C_HEADS, CHUNK, CHUNK), CHUNK ** -0.5),
        "sgu_b": 1.0 + nrm((N_ODD, C_HEADS, CHUNK), 0.1),
        "w_out_odd": nrm((N_ODD, C_WIDTH, D_MODEL), C_WIDTH ** -0.5),
        "ffn_w_gate": nrm((DEPTH, D_MODEL, D_FF), D_MODEL ** -0.5),
        "ffn_w_up": nrm((DEPTH, D_MODEL, D_FF), D_MODEL ** -0.5),
        "ffn_conv_w": nrm((DEPTH, CONV_W, D_FF), CONV_W ** -0.5),
        "ffn_conv_b": nrm((DEPTH, D_FF), 0.02),
        "ffn_w_down": nrm((DEPTH, D_FF, D_MODEL), D_FF ** -0.5),
    }


def reference(x_prompt, x_sample, cache_win_k, cache_win_v, state_wkv, state_shift, state_ffn_conv,
              norm_mix_pre, norm_mix_post, norm_ffn_pre, norm_ffn_post,
              w_in_even, attn_sinks, shift_mu, decay_w0, decay_w2, iclr_a0, iclr_a2, gate_g2,
              key_k, key_a, bonus_r_k, gn_gain, gn_bias, w_out_even,
              w_in_odd, sgu_ln_gain, sgu_ln_bias, sgu_w, sgu_b, w_out_odd,
              ffn_w_gate, ffn_w_up, ffn_conv_w, ffn_conv_b, ffn_w_down):
    pos_p = jnp.arange(SEQ, dtype=jnp.int32)
    pos_s = PAST_LEN + jnp.arange(DEC_SEQ, dtype=jnp.int32)
    hp, hs = x_prompt, x_sample
    kp_l, vp_l, ks_l, vs_l = [], [], [], []
    sp_l, ss_l, shp_l, shs_l = [], [], [], []
    vsgu_l, cp_l, cs_l = [], [], []
    for layer in range(DEPTH):
        j = layer // 2
        xp = rmsnorm(hp, norm_mix_pre[layer])
        xs = rmsnorm(hs, norm_mix_pre[layer])
        if layer % 2 == 0:
            ep = (w_in_even[j], attn_sinks[j], shift_mu[j], decay_w0[j], decay_w2[j], iclr_a0[j], iclr_a2[j],
                  gate_g2[j], key_k[j], key_a[j], bonus_r_k[j], gn_gain[j], gn_bias[j], w_out_even[j])
            shift0 = jnp.zeros((BATCH, B_PROJ), hp.dtype)
            wkv0 = jnp.zeros((BATCH, B_HEADS, B_HEAD_DIM, B_HEAD_DIM), hp.dtype)
            mp, kp, vp, shp, sp = even_mix(xp, pos_p, None, None, shift0, wkv0, *ep)
            ms, kn, vn, shs, sn = even_mix(xs, pos_s, cache_win_k[j], cache_win_v[j], state_shift[j], state_wkv[j], *ep)
            wp = min(WINDOW, SEQ)
            kp_l.append(kp[:, -wp:]); vp_l.append(vp[:, -wp:])
            ks_l.append(kn); vs_l.append(vn)
            sp_l.append(sp); ss_l.append(sn)
            shp_l.append(shp); shs_l.append(shs)
        else:
            op = (w_in_odd[j], sgu_ln_gain[j], sgu_ln_bias[j], sgu_w[j], sgu_b[j], w_out_odd[j])
            mp, _ = chunk_gmlp_mix(xp, *op)
            ms, vsg = chunk_gmlp_mix(xs, *op)
            vsgu_l.append(vsg)
        hp = hp + rmsnorm(mp, norm_mix_post[layer])
        hs = hs + rmsnorm(ms, norm_mix_post[layer])
        fprm = (ffn_w_gate[layer], ffn_w_up[layer], ffn_conv_w[layer], ffn_conv_b[layer], ffn_w_down[layer])
        fp, cp = conv_ffn(rmsnorm(hp, norm_ffn_pre[layer]), jnp.zeros((BATCH, CONV_W - 1, D_FF), hp.dtype), *fprm)
        fs, cs = conv_ffn(rmsnorm(hs, norm_ffn_pre[layer]), state_ffn_conv[layer], *fprm)
        hp = hp + rmsnorm(fp, norm_ffn_post[layer])
        hs = hs + rmsnorm(fs, norm_ffn_post[layer])
        cp_l.append(cp); cs_l.append(cs)
    return (hp, hs,
            jnp.stack(kp_l), jnp.stack(vp_l), jnp.stack(ks_l), jnp.stack(vs_l),
            jnp.stack(sp_l), jnp.stack(ss_l), jnp.stack(shp_l), jnp.stack(shs_l),
            jnp.stack(vsgu_l), jnp.stack(cp_l), jnp.stack(cs_l))
```

```cpp
#include <hip/hip_runtime.h>
#include <hip/hip_cooperative_groups.h>
#include <cstdio>
namespace cg = cooperative_groups;

typedef unsigned short bf16_t;
typedef short bf16x8 __attribute__((ext_vector_type(8)));
typedef float f32x16 __attribute__((ext_vector_type(16)));

#ifndef REP
#define REP 0
#endif
constexpr int NT = 256;
constexpr int D = 1024, SEQ = 8192, NBAT = 2, MP = NBAT * SEQ, MS = 128, M = MP + MS;
constexpr int EP = 2560, DFF = 2816, ZBW = 1792;
constexpr int LDS_BYTES = 73728;

enum { I_XP = 0, I_XS, I_CK, I_CV, I_WKV, I_SHIFT, I_CONV, I_NMPRE, I_NMPOST, I_NFPRE, I_NFPOST, I_WINE, I_SINK, I_MU, I_W0, I_W2, I_A0, I_A2, I_G2,
       I_KK, I_KA, I_RK, I_GNG, I_GNB, I_WOUTE, I_WINO, I_LNG, I_LNB, I_SGUW, I_SGUB, I_WOUTO, I_WG, I_WU, I_CW, I_CB, I_WD, N_IN };
constexpr size_t O_YP = 0, O_YS = O_YP + (size_t)MP * D, O_WKP = O_YS + (size_t)MS * D, O_WVP = O_WKP + 2 * 2 * 128 * 128, O_WKS = O_WVP + 2 * 2 * 128 * 128,
                 O_WVS = O_WKS + 2 * 128 * 128, O_SP = O_WVS + 2 * 128 * 128, O_SS = O_SP + 2 * 2 * 8 * 4096, O_SHP = O_SS + (size_t)2 * 128 * 8 * 4096,
                 O_SHS = O_SHP + 2 * 2 * ZBW, O_SGV = O_SHS + 2 * 128 * ZBW, O_CP = O_SGV + 2 * 128 * 1024, O_CS = O_CP + 4 * 2 * 2 * DFF, O_END = O_CS + (size_t)4 * 128 * 2 * DFF;
constexpr size_t al(size_t x) { return (x + 255) & ~(size_t)255; }
constexpr size_t W_WINE = 0, W_WOUTE = W_WINE + (size_t)2 * EP * D * 2, W_WINO = W_WOUTE + (size_t)2 * D * D * 2, W_WOUTO = W_WINO + (size_t)2 * 2048 * D * 2,
                 W_WGU = W_WOUTO + (size_t)2 * D * D * 2, W_WDN = W_WGU + (size_t)4 * 2 * DFF * D * 2, W_WLR = W_WDN + (size_t)4 * D * DFF * 2,
                 W_TRIL = W_WLR + (size_t)2 * 1536 * 256 * 2, W_ROPE = W_TRIL + (size_t)2 * 8 * 128 * 128 * 2, W_XN = al(W_ROPE + (size_t)8193 * 32 * 2 * 4),
                 W_AR = al(W_XN + (size_t)M * D * 2);
constexpr size_t A_Z = 0, A_LR = al(A_Z + (size_t)M * EP * 2), A_WAG = al(A_LR + (size_t)M * 256 * 2), A_OA = al(A_WAG + (size_t)M * 1536 * 2), A_EVEN_END = A_OA + (size_t)M * D * 2;
constexpr size_t A_ZU = 0, A_Y = al(A_ZU + (size_t)M * 2048 * 2), A_MO_ODD = al(A_Y + (size_t)M * D * 2);
constexpr size_t A_G = 0, A_U = al(A_G + (size_t)M * DFF * 2), A_FFN_END = A_U + (size_t)M * DFF * 2;
constexpr size_t W_BAR = al(W_AR + A_FFN_END);
constexpr size_t W_SAMP = W_BAR + 32768;
constexpr size_t S_Z = 0, S_LR = S_Z + (size_t)MS * EP * 2, S_WAG = S_LR + (size_t)MS * 256 * 2, S_OA = S_WAG + (size_t)MS * 1536 * 2, S_ZU = S_OA + (size_t)MS * D * 2,
                 S_Y = S_ZU + (size_t)MS * 2048 * 2, S_G = S_Y + (size_t)MS * D * 2, S_U = S_G + (size_t)MS * DFF * 2, S_MO = S_U + (size_t)MS * DFF * 2, S_END = S_MO + (size_t)MS * D * 4;
constexpr size_t W_SCN = al(W_SAMP + S_END);
constexpr size_t WS_NEED = W_SCN + (size_t)16 * 7 * 4096 * 4;

struct P { const float* in[N_IN]; float* out; char* ws; };
struct Ctx { bf16_t *Z, *LR, *WAG, *OA, *ZU, *Y, *G, *U; float *MOE, *MOO, *FO; int r0, r1, bid, nb; };

__device__ __forceinline__ int opaque_tid() { int t = threadIdx.x; asm volatile("" : "+v"(t)); return t; }
__device__ __forceinline__ int opaque_bid() { int t = blockIdx.x; asm volatile("" : "+s"(t)); return t; }
#define TIDX opaque_tid()
#define BIDX opaque_bid()
__device__ __forceinline__ bf16_t f2bf(float f) { unsigned u = __float_as_uint(f); u += 0x7fffu + ((u >> 16) & 1u); return (bf16_t)(u >> 16); }
__device__ __forceinline__ float bf2f(bf16_t h) { return __uint_as_float(((unsigned)h) << 16); }
__device__ __forceinline__ unsigned pk2(float a, float b) { return (unsigned)f2bf(a) | ((unsigned)f2bf(b) << 16); }
__device__ __forceinline__ float lo16(unsigned u) { return __uint_as_float(u << 16); }
__device__ __forceinline__ float hi16(unsigned u) { return __uint_as_float(u & 0xffff0000u); }
__device__ __forceinline__ float wave_sum(float v) {
#pragma unroll
    for (int o = 32; o > 0; o >>= 1) v += __shfl_xor(v, o);
    return v;
}
__device__ __forceinline__ float wave_max(float v) {
#pragma unroll
    for (int o = 32; o > 0; o >>= 1) v = fmaxf(v, __shfl_xor(v, o));
    return v;
}
__device__ __forceinline__ float sigmoidf_(float x) { return 1.f / (1.f + __expf(-x)); }
__device__ __forceinline__ float gelu_erf(float x) { return 0.5f * x * (1.f + erff(x * 0.70710678118654752f)); }
__device__ __forceinline__ float gelu_tanh(float x) { const float u2 = 1.5957691216057308f * (x + 0.044715f * x * x * x); return x * __frcp_rn(1.f + __expf(-u2)); }
template <int CTRL> __device__ __forceinline__ float dpp_add(float x) {
    int y = __builtin_amdgcn_update_dpp(0, __float_as_int(x), CTRL, 0xf, 0xf, false);
    return x + __int_as_float(y);
}
__device__ __forceinline__ float row16_sum(float x) {
    x = dpp_add<0xB1>(x); x = dpp_add<0x4E>(x); x = dpp_add<0x141>(x); x = dpp_add<0x140>(x); return x;
}


#define XB_TMO      128
#define XB_XCNT(j)  (256  + 64 * (j))
#define XB_XSUB(j)  (1280 + 64 * (j))
#define XB_XGEN(j)  (2304 + 64 * (j))
#define XB_TOP      3328
#define XB_TOPGEN   3392
#define XCD_BAR_WORDS 3456
#define XB_SPIN_CAP (1u << 20)
#define LAS __attribute__((address_space(3)))
__device__ __forceinline__ unsigned xb_ld(unsigned* p)              { return __hip_atomic_load(p, __ATOMIC_RELAXED, __HIP_MEMORY_SCOPE_AGENT); }
__device__ __forceinline__ unsigned xb_add(unsigned* p, unsigned v) { return __hip_atomic_fetch_add(p, v, __ATOMIC_RELAXED, __HIP_MEMORY_SCOPE_AGENT); }
__device__ __forceinline__ unsigned xb_xcc_id() { return (unsigned)__builtin_amdgcn_s_getreg((3 << 11) | 20) & 0xFu; }
#define XB_SPIN(cond, bar) do { unsigned _sp = 0; while (cond) { __builtin_amdgcn_s_sleep(1); \
    if ((++_sp & 255u) == 0u) { if (xb_ld(&(bar)[XB_TMO])) break; if (_sp > XB_SPIN_CAP) { atomicAdd(&(bar)[XB_TMO], 1u); break; } } } } while (0)
struct XcdBarrier { unsigned* bar; unsigned x; volatile LAS unsigned* st; unsigned G; };
__device__ __forceinline__ XcdBarrier xcd_barrier_post(unsigned* bar, volatile LAS unsigned* st, unsigned G) {
    XcdBarrier b; b.bar = bar; b.x = xb_xcc_id(); b.st = st; b.G = G;
    if (threadIdx.x == 0) (void)xb_add(&bar[XB_XCNT(b.x)], 1u);
    return b;
}
__device__ __forceinline__ void xcd_barrier_complete(unsigned* bar, unsigned x, unsigned G, unsigned& nloc, unsigned& nx) {
    unsigned sum, cnt, mine, sp = 0u;
    for (;;) {
        sum = 0u; cnt = 0u; mine = 0u;
#pragma unroll
        for (unsigned j = 0; j < 16; ++j) { const unsigned c = xb_ld(&bar[XB_XCNT(j)]); sum += c; cnt += (c > 0u) ? 1u : 0u; mine = (j == x) ? c : mine; }
        if (sum == G) break;
        __builtin_amdgcn_s_sleep(1);
        if ((++sp & 255u) == 0u) { if (xb_ld(&bar[XB_TMO])) break; if (sp > XB_SPIN_CAP) { atomicAdd(&bar[XB_TMO], 1u); break; } }
    }
    nloc = mine > 0u ? mine : 1u; nx = cnt > 0u ? cnt : 1u;
}
__device__ __forceinline__ void xcd_barrier(const XcdBarrier& b) {
    asm volatile("s_waitcnt vmcnt(0)" ::: "memory");
    __syncthreads();
    if (threadIdx.x == 0) {
        unsigned* bar = b.bar;
        __builtin_amdgcn_s_waitcnt(0);
        unsigned nloc = b.st[0], nx = b.st[1];
        if (nloc == 0u) { xcd_barrier_complete(bar, b.x, b.G, nloc, nx); b.st[0] = nloc; b.st[1] = nx; }
        const unsigned old = xb_add(&bar[XB_XSUB(b.x)], 1u);
        const unsigned gen = old / nloc;
        if (old + 1u == (gen + 1u) * nloc) {
            __builtin_amdgcn_fence(__ATOMIC_RELEASE, "agent");
            asm volatile("s_waitcnt vmcnt(0)" ::: "memory");
            const unsigned og = xb_add(&bar[XB_TOP], 1u);
            const unsigned tg = og / nx;
            if (og + 1u == (tg + 1u) * nx) xb_add(&bar[XB_TOPGEN], 1u);
            else XB_SPIN(xb_ld(&bar[XB_TOPGEN]) == tg, bar);
            __builtin_amdgcn_fence(__ATOMIC_ACQUIRE, "agent");
            xb_add(&bar[XB_XGEN(b.x)], 1u);
            asm volatile("s_waitcnt vmcnt(0)" ::: "memory");
        } else {
            XB_SPIN(xb_ld(&bar[XB_XGEN(b.x)]) == gen, bar);
            __builtin_amdgcn_fence(__ATOMIC_ACQUIRE, "agent");
            asm volatile("s_waitcnt vmcnt(0)" ::: "memory");
        }
    }
    __syncthreads();
}

__device__ __forceinline__ void rownorm_store(const float (&hv)[16], const float* g, bf16_t* xnrow, int lane) {
    float ss = 0.f;
#pragma unroll
    for (int e = 0; e < 16; ++e) ss += hv[e] * hv[e];
    ss = wave_sum(ss);
    const float rs = rsqrtf(ss * (1.f / D) + 1e-6f);
#pragma unroll
    for (int q = 0; q < 4; ++q) {
        const int c = lane * 4 + 256 * q;
        const float4 gv = *(const float4*)(g + c);
        uint2 o; o.x = pk2(hv[4 * q] * rs * gv.x, hv[4 * q + 1] * rs * gv.y); o.y = pk2(hv[4 * q + 2] * rs * gv.z, hv[4 * q + 3] * rs * gv.w);
        *(uint2*)(xnrow + c) = o;
    }
}

__device__ __forceinline__ void p0_phase(const P& p, char* lds) {
    const int tid = TIDX, lane = tid & 63, wave = tid >> 6;
    float* tl = (float*)lds;
    constexpr int TR_ITEMS = 11776;
    for (int it = BIDX; it < TR_ITEMS; it += gridDim.x) {
        const float* src; bf16_t* dst; int K, N; int r = it;
        if (r < 1280) { int jl = r / 640; r %= 640; src = p.in[I_WINE] + (size_t)jl * D * EP; dst = (bf16_t*)(p.ws + W_WINE) + (size_t)jl * EP * D; K = D; N = EP; }
        else if ((r -= 1280) < 512) { int jl = r / 256; r %= 256; src = p.in[I_WOUTE] + (size_t)jl * D * D; dst = (bf16_t*)(p.ws + W_WOUTE) + (size_t)jl * D * D; K = D; N = D; }
        else if ((r -= 512) < 1024) { int jl = r / 512; r %= 512; src = p.in[I_WINO] + (size_t)jl * D * 2048; dst = (bf16_t*)(p.ws + W_WINO) + (size_t)jl * 2048 * D; K = D; N = 2048; }
        else if ((r -= 1024) < 512) { int jl = r / 256; r %= 256; src = p.in[I_WOUTO] + (size_t)jl * D * D; dst = (bf16_t*)(p.ws + W_WOUTO) + (size_t)jl * D * D; K = D; N = D; }
        else if ((r -= 512) < 2816) { int L = r / 704; r %= 704; src = p.in[I_WG] + (size_t)L * D * DFF; dst = (bf16_t*)(p.ws + W_WGU) + (size_t)L * 2 * DFF * D; K = D; N = DFF; }
        else if ((r -= 2816) < 2816) { int L = r / 704; r %= 704; src = p.in[I_WU] + (size_t)L * D * DFF; dst = (bf16_t*)(p.ws + W_WGU) + (size_t)L * 2 * DFF * D + (size_t)DFF * D; K = D; N = DFF; }
        else { r -= 2816; int L = r / 704; r %= 704; src = p.in[I_WD] + (size_t)L * DFF * D; dst = (bf16_t*)(p.ws + W_WDN) + (size_t)L * D * DFF; K = DFF; N = D; }
        const int nb = N / 64, k0 = (r / nb) * 64, n0 = (r % nb) * 64;
#pragma unroll
        for (int q = 0; q < 4; ++q) {
            const int row = (tid >> 4) + 16 * q, c4 = (tid & 15) * 4;
            const float4 v = *(const float4*)(src + (size_t)(k0 + row) * N + n0 + c4);
            tl[row * 65 + c4] = v.x; tl[row * 65 + c4 + 1] = v.y; tl[row * 65 + c4 + 2] = v.z; tl[row * 65 + c4 + 3] = v.w;
        }
        __syncthreads();
#pragma unroll
        for (int q = 0; q < 2; ++q) {
            const int ch = tid + 256 * q, n = ch >> 3, k8 = ch & 7;
            uint4 o;
            o.x = pk2(tl[(k8 * 8 + 0) * 65 + n], tl[(k8 * 8 + 1) * 65 + n]); o.y = pk2(tl[(k8 * 8 + 2) * 65 + n], tl[(k8 * 8 + 3) * 65 + n]);
            o.z = pk2(tl[(k8 * 8 + 4) * 65 + n], tl[(k8 * 8 + 5) * 65 + n]); o.w = pk2(tl[(k8 * 8 + 6) * 65 + n], tl[(k8 * 8 + 7) * 65 + n]);
            *(uint4*)(dst + (size_t)(n0 + n) * K + k0 + k8 * 8) = o;
        }
        __syncthreads();
    }
    const int gt = BIDX * NT + tid, gs = gridDim.x * NT;
    {
        bf16_t* wlr = (bf16_t*)(p.ws + W_WLR);
        for (int e = gt; e < 2 * 1536 * 256; e += gs) {
            const int jl = e / (1536 * 256), n = (e / 256) % 1536, k = e & 255;
            float v = 0.f;
            if (n < 512) { if (k < 64) v = p.in[I_W2][(size_t)jl * 64 * 512 + k * 512 + n]; }
            else if (n < 1024) { if (k >= 64 && k < 128) v = p.in[I_A2][(size_t)jl * 64 * 512 + (k - 64) * 512 + (n - 512)]; }
            else { if (k >= 128) v = p.in[I_G2][(size_t)jl * 128 * 512 + (k - 128) * 512 + (n - 1024)]; }
            wlr[e] = f2bf(v);
        }
        bf16_t* tr = (bf16_t*)(p.ws + W_TRIL);
        for (int e = gt; e < 2 * 8 * 128 * 128; e += gs) { const int t = (e >> 7) & 127, s = e & 127; tr[e] = f2bf(s <= t ? p.in[I_SGUW][e] : 0.f); }
        float* rope = (float*)(p.ws + W_ROPE);
        for (int e = gt; e < 8193 * 32; e += gs) {
            const int pos = e >> 5, i = e & 31;
            double inv = 1.0; for (int q = 0; q < i; ++q) inv *= 0.7498942093324559;
            double x = (double)pos * inv;
            const double TWO_PI = 6.283185307179586;
            double n = rint(x / TWO_PI); x -= n * TWO_PI;
            double qd = rint(x / 1.5707963267948966); double r = x - qd * 1.5707963267948966; int qi = ((int)qd) & 3;
            double r2 = r * r;
            double sn = r * (1.0 + r2 * (-1.0 / 6 + r2 * (1.0 / 120 + r2 * (-1.0 / 5040 + r2 * (1.0 / 362880 + r2 * (-1.0 / 39916800 + r2 * (1.0 / 6227020800.0)))))));
            double cs = 1.0 + r2 * (-0.5 + r2 * (1.0 / 24 + r2 * (-1.0 / 720 + r2 * (1.0 / 40320 + r2 * (-1.0 / 3628800 + r2 * (1.0 / 479001600.0))))));
            double c, s;
            if (qi == 0) { c = cs; s = sn; } else if (qi == 1) { c = -sn; s = cs; } else if (qi == 2) { c = -cs; s = -sn; } else { c = sn; s = -cs; }
            rope[e] = (float)c; rope[8193 * 32 + e] = (float)s;
        }
    }
    for (int row = BIDX * 4 + wave; row < M; row += gridDim.x * 4) {
        const float* xr = row < MP ? p.in[I_XP] + (size_t)row * D : p.in[I_XS] + (size_t)(row - MP) * D;
        float hv[16];
#pragma unroll
        for (int q = 0; q < 4; ++q) { const float4 v = *(const float4*)(xr + lane * 4 + 256 * q); hv[4 * q] = v.x; hv[4 * q + 1] = v.y; hv[4 * q + 2] = v.z; hv[4 * q + 3] = v.w;
            *(float4*)(p.out + (size_t)row * D + lane * 4 + 256 * q) = v; }
        rownorm_store(hv, p.in[I_NMPRE], (bf16_t*)(p.ws + W_XN) + (size_t)row * D, lane);
    }
}

typedef float f32x4v __attribute__((ext_vector_type(4)));
__device__ __forceinline__ void rownorm_phase(const P& p, const Ctx& cx, const float* mo, const float* gpost, const float* gnext) {
    const int lane = TIDX & 63, wave = TIDX >> 6;
    const int stride = cx.nb * 4;
    f32x4v gp[4], gn[4];
#pragma unroll
    for (int q = 0; q < 4; ++q) { gp[q] = *(const f32x4v*)(gpost + lane * 4 + 256 * q); gn[q] = gnext ? *(const f32x4v*)(gnext + lane * 4 + 256 * q) : (f32x4v){0.f, 0.f, 0.f, 0.f}; }
    for (int row = cx.r0 + cx.bid * 4 + wave; row < cx.r1; row += 2 * stride) {
        const int rowb = row + stride; const bool hasb = rowb < cx.r1; const int rb = hasb ? rowb : row;
        f32x4v ma[4], ha[4], mb[4], hb[4];
        float* hra = p.out + (size_t)row * D + lane * 4; float* hrb = p.out + (size_t)rb * D + lane * 4;
#pragma unroll
        for (int q = 0; q < 4; ++q) { ma[q] = *(const f32x4v*)(mo + (size_t)row * D + lane * 4 + 256 * q); mb[q] = *(const f32x4v*)(mo + (size_t)rb * D + lane * 4 + 256 * q); }
#pragma unroll
        for (int q = 0; q < 4; ++q) { ha[q] = *(const f32x4v*)(hra + 256 * q); hb[q] = *(const f32x4v*)(hrb + 256 * q); }
        float sa = 0.f, sb = 0.f;
#pragma unroll
        for (int q = 0; q < 4; ++q) { const f32x4v a2 = ma[q] * ma[q], b2 = mb[q] * mb[q]; sa += (a2.x + a2.y) + (a2.z + a2.w); sb += (b2.x + b2.y) + (b2.z + b2.w); }
#pragma unroll
        for (int o = 32; o > 0; o >>= 1) { sa += __shfl_xor(sa, o); sb += __shfl_xor(sb, o); }
        const float rsa = rsqrtf(sa * (1.f / D) + 1e-6f), rsb = rsqrtf(sb * (1.f / D) + 1e-6f);
        float ta = 0.f, tb = 0.f;
#pragma unroll
        for (int q = 0; q < 4; ++q) {
            ha[q] = ha[q] + ma[q] * rsa * gp[q]; hb[q] = hb[q] + mb[q] * rsb * gp[q];
            *(f32x4v*)(hra + 256 * q) = ha[q]; if (hasb) *(f32x4v*)(hrb + 256 * q) = hb[q];
            const f32x4v a2 = ha[q] * ha[q], b2 = hb[q] * hb[q]; ta += (a2.x + a2.y) + (a2.z + a2.w); tb += (b2.x + b2.y) + (b2.z + b2.w);
        }
        if (gnext) {
#pragma unroll
            for (int o = 32; o > 0; o >>= 1) { ta += __shfl_xor(ta, o); tb += __shfl_xor(tb, o); }
            const float ra = rsqrtf(ta * (1.f / D) + 1e-6f), rbb = rsqrtf(tb * (1.f / D) + 1e-6f);
            bf16_t* xa = (bf16_t*)(p.ws + W_XN) + (size_t)row * D + lane * 4; bf16_t* xb = (bf16_t*)(p.ws + W_XN) + (size_t)rb * D + lane * 4;
#pragma unroll
            for (int q = 0; q < 4; ++q) {
                const f32x4v ya = ha[q] * ra * gn[q], yb = hb[q] * rbb * gn[q];
                uint2 oa; oa.x = pk2(ya.x, ya.y); oa.y = pk2(ya.z, ya.w); *(uint2*)(xa + 256 * q) = oa;
                if (hasb) { uint2 ob; ob.x = pk2(yb.x, yb.y); ob.y = pk2(yb.z, yb.w); *(uint2*)(xb + 256 * q) = ob; }
            }
        }
    }
}

constexpr int BM = 128, BN = 128, BK = 64, LROW = 144  , OPB = 128 * LROW  , STG = 2 * OPB;
enum { EPI_F32 = 0, EPI_EVENIN, EPI_LR, EPI_GU, EPI_ODDIN };
struct EA { float* c32; bf16_t* o16; bf16_t* o16b; int layer; int ksplit; };

template <int EPI>
__device__ __forceinline__ void gemm_epilogue(const P& p, const f32x16 (&acc)[2][2], int m0, int n0, int wm, int wn, int lane, const EA& ea, int N) {
    const int h = lane >> 5, lr = lane & 31;
    const int jl = ea.layer >> 1;
#pragma unroll
    for (int i = 0; i < 2; ++i) {
        const int m = m0 + wm * 64 + i * 32 + lr;
        const int hb = n0 + wn * 64;
        float v[2][16];
#pragma unroll
        for (int j = 0; j < 2; ++j)
#pragma unroll
            for (int e = 0; e < 16; ++e) v[j][e] = acc[i][j][e];
        if (EPI == EPI_EVENIN) {
            const bool prompt = m < MP; const int t = m & (SEQ - 1), b = m >> 13, bs = m - MP;
            if (hb < 640) {
                const int pos = prompt ? t : SEQ;
                const float* rc = (const float*)(p.ws + W_ROPE) + (size_t)pos * 32; const float* rsn = rc + 8193 * 32;
#pragma unroll
                for (int g = 0; g < 4; ++g) {
                    const float4 c4 = *(const float4*)(rc + 8 * g + 4 * h), s4 = *(const float4*)(rsn + 8 * g + 4 * h);
                    const float cc[4] = {c4.x, c4.y, c4.z, c4.w}, sn[4] = {s4.x, s4.y, s4.z, s4.w};
#pragma unroll
                    for (int e = 0; e < 4; ++e) { const float x1 = v[0][4 * g + e], x2 = v[1][4 * g + e]; v[0][4 * g + e] = x1 * cc[e] - x2 * sn[e]; v[1][4 * g + e] = x2 * cc[e] + x1 * sn[e]; }
                }
            }
#pragma unroll
            for (int j = 0; j < 2; ++j)
#pragma unroll
                for (int g = 0; g < 4; ++g) {
                    const int dc = j * 32 + 8 * g + 4 * h;
                    uint2 o; o.x = pk2(v[j][4 * g], v[j][4 * g + 1]); o.y = pk2(v[j][4 * g + 2], v[j][4 * g + 3]);
                    *(uint2*)(ea.o16 + (size_t)m * EP + hb + dc) = o;
                    const float4 f4 = make_float4(v[j][4 * g], v[j][4 * g + 1], v[j][4 * g + 2], v[j][4 * g + 3]);
                    if (hb >= 512 && hb < 768) {
                        const int kvh = ((hb - 512) >> 6) & 1; const bool isv = hb >= 640;
                        if (prompt) { if (t >= SEQ - 128) *(float4*)(p.out + (isv ? O_WVP : O_WKP) + ((size_t)((jl * 2 + b) * 128 + (t - (SEQ - 128))) * 2 + kvh) * 64 + dc) = f4; }
                        else *(float4*)(p.out + (isv ? O_WVS : O_WKS) + ((size_t)(jl * 128 + bs) * 2 + kvh) * 64 + dc) = f4;
                    } else if (hb >= 768) {
                        const int zc = hb - 768 + dc;
                        if (prompt) { if (t == SEQ - 1) *(float4*)(p.out + O_SHP + (size_t)(jl * 2 + b) * ZBW + zc) = f4; }
                        else {
                            *(float4*)(p.out + O_SHS + (size_t)(jl * 128 + bs) * ZBW + zc) = f4;
                            if (zc >= 1536) {
                                const float4 pv = *(const float4*)(p.in[I_SHIFT] + (size_t)(jl * 128 + bs) * ZBW + zc), mu4 = *(const float4*)(p.in[I_MU] + jl * ZBW + zc);
                                const float pr[4] = {pv.x, pv.y, pv.z, pv.w}, mm[4] = {mu4.x, mu4.y, mu4.z, mu4.w}; float lo[4];
                                const int c = zc - 1536;
                                const float vq[4] = {f4.x, f4.y, f4.z, f4.w};
#pragma unroll
                                for (int e = 0; e < 4; ++e) { const float zs = vq[e] + (pr[e] - vq[e]) * mm[e]; lo[e] = c < 64 ? tanhf(zs) : (c < 128 ? zs : sigmoidf_(zs)); }
                                uint2 ol; ol.x = pk2(lo[0], lo[1]); ol.y = pk2(lo[2], lo[3]);
                                *(uint2*)(ea.o16b + (size_t)m * 256 + c) = ol;
                            }
                        }
                    }
                }
        } else {
#pragma unroll
            for (int j = 0; j < 2; ++j)
#pragma unroll
                for (int g = 0; g < 4; ++g) {
                    const int col = hb + j * 32 + 8 * g + 4 * h;
                    float x0 = v[j][4 * g], x1 = v[j][4 * g + 1], x2 = v[j][4 * g + 2], x3 = v[j][4 * g + 3];
                    if (EPI == EPI_F32) {
                        float* cp = ea.c32 + (size_t)m * N + col;
                        if (ea.ksplit > 1) { atomicAdd(cp, x0); atomicAdd(cp + 1, x1); atomicAdd(cp + 2, x2); atomicAdd(cp + 3, x3); }
                        else *(float4*)cp = make_float4(x0, x1, x2, x3);
                    } else if (EPI == EPI_ODDIN) {
                        uint2 o; o.x = pk2(gelu_erf(x0), gelu_erf(x1)); o.y = pk2(gelu_erf(x2), gelu_erf(x3));
                        *(uint2*)(ea.o16 + (size_t)m * 2048 + col) = o;
                    } else if (EPI == EPI_LR) {
                        float xs[4] = {x0, x1, x2, x3};
                        if (col < 512) {
                            const float4 w0 = *(const float4*)(p.in[I_W0] + jl * 512 + col); const float ww[4] = {w0.x, w0.y, w0.z, w0.w};
#pragma unroll
                            for (int e = 0; e < 4; ++e) xs[e] = -expm1f(-0.606531f * sigmoidf_(xs[e] + ww[e]));
                        } else if (col < 1024) {
                            const float4 a0 = *(const float4*)(p.in[I_A0] + jl * 512 + col - 512); const float aa[4] = {a0.x, a0.y, a0.z, a0.w};
#pragma unroll
                            for (int e = 0; e < 4; ++e) xs[e] = sigmoidf_(xs[e] + aa[e]);
                        }
                        uint2 o; o.x = pk2(xs[0], xs[1]); o.y = pk2(xs[2], xs[3]);
                        *(uint2*)(ea.o16 + (size_t)m * 1536 + col) = o;
                    } else if (EPI == EPI_GU) {
                        uint2 o; o.x = pk2(x0, x1); o.y = pk2(x2, x3);
                        if (col < DFF) {
                            *(uint2*)(ea.o16 + (size_t)m * DFF + col) = o;
                            const int L = ea.layer;
                            if (m < MP) { const int t = m & (SEQ - 1), b = m >> 13; if (t >= SEQ - 2) *(float4*)(p.out + O_CP + ((size_t)(L * 2 + b) * 2 + (t - (SEQ - 2))) * DFF + col) = make_float4(x0, x1, x2, x3); }
                            else { const int bs = m - MP; const size_t base = ((size_t)(L * 128 + bs) * 2) * DFF + col;
                                *(float4*)(p.out + O_CS + base + DFF) = make_float4(x0, x1, x2, x3);
                                *(float4*)(p.out + O_CS + base) = *(const float4*)(p.in[I_CONV] + base + DFF); }
                        } else *(uint2*)(ea.o16b + (size_t)m * DFF + col - DFF) = o;
                    }
                }
        }
    }
}

typedef unsigned u32x4 __attribute__((ext_vector_type(4)));
struct Stg { u32x4 a0, a1, a2, a3, b0, b1, b2, b3; };
__device__ __forceinline__ void stg_load(Stg& r, const bf16_t* ga, const bf16_t* gb, size_t sa, size_t sb) {
    r.a0 = *(const u32x4*)(ga); r.a1 = *(const u32x4*)(ga + sa); r.a2 = *(const u32x4*)(ga + 2 * sa); r.a3 = *(const u32x4*)(ga + 3 * sa);
    r.b0 = *(const u32x4*)(gb); r.b1 = *(const u32x4*)(gb + sb); r.b2 = *(const u32x4*)(gb + 2 * sb); r.b3 = *(const u32x4*)(gb + 3 * sb);
}
__device__ __forceinline__ void stg_store(const Stg& r, char* w) {
    *(u32x4*)(w) = r.a0; *(u32x4*)(w + 32 * LROW) = r.a1; *(u32x4*)(w + 64 * LROW) = r.a2; *(u32x4*)(w + 96 * LROW) = r.a3;
    *(u32x4*)(w + OPB) = r.b0; *(u32x4*)(w + OPB + 32 * LROW) = r.b1; *(u32x4*)(w + OPB + 64 * LROW) = r.b2; *(u32x4*)(w + OPB + 96 * LROW) = r.b3;
}
__device__ __forceinline__ void gemm_ktile(f32x16 (&acc)[2][2], const char* sA, const char* sB) {
    __builtin_amdgcn_s_setprio(1);
#pragma unroll
    for (int ks = 0; ks < 4; ++ks) {
        bf16x8 xa[2], wb[2];
#pragma unroll
        for (int i = 0; i < 2; ++i) xa[i] = *(const bf16x8*)(sA + i * 32 * LROW + ks * 32);
#pragma unroll
        for (int j = 0; j < 2; ++j) wb[j] = *(const bf16x8*)(sB + j * 32 * LROW + ks * 32);
#pragma unroll
        for (int i = 0; i < 2; ++i)
#pragma unroll
            for (int j = 0; j < 2; ++j) acc[i][j] = __builtin_amdgcn_mfma_f32_32x32x16_bf16(wb[j], xa[i], acc[i][j], 0, 0, 0);
    }
    __builtin_amdgcn_s_setprio(0);
}
template <int EPI>
__device__ __forceinline__ void gemm_phase(const P& p, const bf16_t* __restrict__ A, int lda, const bf16_t* __restrict__ Bt, int N, int K, char* lds, EA ea, const Ctx& cx) {
    const int tid = TIDX, lane = tid & 63, wave = tid >> 6, wm = wave >> 1, wn = wave & 1;
    const int ks_n = ea.ksplit, ntn = N / BN, mt0 = cx.r0 / BM, ntiles = ((cx.r1 - cx.r0) / BM) * ntn * ks_n, nk = K / BK / ks_n;
    const int lrow = tid >> 3, lc8 = tid & 7;
    const size_t sa = (size_t)32 * lda, sb = (size_t)32 * K;
    for (int tile = cx.bid; tile < ntiles; tile += cx.nb) {
        const int kpart = tile % ks_n, t2 = tile / ks_n;
        int mt, nt;
        if (cx.r0 == 0 && (cx.nb & 7) == 0) {
            const int x = cx.bid & 7, per = cx.nb >> 3, i = (cx.bid >> 3) + per * ((tile - cx.bid) / cx.nb);
            const int mi = i & 7, rest = i >> 3, nn = rest % ntn, mg = rest / ntn;
            mt = 16 * x + 8 * mg + mi; nt = nn;
        } else { mt = mt0 + t2 / ntn; nt = t2 % ntn; }
        const int m0 = mt * BM, n0 = nt * BN;
        const bf16_t* ga = A + (size_t)(m0 + lrow) * lda + lc8 * 8 + kpart * nk * BK;
        const bf16_t* gb = Bt + (size_t)(n0 + lrow) * K + lc8 * 8 + kpart * nk * BK;
        Stg r0, r1;
        stg_load(r0, ga, gb, sa, sb);
        stg_load(r1, ga + BK, gb + BK, sa, sb);
        f32x16 acc[2][2];
#pragma unroll
        for (int i = 0; i < 2; ++i)
#pragma unroll
            for (int j = 0; j < 2; ++j)
#pragma unroll
                for (int e = 0; e < 16; ++e) acc[i][j][e] = 0.f;
        char* wA = lds + lrow * LROW + lc8 * 16;
        stg_store(r0, wA);
        __syncthreads();
        const char* sA0 = lds + (wm * 64 + (lane & 31)) * LROW + (lane >> 5) * 16;
        const char* sB0 = lds + OPB + (wn * 64 + (lane & 31)) * LROW + (lane >> 5) * 16;
        for (int kt = 0; kt < nk; kt += 2) {
            if (kt + 2 < nk) stg_load(r0, ga + (kt + 2) * BK, gb + (kt + 2) * BK, sa, sb);
            __builtin_amdgcn_sched_barrier(0);
            gemm_ktile(acc, sA0, sB0);
            stg_store(r1, wA + STG);
            __syncthreads();
            if (kt + 3 < nk) stg_load(r1, ga + (kt + 3) * BK, gb + (kt + 3) * BK, sa, sb);
            __builtin_amdgcn_sched_barrier(0);
            gemm_ktile(acc, sA0 + STG, sB0 + STG);
            if (kt + 2 < nk) stg_store(r0, wA);
            __syncthreads();
        }
        gemm_epilogue<EPI>(p, acc, m0, n0, wm, wn, lane, ea, N);
    }
}

__device__ __forceinline__ void lr_phase(const P& p, const Ctx& cx, int jl) {
    const bf16_t* Z = cx.Z; bf16_t* LR = cx.LR;
    const int gt = cx.bid * NT + TIDX, gs = cx.nb * NT;
    for (int it = gt; it < (cx.r1 - cx.r0) * 32; it += gs) {
        const int m = cx.r0 + (it >> 5), c8 = it & 31, zc = 1536 + c8 * 8;
        const uint4 cur = *(const uint4*)(Z + (size_t)m * EP + 768 + zc);
        float pv[8];
        if (m < MP) {
            if ((m & (SEQ - 1)) == 0) { for (int e = 0; e < 8; ++e) pv[e] = 0.f; }
            else { const uint4 pr = *(const uint4*)(Z + (size_t)(m - 1) * EP + 768 + zc); pv[0] = lo16(pr.x); pv[1] = hi16(pr.x); pv[2] = lo16(pr.y); pv[3] = hi16(pr.y); pv[4] = lo16(pr.z); pv[5] = hi16(pr.z); pv[6] = lo16(pr.w); pv[7] = hi16(pr.w); }
        } else { const float* st = p.in[I_SHIFT] + (size_t)(jl * 128 + (m - MP)) * ZBW + zc; for (int e = 0; e < 8; ++e) pv[e] = st[e]; }
        const float cv[8] = {lo16(cur.x), hi16(cur.x), lo16(cur.y), hi16(cur.y), lo16(cur.z), hi16(cur.z), lo16(cur.w), hi16(cur.w)};
        const float* mu = p.in[I_MU] + jl * ZBW + zc;
        float o[8];
#pragma unroll
        for (int e = 0; e < 8; ++e) { const float zs = cv[e] + (pv[e] - cv[e]) * mu[e]; o[e] = c8 < 8 ? tanhf(zs) : (c8 < 16 ? zs : sigmoidf_(zs)); }
        uint4 ov; ov.x = pk2(o[0], o[1]); ov.y = pk2(o[2], o[3]); ov.z = pk2(o[4], o[5]); ov.w = pk2(o[6], o[7]);
        *(uint4*)(LR + (size_t)m * 256 + c8 * 8) = ov;
    }
}

__device__ __forceinline__ float zs_val(const P& p, const bf16_t* Z, int jl, int m, int c) {
    const float cur = bf2f(Z[(size_t)m * EP + 768 + c]);
    float prev;
    if (m < MP) prev = (m & (SEQ - 1)) == 0 ? 0.f : bf2f(Z[(size_t)(m - 1) * EP + 768 + c]);
    else prev = p.in[I_SHIFT][(size_t)(jl * 128 + (m - MP)) * ZBW + c];
    return cur + (prev - cur) * p.in[I_MU][jl * ZBW + c];
}

constexpr int TC = 32;
typedef float f32x2 __attribute__((ext_vector_type(2)));
typedef float f32x4 __attribute__((ext_vector_type(4)));
struct ScanRaw { u32x4 cr, ck, cv, pr, pk, pv, ep, av; };
__device__ __forceinline__ void scan_load(ScanRaw& R, const bf16_t* Z, const bf16_t* WAG, int m, int t, int c) {
    const bf16_t* zr = Z + (size_t)m * EP + 768;
    R.cr = *(const u32x4*)(zr + c); R.ck = *(const u32x4*)(zr + 512 + c); R.cv = *(const u32x4*)(zr + 1024 + c);
    R.pr = (u32x4){0u, 0u, 0u, 0u}; R.pk = R.pr; R.pv = R.pr;
    if (t > 0) { R.pr = *(const u32x4*)(zr - EP + c); R.pk = *(const u32x4*)(zr - EP + 512 + c); R.pv = *(const u32x4*)(zr - EP + 1024 + c); }
    R.ep = *(const u32x4*)(WAG + (size_t)m * 1536 + c); R.av = *(const u32x4*)(WAG + (size_t)m * 1536 + 512 + c);
}
constexpr int NCH = 5, SCAN_P1 = 256, SCAN_P2 = 256, SCAN_BLOCKS = 256;
__device__ __forceinline__ int chunk_begin(int c) { return c >= NCH ? SEQ : (c == 0 ? 0 : 2080 + (c - 1) * 1536); }
enum { SC_FULL = 0, SC_DUAL = 3 };
template <int mode>
__device__ __forceinline__ void scan_task(const P& p, const Ctx& cx, int jl, char* lds, int seq, int rg, int chunk) {
    const bf16_t* Z = cx.Z; const bf16_t* WAG = cx.WAG; bf16_t* OA = cx.OA;
    float* SEND0 = (float*)(p.ws + W_SCN); float* PM = SEND0 + 16 * 4096; float* LOC = PM + 16 * (NCH - 2) * 4096;
    const int b = seq >> 3, hd = seq & 7;
    const int tid = TIDX, lane = tid & 63, wave = tid >> 6;
    const int rowl = wave * 4 + (lane >> 4), row = rg * 16 + rowl, c4 = (lane & 15) * 4;
    float* sW = (float*)lds; float* sKK = sW + TC * 64; float* sBB = sKK + TC * 64; float* sK2 = sBB + TC * 64; float* sR = sK2 + TC * 64; float* sV = sR + TC * 64;
    float* sQ = sV + TC * 64;
    f32x4 x = {0.f, 0.f, 0.f, 0.f};
    f32x2 p01 = {(c4 == row) ? 1.f : 0.f, (c4 + 1 == row) ? 1.f : 0.f}, p23 = {(c4 + 2 == row) ? 1.f : 0.f, (c4 + 3 == row) ? 1.f : 0.f};
    if (mode == SC_FULL && chunk > 0) {
        x = *(const f32x4*)(SEND0 + (size_t)seq * 4096 + row * 64 + c4);
        for (int cc = 1; cc < chunk; ++cc) {
            *(f32x4*)(sQ + rowl * 64 + c4) = x;
            __syncthreads();
            const float* pm = PM + ((size_t)seq * (NCH - 2) + (cc - 1)) * 4096 + c4;
            f32x4 acc = *(const f32x4*)(LOC + ((size_t)seq * (NCH - 2) + (cc - 1)) * 4096 + row * 64 + c4);
#pragma unroll 8
            for (int j = 0; j < 64; ++j) { const float a = sQ[rowl * 64 + j]; const f32x4 pv = *(const f32x4*)(pm + j * 64); acc += pv * a; }
            __syncthreads();
            x = acc;
        }
    }
    f32x2 s01 = x.lo, s23 = x.hi;
    const int ptt = tid >> 3, pj0 = (tid & 7) * 8, pc = hd * 64 + pj0;
    const float* mu = p.in[I_MU] + jl * ZBW;
    float mur[8], muk[8], muv[8], kkw[8], kaw[8];
#pragma unroll
    for (int e = 0; e < 8; ++e) { mur[e] = mu[pc + e]; muk[e] = mu[512 + pc + e]; muv[e] = mu[1024 + pc + e]; kkw[e] = p.in[I_KK][jl * 512 + pc + e]; kaw[e] = p.in[I_KA][jl * 512 + pc + e]; }
    const int tb = chunk_begin(chunk), te = chunk_begin(chunk + 1);
    ScanRaw R;
    scan_load(R, Z, WAG, b * SEQ + tb + ptt, tb + ptt, pc);
    const float vscale = 1.f;
    for (int t0 = tb; t0 < te; t0 += TC) {
        {
            const unsigned crr[4] = {R.cr.x, R.cr.y, R.cr.z, R.cr.w}, ckk[4] = {R.ck.x, R.ck.y, R.ck.z, R.ck.w}, cvv[4] = {R.cv.x, R.cv.y, R.cv.z, R.cv.w};
            const unsigned prr[4] = {R.pr.x, R.pr.y, R.pr.z, R.pr.w}, pkk[4] = {R.pk.x, R.pk.y, R.pk.z, R.pk.w}, pv4[4] = {R.pv.x, R.pv.y, R.pv.z, R.pv.w};
            const unsigned epp[4] = {R.ep.x, R.ep.y, R.ep.z, R.ep.w}, avv[4] = {R.av.x, R.av.y, R.av.z, R.av.w};
            float rr[8], kx[8], vx[8], kkr[8], aa[8], ee[8]; float ssq = 0.f;
#pragma unroll
            for (int e = 0; e < 8; ++e) {
                const int w_ = e >> 1; const bool hi = e & 1;
                const float r_c = hi ? hi16(crr[w_]) : lo16(crr[w_]), r_p = hi ? hi16(prr[w_]) : lo16(prr[w_]);
                const float k_c = hi ? hi16(ckk[w_]) : lo16(ckk[w_]), k_p = hi ? hi16(pkk[w_]) : lo16(pkk[w_]);
                const float v_c = hi ? hi16(cvv[w_]) : lo16(cvv[w_]), v_p = hi ? hi16(pv4[w_]) : lo16(pv4[w_]);
                rr[e] = r_c + (r_p - r_c) * mur[e]; kx[e] = k_c + (k_p - k_c) * muk[e]; vx[e] = (v_c + (v_p - v_c) * muv[e]) * vscale;
                ee[e] = hi ? hi16(epp[w_]) : lo16(epp[w_]); aa[e] = hi ? hi16(avv[w_]) : lo16(avv[w_]);
                kkr[e] = kx[e] * kkw[e]; ssq += kkr[e] * kkr[e];
            }
            ssq += __shfl_xor(ssq, 1); ssq += __shfl_xor(ssq, 2); ssq += __shfl_xor(ssq, 4);
            const float inv = 1.f / fmaxf(sqrtf(ssq), 1e-12f);
            float ow[8], okk[8], obb[8], ok2[8];
#pragma unroll
            for (int e = 0; e < 8; ++e) { const float kkn = kkr[e] * inv; ow[e] = 1.f - ee[e]; okk[e] = kkn; obb[e] = kkn * aa[e]; ok2[e] = kx[e] * (1.f + (aa[e] - 1.f) * kaw[e]); }
            const int o = ptt * 64 + pj0;
            *(float4*)(sW + o) = make_float4(ow[0], ow[1], ow[2], ow[3]); *(float4*)(sW + o + 4) = make_float4(ow[4], ow[5], ow[6], ow[7]);
            *(float4*)(sKK + o) = make_float4(okk[0], okk[1], okk[2], okk[3]); *(float4*)(sKK + o + 4) = make_float4(okk[4], okk[5], okk[6], okk[7]);
            *(float4*)(sBB + o) = make_float4(obb[0], obb[1], obb[2], obb[3]); *(float4*)(sBB + o + 4) = make_float4(obb[4], obb[5], obb[6], obb[7]);
            *(float4*)(sK2 + o) = make_float4(ok2[0], ok2[1], ok2[2], ok2[3]); *(float4*)(sK2 + o + 4) = make_float4(ok2[4], ok2[5], ok2[6], ok2[7]);
            *(float4*)(sR + o) = make_float4(rr[0], rr[1], rr[2], rr[3]); *(float4*)(sR + o + 4) = make_float4(rr[4], rr[5], rr[6], rr[7]);
            *(float4*)(sV + o) = make_float4(vx[0], vx[1], vx[2], vx[3]); *(float4*)(sV + o + 4) = make_float4(vx[4], vx[5], vx[6], vx[7]);
        }
        __syncthreads();
        if (t0 + TC < te) scan_load(R, Z, WAG, b * SEQ + t0 + TC + ptt, t0 + TC + ptt, pc);
        {
            const float* base = sW + c4;
            float* qdst = ((lane & 3) == 0) ? (sQ + rowl * 4 + ((lane & 15) >> 2)) : (sQ + TC * 64 + lane);
            const int qstep = ((lane & 3) == 0) ? 64 : 0;
            const float* vb = sV + row;
            f32x4 kk = *(const f32x4*)(base + TC * 64), w = *(const f32x4*)(base), bb = *(const f32x4*)(base + 2 * TC * 64), k2 = *(const f32x4*)(base + 3 * TC * 64), r = *(const f32x4*)(base + 4 * TC * 64);
            float vi = vb[0];
            f32x4 kk1 = *(const f32x4*)(base + TC * 64 + 64), w1 = *(const f32x4*)(base + 64), bb1 = *(const f32x4*)(base + 2 * TC * 64 + 64), k21 = *(const f32x4*)(base + 3 * TC * 64 + 64), r1 = *(const f32x4*)(base + 4 * TC * 64 + 64);
            float vi1 = vb[64];
#pragma unroll
            for (int tt = 0; tt < TC; ++tt) {
                const int tn = (tt + 2 < TC) ? tt + 2 : TC - 1;
                const f32x4 nkk = *(const f32x4*)(base + TC * 64 + tn * 64), nw = *(const f32x4*)(base + tn * 64), nbb = *(const f32x4*)(base + 2 * TC * 64 + tn * 64),
                            nk2 = *(const f32x4*)(base + 3 * TC * 64 + tn * 64), nr = *(const f32x4*)(base + 4 * TC * 64 + tn * 64);
                const float nvi = vb[tn * 64];
                const f32x2 viv = {vi, vi};
                const f32x2 tp = s01 * kk.lo + s23 * kk.hi;
                float pp = tp.x + tp.y;
                const f32x2 t01 = s01 * w.lo + viv * k2.lo, t23 = s23 * w.hi + viv * k2.hi;
                if (mode == SC_DUAL) {
                    const f32x2 tq = p01 * kk.lo + p23 * kk.hi;
                    float pq = tq.x + tq.y;
                    const f32x2 u01 = p01 * w.lo, u23 = p23 * w.hi;
                    pq = row16_sum(pq);
                    const f32x2 sap = {-pq, -pq};
                    p01 = sap * bb.lo + u01; p23 = sap * bb.hi + u23;
                }
                pp = row16_sum(pp);
                const f32x2 sav = {-pp, -pp};
                s01 = sav * bb.lo + t01; s23 = sav * bb.hi + t23;
                if (mode == SC_FULL) {
                    const f32x2 uq = s01 * r.lo + s23 * r.hi;
                    float q = uq.x + uq.y;
                    q = dpp_add<0xB1>(q); q = dpp_add<0x4E>(q);
                    qdst[tt * qstep] = q;
                }
                kk = kk1; w = w1; bb = bb1; k2 = k21; r = r1; vi = vi1;
                kk1 = nkk; w1 = nw; bb1 = nbb; k21 = nk2; r1 = nr; vi1 = nvi;
            }
        }
        __syncthreads();
        if (mode == SC_FULL) {
            const int tt = tid >> 3, r2 = (tid & 7) * 2; const int m = b * SEQ + t0 + tt;
            const float4 qa = *(const float4*)(sQ + (tt * 16 + r2) * 4), qb = *(const float4*)(sQ + (tt * 16 + r2 + 1) * 4);
            *(unsigned*)(OA + (size_t)m * D + 512 + hd * 64 + rg * 16 + r2) = pk2((qa.x + qa.y) + (qa.z + qa.w), (qb.x + qb.y) + (qb.z + qb.w));
        }
    }
    const f32x4 fin = {s01.x, s01.y, s23.x, s23.y};
    if (mode == SC_FULL) {
        if (chunk == 0) *(f32x4*)(SEND0 + (size_t)seq * 4096 + row * 64 + c4) = fin;
        if (chunk == NCH - 1) *(f32x4*)(p.out + O_SP + ((size_t)((jl * 2 + b) * 8 + hd) * 64 + row) * 64 + c4) = fin;
    } else {
        *(f32x4*)(LOC + ((size_t)seq * (NCH - 2) + (chunk - 1)) * 4096 + row * 64 + c4) = fin;
        const f32x4 pf = {p01.x, p01.y, p23.x, p23.y};
        *(f32x4*)(PM + ((size_t)seq * (NCH - 2) + (chunk - 1)) * 4096 + row * 64 + c4) = pf;
    }
    __syncthreads();
}

__device__ __forceinline__ void attn_prompt_item(const P& p, const Ctx& cx, int jl, int item, char* lds) {
    const bf16_t* Z = cx.Z; bf16_t* OA = cx.OA;
    const int kvh = item & 1, qb = (item >> 1) & 63, b = item >> 7;
    const int tid = TIDX, lane = tid & 63, wave = tid >> 6, lr = lane & 31, h = lane >> 5;
    constexpr int KROW = 144, VROW = 528;
    char* sK = lds; char* sVt = lds + 256 * KROW;
#pragma unroll 2
    for (int q = 0; q < 8; ++q) {
        const int ch = tid + 256 * q, key = ch >> 3, c8 = ch & 7; const int tk = (qb - 1) * 128 + key;
        uint4 kv = make_uint4(0, 0, 0, 0), vv = kv;
        if (tk >= 0) { const bf16_t* zr = Z + (size_t)(b * SEQ + tk) * EP; kv = *(const uint4*)(zr + 512 + kvh * 64 + c8 * 8); vv = *(const uint4*)(zr + 640 + kvh * 64 + c8 * 8); }
        *(uint4*)(sK + key * KROW + c8 * 16) = kv;
        const unsigned vw[4] = {vv.x, vv.y, vv.z, vv.w};
#pragma unroll
        for (int e = 0; e < 8; ++e) *(bf16_t*)(sVt + (c8 * 8 + e) * VROW + key * 2) = (bf16_t)((e & 1) ? (vw[e >> 1] >> 16) : (vw[e >> 1] & 0xffff));
    }
    __syncthreads();
    const int qs = wave;
    const int qrow = b * SEQ + qb * 128 + qs * 32 + lr;
    const int qloc = qs * 32 + lr;
#pragma unroll 1
    for (int g = 0; g < 4; ++g) {
        const int qh = kvh * 4 + g;
        bf16x8 qf[4];
#pragma unroll
        for (int s = 0; s < 4; ++s) qf[s] = *(const bf16x8*)(Z + (size_t)qrow * EP + qh * 64 + s * 16 + h * 8);
        f32x16 sc[5];
#pragma unroll
        for (int u = 0; u < 5; ++u) {
#pragma unroll
            for (int e = 0; e < 16; ++e) sc[u][e] = 0.f;
#pragma unroll
            for (int s = 0; s < 4; ++s) {
                const bf16x8 kf = *(const bf16x8*)(sK + ((qs + u) * 32 + lr) * KROW + s * 32 + h * 16);
                sc[u] = __builtin_amdgcn_mfma_f32_32x32x16_bf16(kf, qf[s], sc[u], 0, 0, 0);
            }
            __builtin_amdgcn_sched_barrier(0);
        }
        const float sink = p.in[I_SINK][jl * 8 + qh];
        float mx = -3e38f;
#pragma unroll
        for (int u = 0; u < 5; ++u)
#pragma unroll
            for (int e = 0; e < 16; ++e) {
                const int kj = (qs + u) * 32 + (e & 3) + 8 * (e >> 2) + 4 * h;
                const int diff = 128 + qloc - kj;
                const bool vis = diff >= 0 && diff <= 128 && (qb > 0 || kj >= 128);
                const float sv = vis ? sc[u][e] * 0.125f : -1e30f;
                sc[u][e] = sv; mx = fmaxf(mx, sv);
            }
        mx = fmaxf(mx, __shfl_xor(mx, 32)); mx = fmaxf(mx, sink);
        float sum = 0.f;
#pragma unroll
        for (int u = 0; u < 5; ++u)
#pragma unroll
            for (int e = 0; e < 16; ++e) { const float pe = __expf(sc[u][e] - mx); sc[u][e] = pe; sum += pe; }
        sum += __shfl_xor(sum, 32);
        const float rden = 1.f / (sum + __expf(sink - mx));
        f32x16 oacc[2];
#pragma unroll
        for (int d2 = 0; d2 < 2; ++d2)
#pragma unroll
            for (int e = 0; e < 16; ++e) oacc[d2][e] = 0.f;
#pragma unroll
        for (int u = 0; u < 5; ++u)
#pragma unroll
            for (int s2 = 0; s2 < 2; ++s2) {
                union { bf16x8 v; unsigned w[4]; } pf;
#pragma unroll
                for (int e2 = 0; e2 < 4; ++e2) pf.w[e2] = pk2(sc[u][8 * s2 + 2 * e2] * rden, sc[u][8 * s2 + 2 * e2 + 1] * rden);
                const int kbase = (qs + u) * 32 + 16 * s2 + 4 * h;
#pragma unroll
                for (int d2 = 0; d2 < 2; ++d2) {
                    union { bf16x8 v; uint2 w[2]; } vf;
                    const char* vp = sVt + (d2 * 32 + lr) * VROW + kbase * 2;
                    vf.w[0] = *(const uint2*)vp; vf.w[1] = *(const uint2*)(vp + 16);
                    oacc[d2] = __builtin_amdgcn_mfma_f32_32x32x16_bf16(vf.v, pf.v, oacc[d2], 0, 0, 0);
                }
                __builtin_amdgcn_sched_barrier(0);
            }
#pragma unroll
        for (int d2 = 0; d2 < 2; ++d2)
#pragma unroll
            for (int g2 = 0; g2 < 4; ++g2) {
                uint2 o; o.x = pk2(oacc[d2][4 * g2], oacc[d2][4 * g2 + 1]); o.y = pk2(oacc[d2][4 * g2 + 2], oacc[d2][4 * g2 + 3]);
                *(uint2*)(OA + (size_t)qrow * D + qh * 64 + d2 * 32 + 8 * g2 + 4 * h) = o;
            }
    }
    __syncthreads();
}

__device__ __forceinline__ void attn_sample_item(const P& p, const Ctx& cx, int jl, int item, char* lds) {
    const bf16_t* Z = cx.Z; bf16_t* OA = cx.OA;
    const int kvh = item & 1, bs = item >> 1, m = MP + bs;
    const int tid = TIDX, lane = tid & 63, wave = tid >> 6, qh = kvh * 4 + wave;
    float* sq = (float*)lds + wave * 64; float* sp = (float*)lds + 256 + wave * 132;
    sq[lane] = bf2f(Z[(size_t)m * EP + qh * 64 + lane]);
    __syncthreads();
    const float* kc = p.in[I_CK] + ((size_t)(jl * 128 + bs) * 128) * 128 + kvh * 64;
    const float* vc = p.in[I_CV] + ((size_t)(jl * 128 + bs) * 128) * 128 + kvh * 64;
    float sc0 = 0.f, sc1 = 0.f, sc2 = 0.f;
#pragma unroll 4
    for (int d = 0; d < 64; d += 4) {
        const float4 k0 = *(const float4*)(kc + (size_t)lane * 128 + d), k1 = *(const float4*)(kc + (size_t)(lane + 64) * 128 + d);
        const float4 q4 = *(const float4*)(sq + d);
        sc0 += k0.x * q4.x + k0.y * q4.y + k0.z * q4.z + k0.w * q4.w; sc1 += k1.x * q4.x + k1.y * q4.y + k1.z * q4.z + k1.w * q4.w;
    }
    sc2 = wave_sum(bf2f(Z[(size_t)m * EP + 512 + kvh * 64 + lane]) * sq[lane]);
    sc0 *= 0.125f; sc1 *= 0.125f; sc2 *= 0.125f;
    const float sink = p.in[I_SINK][jl * 8 + qh];
    float mx = wave_max(fmaxf(sc0, sc1)); mx = fmaxf(fmaxf(mx, sc2), sink);
    const float p0 = __expf(sc0 - mx), p1 = __expf(sc1 - mx), p2 = __expf(sc2 - mx);
    const float den = wave_sum(p0 + p1) + p2 + __expf(sink - mx), rd = 1.f / den;
    sp[lane] = p0 * rd; sp[lane + 64] = p1 * rd; if (lane == 0) sp[128] = p2 * rd;
    __syncthreads();
    float o = 0.f;
#pragma unroll 32
    for (int j = 0; j < 128; ++j) o += sp[j] * vc[(size_t)j * 128 + lane];
    o += sp[128] * bf2f(Z[(size_t)m * EP + 640 + kvh * 64 + lane]);
    OA[(size_t)m * D + qh * 64 + lane] = f2bf(o);
    __syncthreads();
}

__device__ __forceinline__ void rwkv_sample_item(const P& p, const Ctx& cx, int jl, int item, char* lds) {
    const bf16_t* Z = cx.Z; const bf16_t* WAG = cx.WAG; bf16_t* OA = cx.OA;
    const int hd = item & 7, bs = item >> 3, m = MP + bs;
    const int tid = TIDX;
    float* sW = (float*)lds; float* sKK = sW + 64; float* sBB = sKK + 64; float* sK2 = sBB + 64; float* sR = sK2 + 64; float* sV = sR + 64;
    if (tid < 64) {
        const int c = hd * 64 + tid;
        const float r = zs_val(p, Z, jl, m, c), k = zs_val(p, Z, jl, m, 512 + c), v = zs_val(p, Z, jl, m, 1024 + c);
        const float eps = bf2f(WAG[(size_t)m * 1536 + c]), a = bf2f(WAG[(size_t)m * 1536 + 512 + c]);
        const float kkr = k * p.in[I_KK][jl * 512 + c];
        const float ssq = wave_sum(kkr * kkr);
        const float kkn = kkr / fmaxf(sqrtf(ssq), 1e-12f);
        sW[tid] = 1.f - eps; sKK[tid] = kkn; sBB[tid] = kkn * a; sK2[tid] = k * (1.f + (a - 1.f) * p.in[I_KA][jl * 512 + c]); sR[tid] = r; sV[tid] = v;
    }
    __syncthreads();
    const int i = tid >> 2, q = tid & 3;
    const float* sp = p.in[I_WKV] + ((size_t)((jl * 128 + bs) * 8 + hd) * 64 + i) * 64 + q * 16;
    float s[16]; float pp = 0.f;
#pragma unroll
    for (int e4 = 0; e4 < 4; ++e4) { const float4 v = *(const float4*)(sp + 4 * e4); s[4 * e4] = v.x; s[4 * e4 + 1] = v.y; s[4 * e4 + 2] = v.z; s[4 * e4 + 3] = v.w; }
#pragma unroll
    for (int e = 0; e < 16; ++e) pp += s[e] * sKK[q * 16 + e];
    pp += __shfl_xor(pp, 1); pp += __shfl_xor(pp, 2);
    const float sa = -pp, vi = sV[i];
    float qq = 0.f;
#pragma unroll
    for (int e = 0; e < 16; ++e) { const int j = q * 16 + e; s[e] = s[e] * sW[j] + sa * sBB[j] + vi * sK2[j]; qq += s[e] * sR[j]; }
    qq += __shfl_xor(qq, 1); qq += __shfl_xor(qq, 2);
    float* so = p.out + O_SS + ((size_t)((jl * 128 + bs) * 8 + hd) * 64 + i) * 64 + q * 16;
#pragma unroll
    for (int e4 = 0; e4 < 4; ++e4) *(float4*)(so + 4 * e4) = make_float4(s[4 * e4], s[4 * e4 + 1], s[4 * e4 + 2], s[4 * e4 + 3]);
    if (q == 0) OA[(size_t)m * D + 512 + hd * 64 + i] = f2bf(qq);
    __syncthreads();
}

__device__ __forceinline__ void mix_sample(const P& p, const Ctx& cx, int jl, char* lds) {
    for (int it = cx.bid; it < 256 + 1024; it += cx.nb) {
        if (it < 256) attn_sample_item(p, cx, jl, it, lds);
        else rwkv_sample_item(p, cx, jl, it - 256, lds);
    }
}

__device__ __forceinline__ void unpack8(const uint4& u, float (&o)[8]) { o[0] = lo16(u.x); o[1] = hi16(u.x); o[2] = lo16(u.y); o[3] = hi16(u.y); o[4] = lo16(u.z); o[5] = hi16(u.z); o[6] = lo16(u.w); o[7] = hi16(u.w); }
__device__ __forceinline__ void load8f(const float* p_, float (&o)[8]) { const float4 a = *(const float4*)p_, b = *(const float4*)(p_ + 4); o[0] = a.x; o[1] = a.y; o[2] = a.z; o[3] = a.w; o[4] = b.x; o[5] = b.y; o[6] = b.z; o[7] = b.w; }
__device__ __forceinline__ float group8_sum(float x) { x = dpp_add<0xB1>(x); x = dpp_add<0x4E>(x); x = dpp_add<0x141>(x); return x; }
__device__ __forceinline__ void post_phase(const P& p, const Ctx& cx, int jl) {
    if (cx.r0 == MP) { float* mo = cx.MOE + (size_t)MP * D; for (int i = cx.bid * NT + TIDX; i < MS * D / 4; i += cx.nb * NT) *(float4*)(mo + 4 * i) = make_float4(0.f, 0.f, 0.f, 0.f); }
    const bf16_t* Z = cx.Z; const bf16_t* WAG = cx.WAG; bf16_t* OA = cx.OA;
    const int tid = TIDX, lane = tid & 63, wave = tid >> 6, c = lane * 8;
    float mur[8], muk[8], muv[8], ka[8], rkw[8], gg[8], gb[8];
    load8f(p.in[I_MU] + jl * ZBW + c, mur); load8f(p.in[I_MU] + jl * ZBW + 512 + c, muk); load8f(p.in[I_MU] + jl * ZBW + 1024 + c, muv);
    load8f(p.in[I_KA] + jl * 512 + c, ka); load8f(p.in[I_RK] + jl * 512 + c, rkw); load8f(p.in[I_GNG] + jl * 512 + c, gg); load8f(p.in[I_GNB] + jl * 512 + c, gb);
    for (int m = cx.r0 + cx.bid * 4 + wave; m < cx.r1; m += cx.nb * 4) {
        const bf16_t* zr = Z + (size_t)m * EP + 768 + c;
        float r[8], k[8], v[8], pr[8], pk[8], pv[8], a[8], g[8], o[8];
        unpack8(*(const uint4*)zr, r); unpack8(*(const uint4*)(zr + 512), k); unpack8(*(const uint4*)(zr + 1024), v);
        unpack8(*(const uint4*)(WAG + (size_t)m * 1536 + 512 + c), a); unpack8(*(const uint4*)(WAG + (size_t)m * 1536 + 1024 + c), g);
        unpack8(*(const uint4*)(OA + (size_t)m * D + 512 + c), o);
        if (m < MP) {
            if ((m & (SEQ - 1)) == 0) {
#pragma unroll
                for (int e = 0; e < 8; ++e) { pr[e] = 0.f; pk[e] = 0.f; pv[e] = 0.f; }
            } else { unpack8(*(const uint4*)(zr - EP), pr); unpack8(*(const uint4*)(zr - EP + 512), pk); unpack8(*(const uint4*)(zr - EP + 1024), pv); }
        } else { const float* st = p.in[I_SHIFT] + (size_t)(jl * 128 + (m - MP)) * ZBW + c; load8f(st, pr); load8f(st + 512, pk); load8f(st + 1024, pv); }
        float rk = 0.f, so = 0.f;
#pragma unroll
        for (int e = 0; e < 8; ++e) {
            r[e] += (pr[e] - r[e]) * mur[e]; k[e] += (pk[e] - k[e]) * muk[e]; v[e] += (pv[e] - v[e]) * muv[e];
            const float k2 = k[e] * (1.f + (a[e] - 1.f) * ka[e]);
            rk += r[e] * k2 * rkw[e]; so += o[e];
        }
        rk = group8_sum(rk);
        const float mean = group8_sum(so) * (1.f / 64);
        float sv = 0.f;
#pragma unroll
        for (int e = 0; e < 8; ++e) { o[e] -= mean; sv += o[e] * o[e]; }
        const float rstd = rsqrtf(group8_sum(sv) * (1.f / 64) + 64e-5f);
        float res[8];
#pragma unroll
        for (int e = 0; e < 8; ++e) res[e] = (o[e] * rstd * gg[e] + gb[e] + rk * v[e]) * g[e];
        uint4 ov; ov.x = pk2(res[0], res[1]); ov.y = pk2(res[2], res[3]); ov.z = pk2(res[4], res[5]); ov.w = pk2(res[6], res[7]);
        *(uint4*)(OA + (size_t)m * D + 512 + c) = ov;
    }
}

__device__ __forceinline__ void sgu_ln_phase(const P& p, const Ctx& cx, int jo) {
    bf16_t* ZU = cx.ZU;
    const int lane = TIDX & 63, wave = TIDX >> 6;
    for (int m = cx.r0 + cx.bid * 4 + wave; m < cx.r1; m += cx.nb * 4) {
        bf16_t* vr = ZU + (size_t)m * 2048 + 1024;
        float x[16]; float s = 0.f;
#pragma unroll
        for (int q = 0; q < 2; ++q) { const uint4 u = *(const uint4*)(vr + lane * 8 + 512 * q);
            x[8 * q] = lo16(u.x); x[8 * q + 1] = hi16(u.x); x[8 * q + 2] = lo16(u.y); x[8 * q + 3] = hi16(u.y); x[8 * q + 4] = lo16(u.z); x[8 * q + 5] = hi16(u.z); x[8 * q + 6] = lo16(u.w); x[8 * q + 7] = hi16(u.w); }
#pragma unroll
        for (int e = 0; e < 16; ++e) s += x[e];
        const float mean = wave_sum(s) * (1.f / 1024);
        float s2 = 0.f;
#pragma unroll
        for (int e = 0; e < 16; ++e) { x[e] -= mean; s2 += x[e] * x[e]; }
        const float rstd = rsqrtf(wave_sum(s2) * (1.f / 1024) + 1e-5f);
#pragma unroll
        for (int q = 0; q < 2; ++q) {
            const int c = lane * 8 + 512 * q; float o[8];
#pragma unroll
            for (int e = 0; e < 8; ++e) o[e] = x[8 * q + e] * rstd * p.in[I_LNG][jo * 1024 + c + e] + p.in[I_LNB][jo * 1024 + c + e];
            uint4 ov; ov.x = pk2(o[0], o[1]); ov.y = pk2(o[2], o[3]); ov.z = pk2(o[4], o[5]); ov.w = pk2(o[6], o[7]);
            *(uint4*)(vr + c) = ov;
            if (m >= MP) { float* so = p.out + O_SGV + (size_t)(jo * 128 + (m - MP)) * 1024 + c; *(float4*)so = make_float4(o[0], o[1], o[2], o[3]); *(float4*)(so + 4) = make_float4(o[4], o[5], o[6], o[7]); }
        }
    }
}

template <bool SAMPLE>
__device__ __forceinline__ void sgu_phase(const P& p, const Ctx& cx, int jo, char* lds) {
    const bf16_t* ZU = cx.ZU; bf16_t* Y = cx.Y;
    const bf16_t* TR = (const bf16_t*)(p.ws + W_TRIL) + (size_t)jo * 8 * 128 * 128;
    const int tid = TIDX, lane = tid & 63, wave = tid >> 6, wm = wave >> 1, wn = wave & 1, lr = lane & 31, h = lane >> 5;
    constexpr int SROW = 272;
    char* sA = lds; char* sB = lds + 128 * SROW;
    if (!SAMPLE) for (int item = cx.bid; item < 1024; item += cx.nb) {
        const int hh = item & 7, n = (item >> 3) & 63, b = item >> 9;
        const int mbase = b * SEQ + n * 128;
#pragma unroll
        for (int q = 0; q < 8; ++q) {
            const int ch = tid + 256 * q, r = ch >> 4, c8 = ch & 15;
            *(uint4*)(sA + r * SROW + c8 * 16) = *(const uint4*)(TR + (size_t)hh * 16384 + r * 128 + c8 * 8);
            const uint4 vv = *(const uint4*)(ZU + (size_t)(mbase + r) * 2048 + 1024 + hh * 128 + c8 * 8);
            const unsigned vw[4] = {vv.x, vv.y, vv.z, vv.w};
#pragma unroll
            for (int e = 0; e < 8; ++e) *(bf16_t*)(sB + (c8 * 8 + e) * SROW + r * 2) = (bf16_t)((e & 1) ? (vw[e >> 1] >> 16) : (vw[e >> 1] & 0xffff));
        }
        __syncthreads();
        f32x16 acc[2][2];
#pragma unroll
        for (int i = 0; i < 2; ++i)
#pragma unroll
            for (int j = 0; j < 2; ++j)
#pragma unroll
                for (int e = 0; e < 16; ++e) acc[i][j][e] = 0.f;
#pragma unroll
        for (int ks = 0; ks < 8; ++ks) {
            bf16x8 xa[2], wb[2];
#pragma unroll
            for (int i = 0; i < 2; ++i) xa[i] = *(const bf16x8*)(sA + (wm * 64 + i * 32 + lr) * SROW + ks * 32 + h * 16);
#pragma unroll
            for (int j = 0; j < 2; ++j) wb[j] = *(const bf16x8*)(sB + (wn * 64 + j * 32 + lr) * SROW + ks * 32 + h * 16);
#pragma unroll
            for (int i = 0; i < 2; ++i)
#pragma unroll
                for (int j = 0; j < 2; ++j) acc[i][j] = __builtin_amdgcn_mfma_f32_32x32x16_bf16(wb[j], xa[i], acc[i][j], 0, 0, 0);
        }
#pragma unroll
        for (int i = 0; i < 2; ++i) {
            const int t = wm * 64 + i * 32 + lr; const float bias = p.in[I_SGUB][(jo * 8 + hh) * 128 + t];
#pragma unroll
            for (int j = 0; j < 2; ++j)
#pragma unroll
                for (int g = 0; g < 4; ++g) {
                    const int c = hh * 128 + wn * 64 + j * 32 + 8 * g + 4 * h;
                    const uint2 uu = *(const uint2*)(ZU + (size_t)(mbase + t) * 2048 + c);
                    uint2 o; o.x = pk2(lo16(uu.x) * (acc[i][j][4 * g] + bias), hi16(uu.x) * (acc[i][j][4 * g + 1] + bias));
                    o.y = pk2(lo16(uu.y) * (acc[i][j][4 * g + 2] + bias), hi16(uu.y) * (acc[i][j][4 * g + 3] + bias));
                    *(uint2*)(Y + (size_t)(mbase + t) * D + c) = o;
                }
        }
        __syncthreads();
    }
    const int gt = cx.bid * NT + tid, gs = cx.nb * NT;
    if (cx.r0 == MP) { float* mo = cx.MOE + (size_t)MP * D; for (int i = cx.bid * NT + tid; i < MS * D / 4; i += cx.nb * NT) *(float4*)(mo + 4 * i) = make_float4(0.f, 0.f, 0.f, 0.f); }
    if (SAMPLE) for (int it = gt; it < MS * 1024; it += gs) {
        const int m = MP + (it >> 10), c = it & 1023, hh = c >> 7;
        const float u = bf2f(ZU[(size_t)m * 2048 + c]), vn = bf2f(ZU[(size_t)m * 2048 + 1024 + c]);
        Y[(size_t)m * D + c] = f2bf(u * (p.in[I_SGUW][(size_t)(jo * 8 + hh) * 16384] * vn + p.in[I_SGUB][(jo * 8 + hh) * 128]));
    }
}

__device__ __forceinline__ void unpack8v(const u32x4& u, float (&o)[8]) { o[0] = lo16(u.x); o[1] = hi16(u.x); o[2] = lo16(u.y); o[3] = hi16(u.y); o[4] = lo16(u.z); o[5] = hi16(u.z); o[6] = lo16(u.w); o[7] = hi16(u.w); }
template <bool SAMPLE>
__device__ __forceinline__ void act_phase(const P& p, const Ctx& cx, int L) {
    const bf16_t* G = cx.G; bf16_t* U = cx.U;
    const int gt = cx.bid * NT + TIDX, gs = cx.nb * NT;
    const float* cw = p.in[I_CW] + (size_t)L * 3 * DFF; const float* cb = p.in[I_CB] + (size_t)L * DFF;
    constexpr int CG = DFF / 8, RC = 16;
    if (!SAMPLE) for (int it = gt; it < (MP / RC) * CG; it += gs) {
        const int m0 = (it / CG) * RC, c = (it % CG) * 8;
        float w0[8], w1[8], w2[8], bb[8], g1[8], g2[8];
        load8f(cw + c, w0); load8f(cw + DFF + c, w1); load8f(cw + 2 * DFF + c, w2); load8f(cb + c, bb);
        if ((m0 & (SEQ - 1)) == 0) {
#pragma unroll
            for (int e = 0; e < 8; ++e) { g1[e] = 0.f; g2[e] = 0.f; }
        } else { unpack8v(*(const u32x4*)(G + (size_t)(m0 - 1) * DFF + c), g1); unpack8v(*(const u32x4*)(G + (size_t)(m0 - 2) * DFF + c), g2); }
#pragma unroll
        for (int hf = 0; hf < RC / 8; ++hf) {
            u32x4 gq[8], uq[8];
#pragma unroll
            for (int r = 0; r < 8; ++r) { gq[r] = *(const u32x4*)(G + (size_t)(m0 + hf * 8 + r) * DFF + c); uq[r] = *(const u32x4*)(U + (size_t)(m0 + hf * 8 + r) * DFF + c); }
#pragma unroll
            for (int r = 0; r < 8; ++r) {
                float gc[8], uv[8], o[8];
                unpack8v(gq[r], gc); unpack8v(uq[r], uv);
#pragma unroll
                for (int e = 0; e < 8; ++e) { const float cv = bb[e] + w2[e] * gc[e] + w1[e] * g1[e] + w0[e] * g2[e]; o[e] = gelu_tanh(cv) * uv[e]; g2[e] = g1[e]; g1[e] = gc[e]; }
                u32x4 ov; ov.x = pk2(o[0], o[1]); ov.y = pk2(o[2], o[3]); ov.z = pk2(o[4], o[5]); ov.w = pk2(o[6], o[7]);
                *(u32x4*)(U + (size_t)(m0 + hf * 8 + r) * DFF + c) = ov;
            }
        }
    }
    if (cx.r0 == MP) { float* mo = cx.MOE + (size_t)MP * D; for (int i = cx.bid * NT + TIDX; i < MS * D / 4; i += cx.nb * NT) *(float4*)(mo + 4 * i) = make_float4(0.f, 0.f, 0.f, 0.f); }
    if (SAMPLE) for (int it = gt; it < MS * CG; it += gs) {
        const int m = MP + it / CG, c = (it % CG) * 8;
        float w0[8], w1[8], w2[8], bb[8], g1[8], g2[8], gc[8], uv[8], o[8];
        load8f(cw + c, w0); load8f(cw + DFF + c, w1); load8f(cw + 2 * DFF + c, w2); load8f(cb + c, bb);
        const float* st = p.in[I_CONV] + ((size_t)(L * 128 + (m - MP)) * 2) * DFF + c;
        load8f(st, g2); load8f(st + DFF, g1);
        unpack8v(*(const u32x4*)(G + (size_t)m * DFF + c), gc); unpack8v(*(const u32x4*)(U + (size_t)m * DFF + c), uv);
#pragma unroll
        for (int e = 0; e < 8; ++e) { const float cv = bb[e] + w2[e] * gc[e] + w1[e] * g1[e] + w0[e] * g2[e]; o[e] = gelu_tanh(cv) * uv[e]; }
        u32x4 ov; ov.x = pk2(o[0], o[1]); ov.y = pk2(o[2], o[3]); ov.z = pk2(o[4], o[5]); ov.w = pk2(o[6], o[7]);
        *(u32x4*)(U + (size_t)m * DFF + c) = ov;
    }
}

struct Chains { Ctx main, samp; XcdBarrier sb; };

template <bool SAMPLE>
__device__ __forceinline__ void run_op(const P& p, Chains& ch, int L, int op, char* lds, int pass = 1) {
    const Ctx& cx = SAMPLE ? ch.samp : ch.main;
    const int j = L >> 1; const bool even = (L & 1) == 0;
    bf16_t* XN = (bf16_t*)(p.ws + W_XN);
    EA ea; ea.c32 = nullptr; ea.o16 = nullptr; ea.o16b = nullptr; ea.layer = L; ea.ksplit = 1;
    if (even) {
        switch (op) {
        case 0: ea.o16 = cx.Z; ea.o16b = cx.LR; gemm_phase<EPI_EVENIN>(p, XN, D, (const bf16_t*)(p.ws + W_WINE) + (size_t)j * EP * D, EP, D, lds, ea, cx); return;
        case 1: lr_phase(p, cx, j); return;
        case 2: ea.o16 = cx.WAG; gemm_phase<EPI_LR>(p, cx.LR, 256, (const bf16_t*)(p.ws + W_WLR) + (size_t)j * 1536 * 256, 1536, 256, lds, ea, cx); return;
        case 3:
            if constexpr (SAMPLE) mix_sample(p, cx, j, lds);
            else {
                const int bidx = BIDX;
                if (pass == 1) {
                    if (bidx < SCAN_P1) {
                        if (bidx < 64) scan_task<SC_FULL>(p, cx, j, lds, bidx >> 2, bidx & 3, 0);
                        else { const int r = bidx - 64, r2 = r & 63; scan_task<SC_DUAL>(p, cx, j, lds, r2 >> 2, r2 & 3, 1 + (r >> 6)); }
                        return;
                    }
                } else {
                    if (bidx < SCAN_P2) { const int r2 = bidx & 63; scan_task<SC_FULL>(p, cx, j, lds, r2 >> 2, r2 & 3, 1 + (bidx >> 6)); return; }
                    for (int it = ch.samp.bid; it < 256; it += ch.samp.nb) attn_prompt_item(p, cx, j, it, lds);
                }
                if (pass == 1) {
#pragma unroll 1
                    for (int o2 = 0; o2 < 10; ++o2) { if (o2 == 1) continue;
                        run_op<true>(p, ch, L, o2, lds); if (o2 != 9) xcd_barrier(ch.sb); }
                } else {
                    run_op<true>(p, ch, L, 10, lds); xcd_barrier(ch.sb);
#pragma unroll 1
                    for (int o2 = 0; o2 < 9; ++o2) { run_op<true>(p, ch, L + 1, o2, lds); if (o2 != 8) xcd_barrier(ch.sb); }
                }
            }
            return;
        case 4: post_phase(p, cx, j); return;
        case 5: ea.c32 = cx.MOE; if (SAMPLE) ea.ksplit = 4; gemm_phase<EPI_F32>(p, cx.OA, D, (const bf16_t*)(p.ws + W_WOUTE) + (size_t)j * D * D, D, D, lds, ea, cx); return;
        case 6: rownorm_phase(p, cx, cx.MOE, p.in[I_NMPOST] + L * D, p.in[I_NFPRE] + L * D); return;
        default: break;
        }
        op -= 7;
    } else {
        switch (op) {
        case 0: ea.o16 = cx.ZU; gemm_phase<EPI_ODDIN>(p, XN, D, (const bf16_t*)(p.ws + W_WINO) + (size_t)j * 2048 * D, 2048, D, lds, ea, cx); return;
        case 1: sgu_ln_phase(p, cx, j); return;
        case 2: sgu_phase<SAMPLE>(p, cx, j, lds); return;
        case 3: ea.c32 = cx.MOO; if (SAMPLE) ea.ksplit = 4; gemm_phase<EPI_F32>(p, cx.Y, D, (const bf16_t*)(p.ws + W_WOUTO) + (size_t)j * D * D, D, D, lds, ea, cx); return;
        case 4: rownorm_phase(p, cx, cx.MOO, p.in[I_NMPOST] + L * D, p.in[I_NFPRE] + L * D); return;
        default: break;
        }
        op -= 5;
    }
    switch (op) {
    case 0: ea.o16 = cx.G; ea.o16b = cx.U; gemm_phase<EPI_GU>(p, XN, D, (const bf16_t*)(p.ws + W_WGU) + (size_t)L * 2 * DFF * D, 2 * DFF, D, lds, ea, cx); return;
    case 1: act_phase<SAMPLE>(p, cx, L); return;
    case 2: ea.c32 = cx.FO; if (SAMPLE) ea.ksplit = 11; gemm_phase<EPI_F32>(p, cx.U, DFF, (const bf16_t*)(p.ws + W_WDN) + (size_t)L * D * DFF, D, DFF, lds, ea, cx); return;
    case 3: rownorm_phase(p, cx, cx.FO, p.in[I_NFPOST] + L * D, L < 3 ? p.in[I_NMPRE] + (L + 1) * D : nullptr); return;
    default: return;
    }
}

__global__ void __launch_bounds__(NT, 2) mega(P p_arg) {
    __shared__ __attribute__((aligned(16))) char lds[LDS_BYTES];
    cg::grid_group grid = cg::this_grid();
    const P& p = *(const P*)__builtin_amdgcn_kernarg_segment_ptr();
    __shared__ uint4 xb_words, xb_words2;
    unsigned* bar = (unsigned*)(p.ws + W_BAR);
    if (threadIdx.x == 0) { xb_words = make_uint4(0u, 0u, 0u, 0u); xb_words2 = make_uint4(0u, 0u, 0u, 0u); }
    __syncthreads();
    XcdBarrier xb = xcd_barrier_post(bar, (volatile LAS unsigned*)&xb_words, gridDim.x);
    p0_phase(p, lds);
    if (p.ws == nullptr) grid.sync();
    xcd_barrier(xb);
    Chains ch;
    {
        char* AR = p.ws + W_AR; char* SA = p.ws + W_SAMP;
        Ctx& m = ch.main;
        m.Z = (bf16_t*)(AR + A_Z); m.LR = (bf16_t*)(AR + A_LR); m.WAG = (bf16_t*)(AR + A_WAG); m.OA = (bf16_t*)(AR + A_OA); m.ZU = (bf16_t*)(AR + A_ZU); m.Y = (bf16_t*)(AR + A_Y);
        m.G = (bf16_t*)(AR + A_G); m.U = (bf16_t*)(AR + A_U); m.MOE = (float*)(AR + A_Z); m.MOO = (float*)(AR + A_MO_ODD); m.FO = (float*)(AR + A_G);
        m.r0 = 0; m.r1 = MP; m.bid = blockIdx.x; m.nb = gridDim.x;
        Ctx& q = ch.samp;
        q.Z = (bf16_t*)(SA + S_Z) - (size_t)MP * EP; q.LR = (bf16_t*)(SA + S_LR) - (size_t)MP * 256; q.WAG = (bf16_t*)(SA + S_WAG) - (size_t)MP * 1536; q.OA = (bf16_t*)(SA + S_OA) - (size_t)MP * D;
        q.ZU = (bf16_t*)(SA + S_ZU) - (size_t)MP * 2048; q.Y = (bf16_t*)(SA + S_Y) - (size_t)MP * D; q.G = (bf16_t*)(SA + S_G) - (size_t)MP * DFF; q.U = (bf16_t*)(SA + S_U) - (size_t)MP * DFF;
        q.MOE = (float*)(SA + S_MO) - (size_t)MP * D; q.MOO = q.MOE; q.FO = q.MOE;
        q.r0 = MP; q.r1 = M; q.bid = (int)blockIdx.x - SCAN_BLOCKS; q.nb = (int)gridDim.x - SCAN_BLOCKS;
        if ((int)blockIdx.x >= SCAN_BLOCKS) ch.sb = xcd_barrier_post(bar + 4096, (volatile LAS unsigned*)&xb_words2, gridDim.x - SCAN_BLOCKS);
        else { ch.sb.bar = bar + 4096; ch.sb.x = 0; ch.sb.st = (volatile LAS unsigned*)&xb_words2; ch.sb.G = 1; }
    }
#pragma unroll 1
    for (int L = 0; L < 4; ++L) {
        const int nops = (L & 1) ? 9 : 12;
#pragma unroll 1
        for (int op = 0; op < nops; ++op) {
            const bool ev = !(L & 1);
            run_op<false>(p, ch, L, (ev && op >= 4) ? op - 1 : op, lds, (ev && op == 4) ? 2 : 1);
            if (!(L == 3 && op == nops - 1)) xcd_barrier(xb);
        }
    }
}

extern "C" void kernel_launch(void* const* d_in, const int* in_sizes, int n_in, void* d_out, int out_size, void* d_ws, size_t ws_size, hipStream_t stream) {
    static int grid_blocks = 0;
    if (!grid_blocks) {
        if (n_in != N_IN || (size_t)out_size != O_END || ws_size < WS_NEED) {
            fprintf(stderr, "kernel_launch: unexpected shapes: n_in %d out %d (want %zu) ws %zu (need %zu)\n", n_in, out_size, (size_t)O_END, ws_size, (size_t)WS_NEED);
            if (ws_size < WS_NEED) return;
        }
        int dev = 0, cus = 0, per_cu = 0;
        hipGetDevice(&dev);
        hipDeviceGetAttribute(&cus, hipDeviceAttributeMultiprocessorCount, dev);
        hipOccupancyMaxActiveBlocksPerMultiprocessor(&per_cu, mega, NT, 0);
        if (per_cu > 2) per_cu = 2;
        if (per_cu < 1) per_cu = 1;
        grid_blocks = cus * per_cu;
        if (grid_blocks != 512) { fprintf(stderr, "kernel_launch: this kernel's phase program is laid out for 512 resident workgroups (256 CUs x 2); the device offers %d: nothing launched\n", grid_blocks); grid_blocks = -1; }
        fprintf(stderr, "kernel_launch: cus %d per_cu %d grid %d ws_need %zu ws %zu\n", cus, per_cu, grid_blocks, (size_t)WS_NEED, ws_size);
    }
    if (grid_blocks < 0) return;
    P p{};
    for (int i = 0; i < N_IN; ++i) p.in[i] = (const float*)d_in[i];
    p.out = (float*)d_out; p.ws = (char*)d_ws;
    void* args[] = {&p};
    if (hipMemsetAsync((char*)d_ws + W_BAR, 0, 32768, stream) != hipSuccess) fprintf(stderr, "kernel_launch: memset of the barrier words failed\n");
    hipError_t e = hipLaunchCooperativeKernel((void*)mega, dim3(grid_blocks), dim3(NT), args, 0, stream);
    if (e != hipSuccess) fprintf(stderr, "cooperative launch failed: %s (grid %d)\n", hipGetErrorString(e), grid_blocks);
}
```

```cpp
#include <hip/hip_runtime.h>
#include <hip/hip_cooperative_groups.h>
#include <cstdio>
namespace cg = cooperative_groups;

typedef unsigned short bf16_t;
typedef short bf16x8 __attribute__((ext_vector_type(8)));
typedef float f32x16 __attribute__((ext_vector_type(16)));

#ifndef REP
#define REP 0
#endif
constexpr int NT = 256;
constexpr int D = 1024, SEQ = 8192, NBAT = 2, MP = NBAT * SEQ, MS = 128, M = MP + MS;
constexpr int EP = 2560, DFF = 2816, ZBW = 1792;
constexpr int LDS_BYTES = 73728;

enum { I_XP = 0, I_XS, I_CK, I_CV, I_WKV, I_SHIFT, I_CONV, I_NMPRE, I_NMPOST, I_NFPRE, I_NFPOST, I_WINE, I_SINK, I_MU, I_W0, I_W2, I_A0, I_A2, I_G2,
       I_KK, I_KA, I_RK, I_GNG, I_GNB, I_WOUTE, I_WINO, I_LNG, I_LNB, I_SGUW, I_SGUB, I_WOUTO, I_WG, I_WU, I_CW, I_CB, I_WD, N_IN };
constexpr size_t O_YP = 0, O_YS = O_YP + (size_t)MP * D, O_WKP = O_YS + (size_t)MS * D, O_WVP = O_WKP + 2 * 2 * 128 * 128, O_WKS = O_WVP + 2 * 2 * 128 * 128,
                 O_WVS = O_WKS + 2 * 128 * 128, O_SP = O_WVS + 2 * 128 * 128, O_SS = O_SP + 2 * 2 * 8 * 4096, O_SHP = O_SS + (size_t)2 * 128 * 8 * 4096,
                 O_SHS = O_SHP + 2 * 2 * ZBW, O_SGV = O_SHS + 2 * 128 * ZBW, O_CP = O_SGV + 2 * 128 * 1024, O_CS = O_CP + 4 * 2 * 2 * DFF, O_END = O_CS + (size_t)4 * 128 * 2 * DFF;
constexpr size_t al(size_t x) { return (x + 255) & ~(size_t)255; }
constexpr size_t W_WINE = 0, W_WOUTE = W_WINE + (size_t)2 * EP * D * 2, W_WINO = W_WOUTE + (size_t)2 * D * D * 2, W_WOUTO = W_WINO + (size_t)2 * 2048 * D * 2,
                 W_WGU = W_WOUTO + (size_t)2 * D * D * 2, W_WDN = W_WGU + (size_t)4 * 2 * DFF * D * 2, W_WLR = W_WDN + (size_t)4 * D * DFF * 2,
                 W_TRIL = W_WLR + (size_t)2 * 1536 * 256 * 2, W_ROPE = W_TRIL + (size_t)2 * 8 * 128 * 128 * 2, W_XN = al(W_ROPE + (size_t)8193 * 32 * 2 * 4),
                 W_AR = al(W_XN + (size_t)M * D * 2);
constexpr size_t A_Z = 0, A_LR = al(A_Z + (size_t)M * EP * 2), A_WAG = al(A_LR + (size_t)M * 256 * 2), A_OA = al(A_WAG + (size_t)M * 1536 * 2), A_EVEN_END = A_OA + (size_t)M * D * 2;
constexpr size_t A_ZU = 0, A_Y = al(A_ZU + (size_t)M * 2048 * 2), A_MO_ODD = al(A_Y + (size_t)M * D * 2);
constexpr size_t A_G = 0, A_U = al(A_G + (size_t)M * DFF * 2), A_FFN_END = A_U + (size_t)M * DFF * 2;
constexpr size_t W_BAR = al(W_AR + A_FFN_END);
constexpr size_t W_SAMP = W_BAR + 32768;
constexpr size_t S_Z = 0, S_LR = S_Z + (size_t)MS * EP * 2, S_WAG = S_LR + (size_t)MS * 256 * 2, S_OA = S_WAG + (size_t)MS * 1536 * 2, S_ZU = S_OA + (size_t)MS * D * 2,
                 S_Y = S_ZU + (size_t)MS * 2048 * 2, S_G = S_Y + (size_t)MS * D * 2, S_U = S_G + (size_t)MS * DFF * 2, S_MO = S_U + (size_t)MS * DFF * 2, S_END = S_MO + (size_t)MS * D * 4;
constexpr size_t W_SCN = al(W_SAMP + S_END);
constexpr size_t WS_NEED = W_SCN + (size_t)16 * 7 * 4096 * 4;

struct P { const float* in[N_IN]; float* out; char* ws; };
struct Ctx { bf16_t *Z, *LR, *WAG, *OA, *ZU, *Y, *G, *U; float *MOE, *MOO, *FO; int r0, r1, bid, nb; };

__device__ __forceinline__ int opaque_tid() { int t = threadIdx.x; asm volatile("" : "+v"(t)); return t; }
__device__ __forceinline__ int opaque_bid() { int t = blockIdx.x; asm volatile("" : "+s"(t)); return t; }
#define TIDX opaque_tid()
#define BIDX opaque_bid()
__device__ __forceinline__ bf16_t f2bf(float f) { unsigned u = __float_as_uint(f); u += 0x7fffu + ((u >> 16) & 1u); return (bf16_t)(u >> 16); }
__device__ __forceinline__ float bf2f(bf16_t h) { return __uint_as_float(((unsigned)h) << 16); }
__device__ __forceinline__ unsigned pk2(float a, float b) { return (unsigned)f2bf(a) | ((unsigned)f2bf(b) << 16); }
__device__ __forceinline__ float lo16(unsigned u) { return __uint_as_float(u << 16); }
__device__ __forceinline__ float hi16(unsigned u) { return __uint_as_float(u & 0xffff0000u); }
__device__ __forceinline__ float wave_sum(float v) {
#pragma unroll
    for (int o = 32; o > 0; o >>= 1) v += __shfl_xor(v, o);
    return v;
}
__device__ __forceinline__ float wave_max(float v) {
#pragma unroll
    for (int o = 32; o > 0; o >>= 1) v = fmaxf(v, __shfl_xor(v, o));
    return v;
}
__device__ __forceinline__ float sigmoidf_(float x) { return 1.f / (1.f + __expf(-x)); }
__device__ __forceinline__ float gelu_erf(float x) { return 0.5f * x * (1.f + erff(x * 0.70710678118654752f)); }
__device__ __forceinline__ float gelu_tanh(float x) { const float u2 = 1.5957691216057308f * (x + 0.044715f * x * x * x); return x * __frcp_rn(1.f + __expf(-u2)); }
template <int CTRL> __device__ __forceinline__ float dpp_add(float x) {
    int y = __builtin_amdgcn_update_dpp(0, __float_as_int(x), CTRL, 0xf, 0xf, false);
    return x + __int_as_float(y);
}
__device__ __forceinline__ float row16_sum(float x) {
    x = dpp_add<0xB1>(x); x = dpp_add<0x4E>(x); x = dpp_add<0x141>(x); x = dpp_add<0x140>(x); return x;
}


#define XB_TMO      128
#define XB_XCNT(j)  (256  + 64 * (j))
#define XB_XSUB(j)  (1280 + 64 * (j))
#define XB_XGEN(j)  (2304 + 64 * (j))
#define XB_TOP      3328
#define XB_TOPGEN   3392
#define XCD_BAR_WORDS 3456
#define XB_SPIN_CAP (1u << 20)
#define LAS __attribute__((address_space(3)))
__device__ __forceinline__ unsigned xb_ld(unsigned* p)              { return __hip_atomic_load(p, __ATOMIC_RELAXED, __HIP_MEMORY_SCOPE_AGENT); }
__device__ __forceinline__ unsigned xb_add(unsigned* p, unsigned v) { return __hip_atomic_fetch_add(p, v, __ATOMIC_RELAXED, __HIP_MEMORY_SCOPE_AGENT); }
__device__ __forceinline__ unsigned xb_xcc_id() { return (unsigned)__builtin_amdgcn_s_getreg((3 << 11) | 20) & 0xFu; }
#define XB_SPIN(cond, bar) do { unsigned _sp = 0; while (cond) { __builtin_amdgcn_s_sleep(1); \
    if ((++_sp & 255u) == 0u) { if (xb_ld(&(bar)[XB_TMO])) break; if (_sp > XB_SPIN_CAP) { atomicAdd(&(bar)[XB_TMO], 1u); break; } } } } while (0)
struct XcdBarrier { unsigned* bar; unsigned x; volatile LAS unsigned* st; unsigned G; };
__device__ __forceinline__ XcdBarrier xcd_barrier_post(unsigned* bar, volatile LAS unsigned* st, unsigned G) {
    XcdBarrier b; b.bar = bar; b.x = xb_xcc_id(); b.st = st; b.G = G;
    if (threadIdx.x == 0) (void)xb_add(&bar[XB_XCNT(b.x)], 1u);
    return b;
}
__device__ __forceinline__ void xcd_barrier_complete(unsigned* bar, unsigned x, unsigned G, unsigned& nloc, unsigned& nx) {
    unsigned sum, cnt, mine, sp = 0u;
    for (;;) {
        sum = 0u; cnt = 0u; mine = 0u;
#pragma unroll
        for (unsigned j = 0; j < 16; ++j) { const unsigned c = xb_ld(&bar[XB_XCNT(j)]); sum += c; cnt += (c > 0u) ? 1u : 0u; mine = (j == x) ? c : mine; }
        if (sum == G) break;
        __builtin_amdgcn_s_sleep(1);
        if ((++sp & 255u) == 0u) { if (xb_ld(&bar[XB_TMO])) break; if (sp > XB_SPIN_CAP) { atomicAdd(&bar[XB_TMO], 1u); break; } }
    }
    nloc = mine > 0u ? mine : 1u; nx = cnt > 0u ? cnt : 1u;
}
__device__ __forceinline__ void xcd_barrier(const XcdBarrier& b) {
    asm volatile("s_waitcnt vmcnt(0)" ::: "memory");
    __syncthreads();
    if (threadIdx.x == 0) {
        unsigned* bar = b.bar;
        __builtin_amdgcn_s_waitcnt(0);
        unsigned nloc = b.st[0], nx = b.st[1];
        if (nloc == 0u) { xcd_barrier_complete(bar, b.x, b.G, nloc, nx); b.st[0] = nloc; b.st[1] = nx; }
        const unsigned old = xb_add(&bar[XB_XSUB(b.x)], 1u);
        const unsigned gen = old / nloc;
        if (old + 1u == (gen + 1u) * nloc) {
            __builtin_amdgcn_fence(__ATOMIC_RELEASE, "agent");
            asm volatile("s_waitcnt vmcnt(0)" ::: "memory");
            const unsigned og = xb_add(&bar[XB_TOP], 1u);
            const unsigned tg = og / nx;
            if (og + 1u == (tg + 1u) * nx) xb_add(&bar[XB_TOPGEN], 1u);
            else XB_SPIN(xb_ld(&bar[XB_TOPGEN]) == tg, bar);
            __builtin_amdgcn_fence(__ATOMIC_ACQUIRE, "agent");
            xb_add(&bar[XB_XGEN(b.x)], 1u);
            asm volatile("s_waitcnt vmcnt(0)" ::: "memory");
        } else {
            XB_SPIN(xb_ld(&bar[XB_XGEN(b.x)]) == gen, bar);
            __builtin_amdgcn_fence(__ATOMIC_ACQUIRE, "agent");
            asm volatile("s_waitcnt vmcnt(0)" ::: "memory");
        }
    }
    __syncthreads();
}

__device__ __forceinline__ void rownorm_store(const float (&hv)[16], const float* g, bf16_t* xnrow, int lane) {
    float ss = 0.f;
#pragma unroll
    for (int e = 0; e < 16; ++e) ss += hv[e] * hv[e];
    ss = wave_sum(ss);
    const float rs = rsqrtf(ss * (1.f / D) + 1e-6f);
#pragma unroll
    for (int q = 0; q < 4; ++q) {
        const int c = lane * 4 + 256 * q;
        const float4 gv = *(const float4*)(g + c);
        uint2 o; o.x = pk2(hv[4 * q] * rs * gv.x, hv[4 * q + 1] * rs * gv.y); o.y = pk2(hv[4 * q + 2] * rs * gv.z, hv[4 * q + 3] * rs * gv.w);
        *(uint2*)(xnrow + c) = o;
    }
}

__device__ __forceinline__ void p0_phase(const P& p, char* lds) {
    const int tid = TIDX, lane = tid & 63, wave = tid >> 6;
    float* tl = (float*)lds;
    constexpr int TR_ITEMS = 11776;
    for (int it = BIDX; it < TR_ITEMS; it += gridDim.x) {
        const float* src; bf16_t* dst; int K, N; int r = it;
        if (r < 1280) { int jl = r / 640; r %= 640; src = p.in[I_WINE] + (size_t)jl * D * EP; dst = (bf16_t*)(p.ws + W_WINE) + (size_t)jl * EP * D; K = D; N = EP; }
        else if ((r -= 1280) < 512) { int jl = r / 256; r %= 256; src = p.in[I_WOUTE] + (size_t)jl * D * D; dst = (bf16_t*)(p.ws + W_WOUTE) + (size_t)jl * D * D; K = D; N = D; }
        else if ((r -= 512) < 1024) { int jl = r / 512; r %= 512; src = p.in[I_WINO] + (size_t)jl * D * 2048; dst = (bf16_t*)(p.ws + W_WINO) + (size_t)jl * 2048 * D; K = D; N = 2048; }
        else if ((r -= 1024) < 512) { int jl = r / 256; r %= 256; src = p.in[I_WOUTO] + (size_t)jl * D * D; dst = (bf16_t*)(p.ws + W_WOUTO) + (size_t)jl * D * D; K = D; N = D; }
        else if ((r -= 512) < 2816) { int L = r / 704; r %= 704; src = p.in[I_WG] + (size_t)L * D * DFF; dst = (bf16_t*)(p.ws + W_WGU) + (size_t)L * 2 * DFF * D; K = D; N = DFF; }
        else if ((r -= 2816) < 2816) { int L = r / 704; r %= 704; src = p.in[I_WU] + (size_t)L * D * DFF; dst = (bf16_t*)(p.ws + W_WGU) + (size_t)L * 2 * DFF * D + (size_t)DFF * D; K = D; N = DFF; }
        else { r -= 2816; int L = r / 704; r %= 704; src = p.in[I_WD] + (size_t)L * DFF * D; dst = (bf16_t*)(p.ws + W_WDN) + (size_t)L * D * DFF; K = DFF; N = D; }
        const int nb = N / 64, k0 = (r / nb) * 64, n0 = (r % nb) * 64;
#pragma unroll
        for (int q = 0; q < 4; ++q) {
            const int row = (tid >> 4) + 16 * q, c4 = (tid & 15) * 4;
            const float4 v = *(const float4*)(src + (size_t)(k0 + row) * N + n0 + c4);
            tl[row * 65 + c4] = v.x; tl[row * 65 + c4 + 1] = v.y; tl[row * 65 + c4 + 2] = v.z; tl[row * 65 + c4 + 3] = v.w;
        }
        __syncthreads();
#pragma unroll
        for (int q = 0; q < 2; ++q) {
            const int ch = tid + 256 * q, n = ch >> 3, k8 = ch & 7;
            uint4 o;
            o.x = pk2(tl[(k8 * 8 + 0) * 65 + n], tl[(k8 * 8 + 1) * 65 + n]); o.y = pk2(tl[(k8 * 8 + 2) * 65 + n], tl[(k8 * 8 + 3) * 65 + n]);
            o.z = pk2(tl[(k8 * 8 + 4) * 65 + n], tl[(k8 * 8 + 5) * 65 + n]); o.w = pk2(tl[(k8 * 8 + 6) * 65 + n], tl[(k8 * 8 + 7) * 65 + n]);
            *(uint4*)(dst + (size_t)(n0 + n) * K + k0 + k8 * 8) = o;
        }
        __syncthreads();
    }
    const int gt = BIDX * NT + tid, gs = gridDim.x * NT;
    {
        bf16_t* wlr = (bf16_t*)(p.ws + W_WLR);
        for (int e = gt; e < 2 * 1536 * 256; e += gs) {
            const int jl = e / (1536 * 256), n = (e / 256) % 1536, k = e & 255;
            float v = 0.f;
            if (n < 512) { if (k < 64) v = p.in[I_W2][(size_t)jl * 64 * 512 + k * 512 + n]; }
            else if (n < 1024) { if (k >= 64 && k < 128) v = p.in[I_A2][(size_t)jl * 64 * 512 + (k - 64) * 512 + (n - 512)]; }
            else { if (k >= 128) v = p.in[I_G2][(size_t)jl * 128 * 512 + (k - 128) * 512 + (n - 1024)]; }
            wlr[e] = f2bf(v);
        }
        bf16_t* tr = (bf16_t*)(p.ws + W_TRIL);
        for (int e = gt; e < 2 * 8 * 128 * 128; e += gs) { const int t = (e >> 7) & 127, s = e & 127; tr[e] = f2bf(s <= t ? p.in[I_SGUW][e] : 0.f); }
        float* rope = (float*)(p.ws + W_ROPE);
        for (int e = gt; e < 8193 * 32; e += gs) {
            const int pos = e >> 5, i = e & 31;
            double inv = 1.0; for (int q = 0; q < i; ++q) inv *= 0.7498942093324559;
            double x = (double)pos * inv;
            const double TWO_PI = 6.283185307179586;
            double n = rint(x / TWO_PI); x -= n * TWO_PI;
            double qd = rint(x / 1.5707963267948966); double r = x - qd * 1.5707963267948966; int qi = ((int)qd) & 3;
            double r2 = r * r;
            double sn = r * (1.0 + r2 * (-1.0 / 6 + r2 * (1.0 / 120 + r2 * (-1.0 / 5040 + r2 * (1.0 / 362880 + r2 * (-1.0 / 39916800 + r2 * (1.0 / 6227020800.0)))))));
            double cs = 1.0 + r2 * (-0.5 + r2 * (1.0 / 24 + r2 * (-1.0 / 720 + r2 * (1.0 / 40320 + r2 * (-1.0 / 3628800 + r2 * (1.0 / 479001600.0))))));
            double c, s;
            if (qi == 0) { c = cs; s = sn; } else if (qi == 1) { c = -sn; s = cs; } else if (qi == 2) { c = -cs; s = -sn; } else { c = sn; s = -cs; }
            rope[e] = (float)c; rope[8193 * 32 + e] = (float)s;
        }
    }
    for (int row = BIDX * 4 + wave; row < M; row += gridDim.x * 4) {
        const float* xr = row < MP ? p.in[I_XP] + (size_t)row * D : p.in[I_XS] + (size_t)(row - MP) * D;
        float hv[16];
#pragma unroll
        for (int q = 0; q < 4; ++q) { const float4 v = *(const float4*)(xr + lane * 4 + 256 * q); hv[4 * q] = v.x; hv[4 * q + 1] = v.y; hv[4 * q + 2] = v.z; hv[4 * q + 3] = v.w; }
        rownorm_store(hv, p.in[I_NMPRE], (bf16_t*)(p.ws + W_XN) + (size_t)row * D, lane);
    }
}

typedef float f32x4v __attribute__((ext_vector_type(4)));
__device__ __forceinline__ void rownorm_phase(const P& p, const Ctx& cx, const float* mo, const float* gpost, const float* gnext, bool first = false) {
    const int lane = TIDX & 63, wave = TIDX >> 6;
    const int stride = cx.nb * 4;
    f32x4v gp[4], gn[4];
#pragma unroll
    for (int q = 0; q < 4; ++q) { gp[q] = *(const f32x4v*)(gpost + lane * 4 + 256 * q); gn[q] = gnext ? *(const f32x4v*)(gnext + lane * 4 + 256 * q) : (f32x4v){0.f, 0.f, 0.f, 0.f}; }
    for (int row = cx.r0 + cx.bid * 4 + wave; row < cx.r1; row += 2 * stride) {
        const int rowb = row + stride; const bool hasb = rowb < cx.r1; const int rb = hasb ? rowb : row;
        f32x4v ma[4], ha[4], mb[4], hb[4];
        float* hra = p.out + (size_t)row * D + lane * 4; float* hrb = p.out + (size_t)rb * D + lane * 4;
#pragma unroll
        for (int q = 0; q < 4; ++q) { ma[q] = *(const f32x4v*)(mo + (size_t)row * D + lane * 4 + 256 * q); mb[q] = *(const f32x4v*)(mo + (size_t)rb * D + lane * 4 + 256 * q); }
        const float* hsa = first ? (row < MP ? p.in[I_XP] + (size_t)row * D : p.in[I_XS] + (size_t)(row - MP) * D) + lane * 4 : hra;
        const float* hsb = first ? (rb < MP ? p.in[I_XP] + (size_t)rb * D : p.in[I_XS] + (size_t)(rb - MP) * D) + lane * 4 : hrb;
#pragma unroll
        for (int q = 0; q < 4; ++q) { ha[q] = *(const f32x4v*)(hsa + 256 * q); hb[q] = *(const f32x4v*)(hsb + 256 * q); }
        float sa = 0.f, sb = 0.f;
#pragma unroll
        for (int q = 0; q < 4; ++q) { const f32x4v a2 = ma[q] * ma[q], b2 = mb[q] * mb[q]; sa += (a2.x + a2.y) + (a2.z + a2.w); sb += (b2.x + b2.y) + (b2.z + b2.w); }
#pragma unroll
        for (int o = 32; o > 0; o >>= 1) { sa += __shfl_xor(sa, o); sb += __shfl_xor(sb, o); }
        const float rsa = rsqrtf(sa * (1.f / D) + 1e-6f), rsb = rsqrtf(sb * (1.f / D) + 1e-6f);
        float ta = 0.f, tb = 0.f;
#pragma unroll
        for (int q = 0; q < 4; ++q) {
            ha[q] = ha[q] + ma[q] * rsa * gp[q]; hb[q] = hb[q] + mb[q] * rsb * gp[q];
            *(f32x4v*)(hra + 256 * q) = ha[q]; if (hasb) *(f32x4v*)(hrb + 256 * q) = hb[q];
            const f32x4v a2 = ha[q] * ha[q], b2 = hb[q] * hb[q]; ta += (a2.x + a2.y) + (a2.z + a2.w); tb += (b2.x + b2.y) + (b2.z + b2.w);
        }
        if (gnext) {
#pragma unroll
            for (int o = 32; o > 0; o >>= 1) { ta += __shfl_xor(ta, o); tb += __shfl_xor(tb, o); }
            const float ra = rsqrtf(ta * (1.f / D) + 1e-6f), rbb = rsqrtf(tb * (1.f / D) + 1e-6f);
            bf16_t* xa = (bf16_t*)(p.ws + W_XN) + (size_t)row * D + lane * 4; bf16_t* xb = (bf16_t*)(p.ws + W_XN) + (size_t)rb * D + lane * 4;
#pragma unroll
            for (int q = 0; q < 4; ++q) {
                const f32x4v ya = ha[q] * ra * gn[q], yb = hb[q] * rbb * gn[q];
                uint2 oa; oa.x = pk2(ya.x, ya.y); oa.y = pk2(ya.z, ya.w); *(uint2*)(xa + 256 * q) = oa;
                if (hasb) { uint2 ob; ob.x = pk2(yb.x, yb.y); ob.y = pk2(yb.z, yb.w); *(uint2*)(xb + 256 * q) = ob; }
            }
        }
    }
}

constexpr int BM = 128, BN = 128, BK = 64, LROW = 144  , OPB = 128 * LROW  , STG = 2 * OPB;
enum { EPI_F32 = 0, EPI_EVENIN, EPI_LR, EPI_GU, EPI_ODDIN };
struct EA { float* c32; bf16_t* o16; bf16_t* o16b; int layer; int ksplit; };

template <int EPI>
__device__ __forceinline__ void gemm_epilogue(const P& p, const f32x16 (&acc)[2][2], int m0, int n0, int wm, int wn, int lane, const EA& ea, int N) {
    const int h = lane >> 5, lr = lane & 31;
    const int jl = ea.layer >> 1;
#pragma unroll
    for (int i = 0; i < 2; ++i) {
        const int m = m0 + wm * 64 + i * 32 + lr;
        const int hb = n0 + wn * 64;
        float v[2][16];
#pragma unroll
        for (int j = 0; j < 2; ++j)
#pragma unroll
            for (int e = 0; e < 16; ++e) v[j][e] = acc[i][j][e];
        if (EPI == EPI_EVENIN) {
            const bool prompt = m < MP; const int t = m & (SEQ - 1), b = m >> 13, bs = m - MP;
            if (hb < 640) {
                const int pos = prompt ? t : SEQ;
                const float* rc = (const float*)(p.ws + W_ROPE) + (size_t)pos * 32; const float* rsn = rc + 8193 * 32;
#pragma unroll
                for (int g = 0; g < 4; ++g) {
                    const float4 c4 = *(const float4*)(rc + 8 * g + 4 * h), s4 = *(const float4*)(rsn + 8 * g + 4 * h);
                    const float cc[4] = {c4.x, c4.y, c4.z, c4.w}, sn[4] = {s4.x, s4.y, s4.z, s4.w};
#pragma unroll
                    for (int e = 0; e < 4; ++e) { const float x1 = v[0][4 * g + e], x2 = v[1][4 * g + e]; v[0][4 * g + e] = x1 * cc[e] - x2 * sn[e]; v[1][4 * g + e] = x2 * cc[e] + x1 * sn[e]; }
                }
            }
#pragma unroll
            for (int j = 0; j < 2; ++j)
#pragma unroll
                for (int g = 0; g < 4; ++g) {
                    const int dc = j * 32 + 8 * g + 4 * h;
                    uint2 o; o.x = pk2(v[j][4 * g], v[j][4 * g + 1]); o.y = pk2(v[j][4 * g + 2], v[j][4 * g + 3]);
                    *(uint2*)(ea.o16 + (size_t)m * EP + hb + dc) = o;
                    const float4 f4 = make_float4(v[j][4 * g], v[j][4 * g + 1], v[j][4 * g + 2], v[j][4 * g + 3]);
                    if (hb >= 512 && hb < 768) {
                        const int kvh = ((hb - 512) >> 6) & 1; const bool isv = hb >= 640;
                        if (prompt) { if (t >= SEQ - 128) *(float4*)(p.out + (isv ? O_WVP : O_WKP) + ((size_t)((jl * 2 + b) * 128 + (t - (SEQ - 128))) * 2 + kvh) * 64 + dc) = f4; }
                        else *(float4*)(p.out + (isv ? O_WVS : O_WKS) + ((size_t)(jl * 128 + bs) * 2 + kvh) * 64 + dc) = f4;
                    } else if (hb >= 768) {
                        const int zc = hb - 768 + dc;
                        if (prompt) { if (t == SEQ - 1) *(float4*)(p.out + O_SHP + (size_t)(jl * 2 + b) * ZBW + zc) = f4; }
                        else {
                            *(float4*)(p.out + O_SHS + (size_t)(jl * 128 + bs) * ZBW + zc) = f4;
                            if (zc >= 1536) {
                                const float4 pv = *(const float4*)(p.in[I_SHIFT] + (size_t)(jl * 128 + bs) * ZBW + zc), mu4 = *(const float4*)(p.in[I_MU] + jl * ZBW + zc);
                                const float pr[4] = {pv.x, pv.y, pv.z, pv.w}, mm[4] = {mu4.x, mu4.y, mu4.z, mu4.w}; float lo[4];
                                const int c = zc - 1536;
                                const float vq[4] = {f4.x, f4.y, f4.z, f4.w};
#pragma unroll
                                for (int e = 0; e < 4; ++e) { const float zs = vq[e] + (pr[e] - vq[e]) * mm[e]; lo[e] = c < 64 ? tanhf(zs) : (c < 128 ? zs : sigmoidf_(zs)); }
                                uint2 ol; ol.x = pk2(lo[0], lo[1]); ol.y = pk2(lo[2], lo[3]);
                                *(uint2*)(ea.o16b + (size_t)m * 256 + c) = ol;
                            }
                        }
                    }
                }
        } else {
#pragma unroll
            for (int j = 0; j < 2; ++j)
#pragma unroll
                for (int g = 0; g < 4; ++g) {
                    const int col = hb + j * 32 + 8 * g + 4 * h;
                    float x0 = v[j][4 * g], x1 = v[j][4 * g + 1], x2 = v[j][4 * g + 2], x3 = v[j][4 * g + 3];
                    if (EPI == EPI_F32) {
                        float* cp = ea.c32 + (size_t)m * N + col;
                        if (ea.ksplit > 1) { atomicAdd(cp, x0); atomicAdd(cp + 1, x1); atomicAdd(cp + 2, x2); atomicAdd(cp + 3, x3); }
                        else *(float4*)cp = make_float4(x0, x1, x2, x3);
                    } else if (EPI == EPI_ODDIN) {
                        uint2 o; o.x = pk2(gelu_erf(x0), gelu_erf(x1)); o.y = pk2(gelu_erf(x2), gelu_erf(x3));
                        *(uint2*)(ea.o16 + (size_t)m * 2048 + col) = o;
                    } else if (EPI == EPI_LR) {
                        float xs[4] = {x0, x1, x2, x3};
                        if (col < 512) {
                            const float4 w0 = *(const float4*)(p.in[I_W0] + jl * 512 + col); const float ww[4] = {w0.x, w0.y, w0.z, w0.w};
#pragma unroll
                            for (int e = 0; e < 4; ++e) xs[e] = -expm1f(-0.606531f * sigmoidf_(xs[e] + ww[e]));
                        } else if (col < 1024) {
                            const float4 a0 = *(const float4*)(p.in[I_A0] + jl * 512 + col - 512); const float aa[4] = {a0.x, a0.y, a0.z, a0.w};
#pragma unroll
                            for (int e = 0; e < 4; ++e) xs[e] = sigmoidf_(xs[e] + aa[e]);
                        }
                        uint2 o; o.x = pk2(xs[0], xs[1]); o.y = pk2(xs[2], xs[3]);
                        *(uint2*)(ea.o16 + (size_t)m * 1536 + col) = o;
                    } else if (EPI == EPI_GU) {
                        uint2 o; o.x = pk2(x0, x1); o.y = pk2(x2, x3);
                        if (col < DFF) {
                            *(uint2*)(ea.o16 + (size_t)m * DFF + col) = o;
                            const int L = ea.layer;
                            if (m < MP) { const int t = m & (SEQ - 1), b = m >> 13; if (t >= SEQ - 2) *(float4*)(p.out + O_CP + ((size_t)(L * 2 + b) * 2 + (t - (SEQ - 2))) * DFF + col) = make_float4(x0, x1, x2, x3); }
                            else { const int bs = m - MP; const size_t base = ((size_t)(L * 128 + bs) * 2) * DFF + col;
                                *(float4*)(p.out + O_CS + base + DFF) = make_float4(x0, x1, x2, x3);
                                *(float4*)(p.out + O_CS + base) = *(const float4*)(p.in[I_CONV] + base + DFF); }
                        } else *(uint2*)(ea.o16b + (size_t)m * DFF + col - DFF) = o;
                    }
                }
        }
    }
}

typedef unsigned u32x4 __attribute__((ext_vector_type(4)));
struct Stg { u32x4 a0, a1, a2, a3, b0, b1, b2, b3; };
__device__ __forceinline__ void stg_load(Stg& r, const bf16_t* ga, const bf16_t* gb, size_t sa, size_t sb) {
    r.a0 = *(const u32x4*)(ga); r.a1 = *(const u32x4*)(ga + sa); r.a2 = *(const u32x4*)(ga + 2 * sa); r.a3 = *(const u32x4*)(ga + 3 * sa);
    r.b0 = *(const u32x4*)(gb); r.b1 = *(const u32x4*)(gb + sb); r.b2 = *(const u32x4*)(gb + 2 * sb); r.b3 = *(const u32x4*)(gb + 3 * sb);
}
__device__ __forceinline__ void stg_store(const Stg& r, char* w) {
    *(u32x4*)(w) = r.a0; *(u32x4*)(w + 32 * LROW) = r.a1; *(u32x4*)(w + 64 * LROW) = r.a2; *(u32x4*)(w + 96 * LROW) = r.a3;
    *(u32x4*)(w + OPB) = r.b0; *(u32x4*)(w + OPB + 32 * LROW) = r.b1; *(u32x4*)(w + OPB + 64 * LROW) = r.b2; *(u32x4*)(w + OPB + 96 * LROW) = r.b3;
}
__device__ __forceinline__ void gemm_ktile(f32x16 (&acc)[2][2], const char* sA, const char* sB) {
    __builtin_amdgcn_s_setprio(1);
#pragma unroll
    for (int ks = 0; ks < 4; ++ks) {
        bf16x8 xa[2], wb[2];
#pragma unroll
        for (int i = 0; i < 2; ++i) xa[i] = *(const bf16x8*)(sA + i * 32 * LROW + ks * 32);
#pragma unroll
        for (int j = 0; j < 2; ++j) wb[j] = *(const bf16x8*)(sB + j * 32 * LROW + ks * 32);
#pragma unroll
        for (int i = 0; i < 2; ++i)
#pragma unroll
            for (int j = 0; j < 2; ++j) acc[i][j] = __builtin_amdgcn_mfma_f32_32x32x16_bf16(wb[j], xa[i], acc[i][j], 0, 0, 0);
    }
    __builtin_amdgcn_s_setprio(0);
}
template <int EPI>
__device__ __forceinline__ void gemm_phase(const P& p, const bf16_t* __restrict__ A, int lda, const bf16_t* __restrict__ Bt, int N, int K, char* lds, EA ea, const Ctx& cx) {
    const int tid = TIDX, lane = tid & 63, wave = tid >> 6, wm = wave >> 1, wn = wave & 1;
    const int ks_n = ea.ksplit, ntn = N / BN, mt0 = cx.r0 / BM, ntiles = ((cx.r1 - cx.r0) / BM) * ntn * ks_n, nk = K / BK / ks_n;
    const int lrow = tid >> 3, lc8 = tid & 7;
    const size_t sa = (size_t)32 * lda, sb = (size_t)32 * K;
    for (int tile = cx.bid; tile < ntiles; tile += cx.nb) {
        const int kpart = tile % ks_n, t2 = tile / ks_n;
        int mt, nt;
        if (cx.r0 == 0 && (cx.nb & 7) == 0) {
            const int x = cx.bid & 7, per = cx.nb >> 3, i = (cx.bid >> 3) + per * ((tile - cx.bid) / cx.nb);
            const int mi = i & 7, rest = i >> 3, nn = rest % ntn, mg = rest / ntn;
            mt = 16 * x + 8 * mg + mi; nt = nn;
        } else { mt = mt0 + t2 / ntn; nt = t2 % ntn; }
        const int m0 = mt * BM, n0 = nt * BN;
        const bf16_t* ga = A + (size_t)(m0 + lrow) * lda + lc8 * 8 + kpart * nk * BK;
        const bf16_t* gb = Bt + (size_t)(n0 + lrow) * K + lc8 * 8 + kpart * nk * BK;
        Stg r0, r1;
        stg_load(r0, ga, gb, sa, sb);
        stg_load(r1, ga + BK, gb + BK, sa, sb);
        f32x16 acc[2][2];
#pragma unroll
        for (int i = 0; i < 2; ++i)
#pragma unroll
            for (int j = 0; j < 2; ++j)
#pragma unroll
                for (int e = 0; e < 16; ++e) acc[i][j][e] = 0.f;
        char* wA = lds + lrow * LROW + lc8 * 16;
        stg_store(r0, wA);
        __syncthreads();
        const char* sA0 = lds + (wm * 64 + (lane & 31)) * LROW + (lane >> 5) * 16;
        const char* sB0 = lds + OPB + (wn * 64 + (lane & 31)) * LROW + (lane >> 5) * 16;
        for (int kt = 0; kt < nk; kt += 2) {
            if (kt + 2 < nk) stg_load(r0, ga + (kt + 2) * BK, gb + (kt + 2) * BK, sa, sb);
            __builtin_amdgcn_sched_barrier(0);
            gemm_ktile(acc, sA0, sB0);
            stg_store(r1, wA + STG);
            __syncthreads();
            if (kt + 3 < nk) stg_load(r1, ga + (kt + 3) * BK, gb + (kt + 3) * BK, sa, sb);
            __builtin_amdgcn_sched_barrier(0);
            gemm_ktile(acc, sA0 + STG, sB0 + STG);
            if (kt + 2 < nk) stg_store(r0, wA);
            __syncthreads();
        }
        gemm_epilogue<EPI>(p, acc, m0, n0, wm, wn, lane, ea, N);
    }
}

__device__ __forceinline__ void lr_phase(const P& p, const Ctx& cx, int jl) {
    const bf16_t* Z = cx.Z; bf16_t* LR = cx.LR;
    const int gt = cx.bid * NT + TIDX, gs = cx.nb * NT;
    for (int it = gt; it < (cx.r1 - cx.r0) * 32; it += gs) {
        const int m = cx.r0 + (it >> 5), c8 = it & 31, zc = 1536 + c8 * 8;
        const uint4 cur = *(const uint4*)(Z + (size_t)m * EP + 768 + zc);
        float pv[8];
        if (m < MP) {
            if ((m & (SEQ - 1)) == 0) { for (int e = 0; e < 8; ++e) pv[e] = 0.f; }
            else { const uint4 pr = *(const uint4*)(Z + (size_t)(m - 1) * EP + 768 + zc); pv[0] = lo16(pr.x); pv[1] = hi16(pr.x); pv[2] = lo16(pr.y); pv[3] = hi16(pr.y); pv[4] = lo16(pr.z); pv[5] = hi16(pr.z); pv[6] = lo16(pr.w); pv[7] = hi16(pr.w); }
        } else { const float* st = p.in[I_SHIFT] + (size_t)(jl * 128 + (m - MP)) * ZBW + zc; for (int e = 0; e < 8; ++e) pv[e] = st[e]; }
        const float cv[8] = {lo16(cur.x), hi16(cur.x), lo16(cur.y), hi16(cur.y), lo16(cur.z), hi16(cur.z), lo16(cur.w), hi16(cur.w)};
        const float* mu = p.in[I_MU] + jl * ZBW + zc;
        float o[8];
#pragma unroll
        for (int e = 0; e < 8; ++e) { const float zs = cv[e] + (pv[e] - cv[e]) * mu[e]; o[e] = c8 < 8 ? tanhf(zs) : (c8 < 16 ? zs : sigmoidf_(zs)); }
        uint4 ov; ov.x = pk2(o[0], o[1]); ov.y = pk2(o[2], o[3]); ov.z = pk2(o[4], o[5]); ov.w = pk2(o[6], o[7]);
        *(uint4*)(LR + (size_t)m * 256 + c8 * 8) = ov;
    }
}

__device__ __forceinline__ float zs_val(const P& p, const bf16_t* Z, int jl, int m, int c) {
    const float cur = bf2f(Z[(size_t)m * EP + 768 + c]);
    float prev;
    if (m < MP) prev = (m & (SEQ - 1)) == 0 ? 0.f : bf2f(Z[(size_t)(m - 1) * EP + 768 + c]);
    else prev = p.in[I_SHIFT][(size_t)(jl * 128 + (m - MP)) * ZBW + c];
    return cur + (prev - cur) * p.in[I_MU][jl * ZBW + c];
}

constexpr int TC = 32;
typedef float f32x2 __attribute__((ext_vector_type(2)));
typedef float f32x4 __attribute__((ext_vector_type(4)));
struct ScanRaw { u32x4 cr, ck, cv, pr, pk, pv, ep, av; };
__device__ __forceinline__ void scan_load(ScanRaw& R, const bf16_t* Z, const bf16_t* WAG, int m, int t, int c) {
    const bf16_t* zr = Z + (size_t)m * EP + 768;
    R.cr = *(const u32x4*)(zr + c); R.ck = *(const u32x4*)(zr + 512 + c); R.cv = *(const u32x4*)(zr + 1024 + c);
    R.pr = (u32x4){0u, 0u, 0u, 0u}; R.pk = R.pr; R.pv = R.pr;
    if (t > 0) { R.pr = *(const u32x4*)(zr - EP + c); R.pk = *(const u32x4*)(zr - EP + 512 + c); R.pv = *(const u32x4*)(zr - EP + 1024 + c); }
    R.ep = *(const u32x4*)(WAG + (size_t)m * 1536 + c); R.av = *(const u32x4*)(WAG + (size_t)m * 1536 + 512 + c);
}
constexpr int NCH = 5, SCAN_P1 = 256, SCAN_P2 = 256, SCAN_BLOCKS = 256;
__device__ __forceinline__ int chunk_begin(int c) { return c >= NCH ? SEQ : (c == 0 ? 0 : 2080 + (c - 1) * 1536); }
enum { SC_FULL = 0, SC_DUAL = 3 };
template <int mode>
__device__ __forceinline__ void scan_task(const P& p, const Ctx& cx, int jl, char* lds, int seq, int rg, int chunk) {
    const bf16_t* Z = cx.Z; const bf16_t* WAG = cx.WAG; bf16_t* OA = cx.OA;
    float* SEND0 = (float*)(p.ws + W_SCN); float* PM = SEND0 + 16 * 4096; float* LOC = PM + 16 * (NCH - 2) * 4096;
    const int b = seq >> 3, hd = seq & 7;
    const int tid = TIDX, lane = tid & 63, wave = tid >> 6;
    const int rowl = wave * 4 + (lane >> 4), row = rg * 16 + rowl, c4 = (lane & 15) * 4;
    float* sW = (float*)lds; float* sKK = sW + TC * 64; float* sBB = sKK + TC * 64; float* sK2 = sBB + TC * 64; float* sR = sK2 + TC * 64; float* sV = sR + TC * 64;
    float* sQ = sV + TC * 64;
    f32x4 x = {0.f, 0.f, 0.f, 0.f};
    f32x2 p01 = {(c4 == row) ? 1.f : 0.f, (c4 + 1 == row) ? 1.f : 0.f}, p23 = {(c4 + 2 == row) ? 1.f : 0.f, (c4 + 3 == row) ? 1.f : 0.f};
    if (mode == SC_FULL && chunk > 0) {
        x = *(const f32x4*)(SEND0 + (size_t)seq * 4096 + row * 64 + c4);
        for (int cc = 1; cc < chunk; ++cc) {
            *(f32x4*)(sQ + rowl * 64 + c4) = x;
            __syncthreads();
            const float* pm = PM + ((size_t)seq * (NCH - 2) + (cc - 1)) * 4096 + c4;
            f32x4 acc = *(const f32x4*)(LOC + ((size_t)seq * (NCH - 2) + (cc - 1)) * 4096 + row * 64 + c4);
#pragma unroll 8
            for (int j = 0; j < 64; ++j) { const float a = sQ[rowl * 64 + j]; const f32x4 pv = *(const f32x4*)(pm + j * 64); acc += pv * a; }
            __syncthreads();
            x = acc;
        }
    }
    f32x2 s01 = x.lo, s23 = x.hi;
    const int ptt = tid >> 3, pj0 = (tid & 7) * 8, pc = hd * 64 + pj0;
    const float* mu = p.in[I_MU] + jl * ZBW;
    float mur[8], muk[8], muv[8], kkw[8], kaw[8];
#pragma unroll
    for (int e = 0; e < 8; ++e) { mur[e] = mu[pc + e]; muk[e] = mu[512 + pc + e]; muv[e] = mu[1024 + pc + e]; kkw[e] = p.in[I_KK][jl * 512 + pc + e]; kaw[e] = p.in[I_KA][jl * 512 + pc + e]; }
    const int tb = chunk_begin(chunk), te = chunk_begin(chunk + 1);
    ScanRaw R;
    scan_load(R, Z, WAG, b * SEQ + tb + ptt, tb + ptt, pc);
    const float vscale = 1.f;
    for (int t0 = tb; t0 < te; t0 += TC) {
        {
            const unsigned crr[4] = {R.cr.x, R.cr.y, R.cr.z, R.cr.w}, ckk[4] = {R.ck.x, R.ck.y, R.ck.z, R.ck.w}, cvv[4] = {R.cv.x, R.cv.y, R.cv.z, R.cv.w};
            const unsigned prr[4] = {R.pr.x, R.pr.y, R.pr.z, R.pr.w}, pkk[4] = {R.pk.x, R.pk.y, R.pk.z, R.pk.w}, pv4[4] = {R.pv.x, R.pv.y, R.pv.z, R.pv.w};
            const unsigned epp[4] = {R.ep.x, R.ep.y, R.ep.z, R.ep.w}, avv[4] = {R.av.x, R.av.y, R.av.z, R.av.w};
            float rr[8], kx[8], vx[8], kkr[8], aa[8], ee[8]; float ssq = 0.f;
#pragma unroll
            for (int e = 0; e < 8; ++e) {
                const int w_ = e >> 1; const bool hi = e & 1;
                const float r_c = hi ? hi16(crr[w_]) : lo16(crr[w_]), r_p = hi ? hi16(prr[w_]) : lo16(prr[w_]);
                const float k_c = hi ? hi16(ckk[w_]) : lo16(ckk[w_]), k_p = hi ? hi16(pkk[w_]) : lo16(pkk[w_]);
                const float v_c = hi ? hi16(cvv[w_]) : lo16(cvv[w_]), v_p = hi ? hi16(pv4[w_]) : lo16(pv4[w_]);
                rr[e] = r_c + (r_p - r_c) * mur[e]; kx[e] = k_c + (k_p - k_c) * muk[e]; vx[e] = (v_c + (v_p - v_c) * muv[e]) * vscale;
                ee[e] = hi ? hi16(epp[w_]) : lo16(epp[w_]); aa[e] = hi ? hi16(avv[w_]) : lo16(avv[w_]);
                kkr[e] = kx[e] * kkw[e]; ssq += kkr[e] * kkr[e];
            }
            ssq += __shfl_xor(ssq, 1); ssq += __shfl_xor(ssq, 2); ssq += __shfl_xor(ssq, 4);
            const float inv = 1.f / fmaxf(sqrtf(ssq), 1e-12f);
            float ow[8], okk[8], obb[8], ok2[8];
#pragma unroll
            for (int e = 0; e < 8; ++e) { const float kkn = kkr[e] * inv; ow[e] = 1.f - ee[e]; okk[e] = kkn; obb[e] = kkn * aa[e]; ok2[e] = kx[e] * (1.f + (aa[e] - 1.f) * kaw[e]); }
            const int o = ptt * 64 + pj0;
            *(float4*)(sW + o) = make_float4(ow[0], ow[1], ow[2], ow[3]); *(float4*)(sW + o + 4) = make_float4(ow[4], ow[5], ow[6], ow[7]);
            *(float4*)(sKK + o) = make_float4(okk[0], okk[1], okk[2], okk[3]); *(float4*)(sKK + o + 4) = make_float4(okk[4], okk[5], okk[6], okk[7]);
            *(float4*)(sBB + o) = make_float4(obb[0], obb[1], obb[2], obb[3]); *(float4*)(sBB + o + 4) = make_float4(obb[4], obb[5], obb[6], obb[7]);
            *(float4*)(sK2 + o) = make_float4(ok2[0], ok2[1], ok2[2], ok2[3]); *(float4*)(sK2 + o + 4) = make_float4(ok2[4], ok2[5], ok2[6], ok2[7]);
            *(float4*)(sR + o) = make_float4(rr[0], rr[1], rr[2], rr[3]); *(float4*)(sR + o + 4) = make_float4(rr[4], rr[5], rr[6], rr[7]);
            *(float4*)(sV + o) = make_float4(vx[0], vx[1], vx[2], vx[3]); *(float4*)(sV + o + 4) = make_float4(vx[4], vx[5], vx[6], vx[7]);
        }
        __syncthreads();
        if (t0 + TC < te) scan_load(R, Z, WAG, b * SEQ + t0 + TC + ptt, t0 + TC + ptt, pc);
        {
            const float* base = sW + c4;
            float* qdst = ((lane & 3) == 0) ? (sQ + rowl * 4 + ((lane & 15) >> 2)) : (sQ + TC * 64 + lane);
            const int qstep = ((lane & 3) == 0) ? 64 : 0;
            const float* vb = sV + row;
            f32x4 kk = *(const f32x4*)(base + TC * 64), w = *(const f32x4*)(base), bb = *(const f32x4*)(base + 2 * TC * 64), k2 = *(const f32x4*)(base + 3 * TC * 64), r = *(const f32x4*)(base + 4 * TC * 64);
            float vi = vb[0];
            f32x4 kk1 = *(const f32x4*)(base + TC * 64 + 64), w1 = *(const f32x4*)(base + 64), bb1 = *(const f32x4*)(base + 2 * TC * 64 + 64), k21 = *(const f32x4*)(base + 3 * TC * 64 + 64), r1 = *(const f32x4*)(base + 4 * TC * 64 + 64);
            float vi1 = vb[64];
#pragma unroll 16
            for (int tt = 0; tt < TC; ++tt) {
                const int tn = (tt + 2 < TC) ? tt + 2 : TC - 1;
                const f32x4 nkk = *(const f32x4*)(base + TC * 64 + tn * 64), nw = *(const f32x4*)(base + tn * 64), nbb = *(const f32x4*)(base + 2 * TC * 64 + tn * 64),
                            nk2 = *(const f32x4*)(base + 3 * TC * 64 + tn * 64), nr = *(const f32x4*)(base + 4 * TC * 64 + tn * 64);
                const float nvi = vb[tn * 64];
                const f32x2 viv = {vi, vi};
                const f32x2 tp = s01 * kk.lo + s23 * kk.hi;
                float pp = tp.x + tp.y;
                const f32x2 t01 = s01 * w.lo + viv * k2.lo, t23 = s23 * w.hi + viv * k2.hi;
                if (mode == SC_DUAL) {
                    const f32x2 tq = p01 * kk.lo + p23 * kk.hi;
                    float pq = tq.x + tq.y;
                    const f32x2 u01 = p01 * w.lo, u23 = p23 * w.hi;
                    pq = row16_sum(pq);
                    const f32x2 sap = {-pq, -pq};
                    p01 = sap * bb.lo + u01; p23 = sap * bb.hi + u23;
                }
                pp = row16_sum(pp);
                const f32x2 sav = {-pp, -pp};
                s01 = sav * bb.lo + t01; s23 = sav * bb.hi + t23;
                if (mode == SC_FULL) {
                    const f32x2 uq = s01 * r.lo + s23 * r.hi;
                    float q = uq.x + uq.y;
                    q = dpp_add<0xB1>(q); q = dpp_add<0x4E>(q);
                    qdst[tt * qstep] = q;
                }
                kk = kk1; w = w1; bb = bb1; k2 = k21; r = r1; vi = vi1;
                kk1 = nkk; w1 = nw; bb1 = nbb; k21 = nk2; r1 = nr; vi1 = nvi;
            }
        }
        __syncthreads();
        if (mode == SC_FULL) {
            const int tt = tid >> 3, r2 = (tid & 7) * 2; const int m = b * SEQ + t0 + tt;
            const float4 qa = *(const float4*)(sQ + (tt * 16 + r2) * 4), qb = *(const float4*)(sQ + (tt * 16 + r2 + 1) * 4);
            *(unsigned*)(OA + (size_t)m * D + 512 + hd * 64 + rg * 16 + r2) = pk2((qa.x + qa.y) + (qa.z + qa.w), (qb.x + qb.y) + (qb.z + qb.w));
        }
    }
    const f32x4 fin = {s01.x, s01.y, s23.x, s23.y};
    if (mode == SC_FULL) {
        if (chunk == 0) *(f32x4*)(SEND0 + (size_t)seq * 4096 + row * 64 + c4) = fin;
        if (chunk == NCH - 1) *(f32x4*)(p.out + O_SP + ((size_t)((jl * 2 + b) * 8 + hd) * 64 + row) * 64 + c4) = fin;
    } else {
        *(f32x4*)(LOC + ((size_t)seq * (NCH - 2) + (chunk - 1)) * 4096 + row * 64 + c4) = fin;
        const f32x4 pf = {p01.x, p01.y, p23.x, p23.y};
        *(f32x4*)(PM + ((size_t)seq * (NCH - 2) + (chunk - 1)) * 4096 + row * 64 + c4) = pf;
    }
    __syncthreads();
}

__device__ __forceinline__ void attn_prompt_item(const P& p, const Ctx& cx, int jl, int item, char* lds) {
    const bf16_t* Z = cx.Z; bf16_t* OA = cx.OA;
    const int kvh = item & 1, qb = (item >> 1) & 63, b = item >> 7;
    const int tid = TIDX, lane = tid & 63, wave = tid >> 6, lr = lane & 31, h = lane >> 5;
    constexpr int KROW = 144, VROW = 528;
    char* sK = lds; char* sVt = lds + 256 * KROW;
#pragma unroll 2
    for (int q = 0; q < 8; ++q) {
        const int ch = tid + 256 * q, key = ch >> 3, c8 = ch & 7; const int tk = (qb - 1) * 128 + key;
        uint4 kv = make_uint4(0, 0, 0, 0), vv = kv;
        if (tk >= 0) { const bf16_t* zr = Z + (size_t)(b * SEQ + tk) * EP; kv = *(const uint4*)(zr + 512 + kvh * 64 + c8 * 8); vv = *(const uint4*)(zr + 640 + kvh * 64 + c8 * 8); }
        *(uint4*)(sK + key * KROW + c8 * 16) = kv;
        const unsigned vw[4] = {vv.x, vv.y, vv.z, vv.w};
#pragma unroll
        for (int e = 0; e < 8; ++e) *(bf16_t*)(sVt + (c8 * 8 + e) * VROW + key * 2) = (bf16_t)((e & 1) ? (vw[e >> 1] >> 16) : (vw[e >> 1] & 0xffff));
    }
    __syncthreads();
    const int qs = wave;
    const int qrow = b * SEQ + qb * 128 + qs * 32 + lr;
    const int qloc = qs * 32 + lr;
#pragma unroll 1
    for (int g = 0; g < 4; ++g) {
        const int qh = kvh * 4 + g;
        bf16x8 qf[4];
#pragma unroll
        for (int s = 0; s < 4; ++s) qf[s] = *(const bf16x8*)(Z + (size_t)qrow * EP + qh * 64 + s * 16 + h * 8);
        f32x16 sc[5];
#pragma unroll
        for (int u = 0; u < 5; ++u) {
#pragma unroll
            for (int e = 0; e < 16; ++e) sc[u][e] = 0.f;
#pragma unroll
            for (int s = 0; s < 4; ++s) {
                const bf16x8 kf = *(const bf16x8*)(sK + ((qs + u) * 32 + lr) * KROW + s * 32 + h * 16);
                sc[u] = __builtin_amdgcn_mfma_f32_32x32x16_bf16(kf, qf[s], sc[u], 0, 0, 0);
            }
            __builtin_amdgcn_sched_barrier(0);
        }
        const float sink = p.in[I_SINK][jl * 8 + qh];
        float mx = -3e38f;
#pragma unroll
        for (int u = 0; u < 5; ++u)
#pragma unroll
            for (int e = 0; e < 16; ++e) {
                const int kj = (qs + u) * 32 + (e & 3) + 8 * (e >> 2) + 4 * h;
                const int diff = 128 + qloc - kj;
                const bool vis = diff >= 0 && diff <= 128 && (qb > 0 || kj >= 128);
                const float sv = vis ? sc[u][e] * 0.125f : -1e30f;
                sc[u][e] = sv; mx = fmaxf(mx, sv);
            }
        mx = fmaxf(mx, __shfl_xor(mx, 32)); mx = fmaxf(mx, sink);
        float sum = 0.f;
#pragma unroll
        for (int u = 0; u < 5; ++u)
#pragma unroll
            for (int e = 0; e < 16; ++e) { const float pe = __expf(sc[u][e] - mx); sc[u][e] = pe; sum += pe; }
        sum += __shfl_xor(sum, 32);
        const float rden = 1.f / (sum + __expf(sink - mx));
        f32x16 oacc[2];
#pragma unroll
        for (int d2 = 0; d2 < 2; ++d2)
#pragma unroll
            for (int e = 0; e < 16; ++e) oacc[d2][e] = 0.f;
#pragma unroll
        for (int u = 0; u < 5; ++u)
#pragma unroll
            for (int s2 = 0; s2 < 2; ++s2) {
                union { bf16x8 v; unsigned w[4]; } pf;
#pragma unroll
                for (int e2 = 0; e2 < 4; ++e2) pf.w[e2] = pk2(sc[u][8 * s2 + 2 * e2] * rden, sc[u][8 * s2 + 2 * e2 + 1] * rden);
                const int kbase = (qs + u) * 32 + 16 * s2 + 4 * h;
#pragma unroll
                for (int d2 = 0; d2 < 2; ++d2) {
                    union { bf16x8 v; uint2 w[2]; } vf;
                    const char* vp = sVt + (d2 * 32 + lr) * VROW + kbase * 2;
                    vf.w[0] = *(const uint2*)vp; vf.w[1] = *(const uint2*)(vp + 16);
                    oacc[d2] = __builtin_amdgcn_mfma_f32_32x32x16_bf16(vf.v, pf.v, oacc[d2], 0, 0, 0);
                }
                __builtin_amdgcn_sched_barrier(0);
            }
#pragma unroll
        for (int d2 = 0; d2 < 2; ++d2)
#pragma unroll
            for (int g2 = 0; g2 < 4; ++g2) {
                uint2 o; o.x = pk2(oacc[d2][4 * g2], oacc[d2][4 * g2 + 1]); o.y = pk2(oacc[d2][4 * g2 + 2], oacc[d2][4 * g2 + 3]);
                *(uint2*)(OA + (size_t)qrow * D + qh * 64 + d2 * 32 + 8 * g2 + 4 * h) = o;
            }
    }
    __syncthreads();
}

__device__ __forceinline__ void attn_sample_item(const P& p, const Ctx& cx, int jl, int item, char* lds) {
    const bf16_t* Z = cx.Z; bf16_t* OA = cx.OA;
    const int kvh = item & 1, bs = item >> 1, m = MP + bs;
    const int tid = TIDX, lane = tid & 63, wave = tid >> 6, qh = kvh * 4 + wave;
    float* sq = (float*)lds + wave * 64; float* sp = (float*)lds + 256 + wave * 132;
    sq[lane] = bf2f(Z[(size_t)m * EP + qh * 64 + lane]);
    __syncthreads();
    const float* kc = p.in[I_CK] + ((size_t)(jl * 128 + bs) * 128) * 128 + kvh * 64;
    const float* vc = p.in[I_CV] + ((size_t)(jl * 128 + bs) * 128) * 128 + kvh * 64;
    float sc0 = 0.f, sc1 = 0.f, sc2 = 0.f;
#pragma unroll 4
    for (int d = 0; d < 64; d += 4) {
        const float4 k0 = *(const float4*)(kc + (size_t)lane * 128 + d), k1 = *(const float4*)(kc + (size_t)(lane + 64) * 128 + d);
        const float4 q4 = *(const float4*)(sq + d);
        sc0 += k0.x * q4.x + k0.y * q4.y + k0.z * q4.z + k0.w * q4.w; sc1 += k1.x * q4.x + k1.y * q4.y + k1.z * q4.z + k1.w * q4.w;
    }
    sc2 = wave_sum(bf2f(Z[(size_t)m * EP + 512 + kvh * 64 + lane]) * sq[lane]);
    sc0 *= 0.125f; sc1 *= 0.125f; sc2 *= 0.125f;
    const float sink = p.in[I_SINK][jl * 8 + qh];
    float mx = wave_max(fmaxf(sc0, sc1)); mx = fmaxf(fmaxf(mx, sc2), sink);
    const float p0 = __expf(sc0 - mx), p1 = __expf(sc1 - mx), p2 = __expf(sc2 - mx);
    const float den = wave_sum(p0 + p1) + p2 + __expf(sink - mx), rd = 1.f / den;
    sp[lane] = p0 * rd; sp[lane + 64] = p1 * rd; if (lane == 0) sp[128] = p2 * rd;
    __syncthreads();
    float o = 0.f;
#pragma unroll 32
    for (int j = 0; j < 128; ++j) o += sp[j] * vc[(size_t)j * 128 + lane];
    o += sp[128] * bf2f(Z[(size_t)m * EP + 640 + kvh * 64 + lane]);
    OA[(size_t)m * D + qh * 64 + lane] = f2bf(o);
    __syncthreads();
}

__device__ __forceinline__ void rwkv_sample_item(const P& p, const Ctx& cx, int jl, int item, char* lds) {
    const bf16_t* Z = cx.Z; const bf16_t* WAG = cx.WAG; bf16_t* OA = cx.OA;
    const int hd = item & 7, bs = item >> 3, m = MP + bs;
    const int tid = TIDX;
    float* sW = (float*)lds; float* sKK = sW + 64; float* sBB = sKK + 64; float* sK2 = sBB + 64; float* sR = sK2 + 64; float* sV = sR + 64;
    if (tid < 64) {
        const int c = hd * 64 + tid;
        const float r = zs_val(p, Z, jl, m, c), k = zs_val(p, Z, jl, m, 512 + c), v = zs_val(p, Z, jl, m, 1024 + c);
        const float eps = bf2f(WAG[(size_t)m * 1536 + c]), a = bf2f(WAG[(size_t)m * 1536 + 512 + c]);
        const float kkr = k * p.in[I_KK][jl * 512 + c];
        const float ssq = wave_sum(kkr * kkr);
        const float kkn = kkr / fmaxf(sqrtf(ssq), 1e-12f);
        sW[tid] = 1.f - eps; sKK[tid] = kkn; sBB[tid] = kkn * a; sK2[tid] = k * (1.f + (a - 1.f) * p.in[I_KA][jl * 512 + c]); sR[tid] = r; sV[tid] = v;
    }
    __syncthreads();
    const int i = tid >> 2, q = tid & 3;
    const float* sp = p.in[I_WKV] + ((size_t)((jl * 128 + bs) * 8 + hd) * 64 + i) * 64 + q * 16;
    float s[16]; float pp = 0.f;
#pragma unroll
    for (int e4 = 0; e4 < 4; ++e4) { const float4 v = *(const float4*)(sp + 4 * e4); s[4 * e4] = v.x; s[4 * e4 + 1] = v.y; s[4 * e4 + 2] = v.z; s[4 * e4 + 3] = v.w; }
#pragma unroll
    for (int e = 0; e < 16; ++e) pp += s[e] * sKK[q * 16 + e];
    pp += __shfl_xor(pp, 1); pp += __shfl_xor(pp, 2);
    const float sa = -pp, vi = sV[i];
    float qq = 0.f;
#pragma unroll
    for (int e = 0; e < 16; ++e) { const int j = q * 16 + e; s[e] = s[e] * sW[j] + sa * sBB[j] + vi * sK2[j]; qq += s[e] * sR[j]; }
    qq += __shfl_xor(qq, 1); qq += __shfl_xor(qq, 2);
    float* so = p.out + O_SS + ((size_t)((jl * 128 + bs) * 8 + hd) * 64 + i) * 64 + q * 16;
#pragma unroll
    for (int e4 = 0; e4 < 4; ++e4) *(float4*)(so + 4 * e4) = make_float4(s[4 * e4], s[4 * e4 + 1], s[4 * e4 + 2], s[4 * e4 + 3]);
    if (q == 0) OA[(size_t)m * D + 512 + hd * 64 + i] = f2bf(qq);
    __syncthreads();
}

__device__ __forceinline__ void mix_sample(const P& p, const Ctx& cx, int jl, char* lds) {
    for (int it = cx.bid; it < 256 + 1024; it += cx.nb) {
        if (it < 256) attn_sample_item(p, cx, jl, it, lds);
        else rwkv_sample_item(p, cx, jl, it - 256, lds);
    }
}

__device__ __forceinline__ void unpack8(const uint4& u, float (&o)[8]) { o[0] = lo16(u.x); o[1] = hi16(u.x); o[2] = lo16(u.y); o[3] = hi16(u.y); o[4] = lo16(u.z); o[5] = hi16(u.z); o[6] = lo16(u.w); o[7] = hi16(u.w); }
__device__ __forceinline__ void load8f(const float* p_, float (&o)[8]) { const float4 a = *(const float4*)p_, b = *(const float4*)(p_ + 4); o[0] = a.x; o[1] = a.y; o[2] = a.z; o[3] = a.w; o[4] = b.x; o[5] = b.y; o[6] = b.z; o[7] = b.w; }
__device__ __forceinline__ float group8_sum(float x) { x = dpp_add<0xB1>(x); x = dpp_add<0x4E>(x); x = dpp_add<0x141>(x); return x; }
__device__ __forceinline__ void post_phase(const P& p, const Ctx& cx, int jl) {
    if (cx.r0 == MP) { float* mo = cx.MOE + (size_t)MP * D; for (int i = cx.bid * NT + TIDX; i < MS * D / 4; i += cx.nb * NT) *(float4*)(mo + 4 * i) = make_float4(0.f, 0.f, 0.f, 0.f); }
    const bf16_t* Z = cx.Z; const bf16_t* WAG = cx.WAG; bf16_t* OA = cx.OA;
    const int tid = TIDX, lane = tid & 63, wave = tid >> 6, c = lane * 8;
    float mur[8], muk[8], muv[8], ka[8], rkw[8], gg[8], gb[8];
    load8f(p.in[I_MU] + jl * ZBW + c, mur); load8f(p.in[I_MU] + jl * ZBW + 512 + c, muk); load8f(p.in[I_MU] + jl * ZBW + 1024 + c, muv);
    load8f(p.in[I_KA] + jl * 512 + c, ka); load8f(p.in[I_RK] + jl * 512 + c, rkw); load8f(p.in[I_GNG] + jl * 512 + c, gg); load8f(p.in[I_GNB] + jl * 512 + c, gb);
    for (int m = cx.r0 + cx.bid * 4 + wave; m < cx.r1; m += cx.nb * 4) {
        const bf16_t* zr = Z + (size_t)m * EP + 768 + c;
        float r[8], k[8], v[8], pr[8], pk[8], pv[8], a[8], g[8], o[8];
        unpack8(*(const uint4*)zr, r); unpack8(*(const uint4*)(zr + 512), k); unpack8(*(const uint4*)(zr + 1024), v);
        unpack8(*(const uint4*)(WAG + (size_t)m * 1536 + 512 + c), a); unpack8(*(const uint4*)(WAG + (size_t)m * 1536 + 1024 + c), g);
        unpack8(*(const uint4*)(OA + (size_t)m * D + 512 + c), o);
        if (m < MP) {
            if ((m & (SEQ - 1)) == 0) {
#pragma unroll
                for (int e = 0; e < 8; ++e) { pr[e] = 0.f; pk[e] = 0.f; pv[e] = 0.f; }
            } else { unpack8(*(const uint4*)(zr - EP), pr); unpack8(*(const uint4*)(zr - EP + 512), pk); unpack8(*(const uint4*)(zr - EP + 1024), pv); }
        } else { const float* st = p.in[I_SHIFT] + (size_t)(jl * 128 + (m - MP)) * ZBW + c; load8f(st, pr); load8f(st + 512, pk); load8f(st + 1024, pv); }
        float rk = 0.f, so = 0.f;
#pragma unroll
        for (int e = 0; e < 8; ++e) {
            r[e] += (pr[e] - r[e]) * mur[e]; k[e] += (pk[e] - k[e]) * muk[e]; v[e] += (pv[e] - v[e]) * muv[e];
            const float k2 = k[e] * (1.f + (a[e] - 1.f) * ka[e]);
            rk += r[e] * k2 * rkw[e]; so += o[e];
        }
        rk = group8_sum(rk);
        const float mean = group8_sum(so) * (1.f / 64);
        float sv = 0.f;
#pragma unroll
        for (int e = 0; e < 8; ++e) { o[e] -= mean; sv += o[e] * o[e]; }
        const float rstd = rsqrtf(group8_sum(sv) * (1.f / 64) + 64e-5f);
        float res[8];
#pragma unroll
        for (int e = 0; e < 8; ++e) res[e] = (o[e] * rstd * gg[e] + gb[e] + rk * v[e]) * g[e];
        uint4 ov; ov.x = pk2(res[0], res[1]); ov.y = pk2(res[2], res[3]); ov.z = pk2(res[4], res[5]); ov.w = pk2(res[6], res[7]);
        *(uint4*)(OA + (size_t)m * D + 512 + c) = ov;
    }
}

__device__ __forceinline__ void sgu_ln_phase(const P& p, const Ctx& cx, int jo) {
    bf16_t* ZU = cx.ZU;
    const int lane = TIDX & 63, wave = TIDX >> 6;
    for (int m = cx.r0 + cx.bid * 4 + wave; m < cx.r1; m += cx.nb * 4) {
        bf16_t* vr = ZU + (size_t)m * 2048 + 1024;
        float x[16]; float s = 0.f;
#pragma unroll
        for (int q = 0; q < 2; ++q) { const uint4 u = *(const uint4*)(vr + lane * 8 + 512 * q);
            x[8 * q] = lo16(u.x); x[8 * q + 1] = hi16(u.x); x[8 * q + 2] = lo16(u.y); x[8 * q + 3] = hi16(u.y); x[8 * q + 4] = lo16(u.z); x[8 * q + 5] = hi16(u.z); x[8 * q + 6] = lo16(u.w); x[8 * q + 7] = hi16(u.w); }
#pragma unroll
        for (int e = 0; e < 16; ++e) s += x[e];
        const float mean = wave_sum(s) * (1.f / 1024);
        float s2 = 0.f;
#pragma unroll
        for (int e = 0; e < 16; ++e) { x[e] -= mean; s2 += x[e] * x[e]; }
        const float rstd = rsqrtf(wave_sum(s2) * (1.f / 1024) + 1e-5f);
#pragma unroll
        for (int q = 0; q < 2; ++q) {
            const int c = lane * 8 + 512 * q; float o[8];
#pragma unroll
            for (int e = 0; e < 8; ++e) o[e] = x[8 * q + e] * rstd * p.in[I_LNG][jo * 1024 + c + e] + p.in[I_LNB][jo * 1024 + c + e];
            uint4 ov; ov.x = pk2(o[0], o[1]); ov.y = pk2(o[2], o[3]); ov.z = pk2(o[4], o[5]); ov.w = pk2(o[6], o[7]);
            *(uint4*)(vr + c) = ov;
            if (m >= MP) { float* so = p.out + O_SGV + (size_t)(jo * 128 + (m - MP)) * 1024 + c; *(float4*)so = make_float4(o[0], o[1], o[2], o[3]); *(float4*)(so + 4) = make_float4(o[4], o[5], o[6], o[7]); }
        }
    }
}

template <bool SAMPLE>
__device__ __forceinline__ void sgu_phase(const P& p, const Ctx& cx, int jo, char* lds) {
    const bf16_t* ZU = cx.ZU; bf16_t* Y = cx.Y;
    const bf16_t* TR = (const bf16_t*)(p.ws + W_TRIL) + (size_t)jo * 8 * 128 * 128;
    const int tid = TIDX, lane = tid & 63, wave = tid >> 6, wm = wave >> 1, wn = wave & 1, lr = lane & 31, h = lane >> 5;
    constexpr int SROW = 272;
    char* sA = lds; char* sB = lds + 128 * SROW;
    if (!SAMPLE) for (int item = cx.bid; item < 1024; item += cx.nb) {
        const int hh = item & 7, n = (item >> 3) & 63, b = item >> 9;
        const int mbase = b * SEQ + n * 128;
#pragma unroll
        for (int q = 0; q < 8; ++q) {
            const int ch = tid + 256 * q, r = ch >> 4, c8 = ch & 15;
            *(uint4*)(sA + r * SROW + c8 * 16) = *(const uint4*)(TR + (size_t)hh * 16384 + r * 128 + c8 * 8);
            const uint4 vv = *(const uint4*)(ZU + (size_t)(mbase + r) * 2048 + 1024 + hh * 128 + c8 * 8);
            const unsigned vw[4] = {vv.x, vv.y, vv.z, vv.w};
#pragma unroll
            for (int e = 0; e < 8; ++e) *(bf16_t*)(sB + (c8 * 8 + e) * SROW + r * 2) = (bf16_t)((e & 1) ? (vw[e >> 1] >> 16) : (vw[e >> 1] & 0xffff));
        }
        __syncthreads();
        f32x16 acc[2][2];
#pragma unroll
        for (int i = 0; i < 2; ++i)
#pragma unroll
            for (int j = 0; j < 2; ++j)
#pragma unroll
                for (int e = 0; e < 16; ++e) acc[i][j][e] = 0.f;
#pragma unroll
        for (int ks = 0; ks < 8; ++ks) {
            bf16x8 xa[2], wb[2];
#pragma unroll
            for (int i = 0; i < 2; ++i) xa[i] = *(const bf16x8*)(sA + (wm * 64 + i * 32 + lr) * SROW + ks * 32 + h * 16);
#pragma unroll
            for (int j = 0; j < 2; ++j) wb[j] = *(const bf16x8*)(sB + (wn * 64 + j * 32 + lr) * SROW + ks * 32 + h * 16);
#pragma unroll
            for (int i = 0; i < 2; ++i)
#pragma unroll
                for (int j = 0; j < 2; ++j) acc[i][j] = __builtin_amdgcn_mfma_f32_32x32x16_bf16(wb[j], xa[i], acc[i][j], 0, 0, 0);
        }
#pragma unroll
        for (int i = 0; i < 2; ++i) {
            const int t = wm * 64 + i * 32 + lr; const float bias = p.in[I_SGUB][(jo * 8 + hh) * 128 + t];
#pragma unroll
            for (int j = 0; j < 2; ++j)
#pragma unroll
                for (int g = 0; g < 4; ++g) {
                    const int c = hh * 128 + wn * 64 + j * 32 + 8 * g + 4 * h;
                    const uint2 uu = *(const uint2*)(ZU + (size_t)(mbase + t) * 2048 + c);
                    uint2 o; o.x = pk2(lo16(uu.x) * (acc[i][j][4 * g] + bias), hi16(uu.x) * (acc[i][j][4 * g + 1] + bias));
                    o.y = pk2(lo16(uu.y) * (acc[i][j][4 * g + 2] + bias), hi16(uu.y) * (acc[i][j][4 * g + 3] + bias));
                    *(uint2*)(Y + (size_t)(mbase + t) * D + c) = o;
                }
        }
        __syncthreads();
    }
    const int gt = cx.bid * NT + tid, gs = cx.nb * NT;
    if (cx.r0 == MP) { float* mo = cx.MOE + (size_t)MP * D; for (int i = cx.bid * NT + tid; i < MS * D / 4; i += cx.nb * NT) *(float4*)(mo + 4 * i) = make_float4(0.f, 0.f, 0.f, 0.f); }
    if (SAMPLE) for (int it = gt; it < MS * 1024; it += gs) {
        const int m = MP + (it >> 10), c = it & 1023, hh = c >> 7;
        const float u = bf2f(ZU[(size_t)m * 2048 + c]), vn = bf2f(ZU[(size_t)m * 2048 + 1024 + c]);
        Y[(size_t)m * D + c] = f2bf(u * (p.in[I_SGUW][(size_t)(jo * 8 + hh) * 16384] * vn + p.in[I_SGUB][(jo * 8 + hh) * 128]));
    }
}

__device__ __forceinline__ void unpack8v(const u32x4& u, float (&o)[8]) { o[0] = lo16(u.x); o[1] = hi16(u.x); o[2] = lo16(u.y); o[3] = hi16(u.y); o[4] = lo16(u.z); o[5] = hi16(u.z); o[6] = lo16(u.w); o[7] = hi16(u.w); }
template <bool SAMPLE>
__device__ __forceinline__ void act_phase(const P& p, const Ctx& cx, int L) {
    const bf16_t* G = cx.G; bf16_t* U = cx.U;
    const int gt = cx.bid * NT + TIDX, gs = cx.nb * NT;
    const float* cw = p.in[I_CW] + (size_t)L * 3 * DFF; const float* cb = p.in[I_CB] + (size_t)L * DFF;
    constexpr int CG = DFF / 8, RC = 16;
    if (!SAMPLE) for (int it = gt; it < (MP / RC) * CG; it += gs) {
        const int m0 = (it / CG) * RC, c = (it % CG) * 8;
        float w0[8], w1[8], w2[8], bb[8], g1[8], g2[8];
        load8f(cw + c, w0); load8f(cw + DFF + c, w1); load8f(cw + 2 * DFF + c, w2); load8f(cb + c, bb);
        if ((m0 & (SEQ - 1)) == 0) {
#pragma unroll
            for (int e = 0; e < 8; ++e) { g1[e] = 0.f; g2[e] = 0.f; }
        } else { unpack8v(*(const u32x4*)(G + (size_t)(m0 - 1) * DFF + c), g1); unpack8v(*(const u32x4*)(G + (size_t)(m0 - 2) * DFF + c), g2); }
#pragma unroll
        for (int hf = 0; hf < RC / 8; ++hf) {
            u32x4 gq[8], uq[8];
#pragma unroll
            for (int r = 0; r < 8; ++r) { gq[r] = *(const u32x4*)(G + (size_t)(m0 + hf * 8 + r) * DFF + c); uq[r] = *(const u32x4*)(U + (size_t)(m0 + hf * 8 + r) * DFF + c); }
#pragma unroll
            for (int r = 0; r < 8; ++r) {
                float gc[8], uv[8], o[8];
                unpack8v(gq[r], gc); unpack8v(uq[r], uv);
#pragma unroll
                for (int e = 0; e < 8; ++e) { const float cv = bb[e] + w2[e] * gc[e] + w1[e] * g1[e] + w0[e] * g2[e]; o[e] = gelu_tanh(cv) * uv[e]; g2[e] = g1[e]; g1[e] = gc[e]; }
                u32x4 ov; ov.x = pk2(o[0], o[1]); ov.y = pk2(o[2], o[3]); ov.z = pk2(o[4], o[5]); ov.w = pk2(o[6], o[7]);
                *(u32x4*)(U + (size_t)(m0 + hf * 8 + r) * DFF + c) = ov;
            }
        }
    }
    if (cx.r0 == MP) { float* mo = cx.MOE + (size_t)MP * D; for (int i = cx.bid * NT + TIDX; i < MS * D / 4; i += cx.nb * NT) *(float4*)(mo + 4 * i) = make_float4(0.f, 0.f, 0.f, 0.f); }
    if (SAMPLE) for (int it = gt; it < MS * CG; it += gs) {
        const int m = MP + it / CG, c = (it % CG) * 8;
        float w0[8], w1[8], w2[8], bb[8], g1[8], g2[8], gc[8], uv[8], o[8];
        load8f(cw + c, w0); load8f(cw + DFF + c, w1); load8f(cw + 2 * DFF + c, w2); load8f(cb + c, bb);
        const float* st = p.in[I_CONV] + ((size_t)(L * 128 + (m - MP)) * 2) * DFF + c;
        load8f(st, g2); load8f(st + DFF, g1);
        unpack8v(*(const u32x4*)(G + (size_t)m * DFF + c), gc); unpack8v(*(const u32x4*)(U + (size_t)m * DFF + c), uv);
#pragma unroll
        for (int e = 0; e < 8; ++e) { const float cv = bb[e] + w2[e] * gc[e] + w1[e] * g1[e] + w0[e] * g2[e]; o[e] = gelu_tanh(cv) * uv[e]; }
        u32x4 ov; ov.x = pk2(o[0], o[1]); ov.y = pk2(o[2], o[3]); ov.z = pk2(o[4], o[5]); ov.w = pk2(o[6], o[7]);
        *(u32x4*)(U + (size_t)m * DFF + c) = ov;
    }
}

struct Chains { Ctx main, samp; XcdBarrier sb; };

template <bool SAMPLE>
__device__ __forceinline__ void run_op(const P& p, Chains& ch, int L, int op, char* lds, int pass = 1) {
    const Ctx& cx = SAMPLE ? ch.samp : ch.main;
    const int j = L >> 1; const bool even = (L & 1) == 0;
    bf16_t* XN = (bf16_t*)(p.ws + W_XN);
    EA ea; ea.c32 = nullptr; ea.o16 = nullptr; ea.o16b = nullptr; ea.layer = L; ea.ksplit = 1;
    if (even) {
        switch (op) {
        case 0: ea.o16 = cx.Z; ea.o16b = cx.LR; gemm_phase<EPI_EVENIN>(p, XN, D, (const bf16_t*)(p.ws + W_WINE) + (size_t)j * EP * D, EP, D, lds, ea, cx); return;
        case 1: lr_phase(p, cx, j); return;
        case 2: ea.o16 = cx.WAG; gemm_phase<EPI_LR>(p, cx.LR, 256, (const bf16_t*)(p.ws + W_WLR) + (size_t)j * 1536 * 256, 1536, 256, lds, ea, cx); return;
        case 3:
            if constexpr (SAMPLE) mix_sample(p, cx, j, lds);
            else {
                const int bidx = BIDX;
                if (pass == 1) {
                    if (bidx < SCAN_P1) {
                        if (bidx < 64) scan_task<SC_FULL>(p, cx, j, lds, bidx >> 2, bidx & 3, 0);
                        else { const int r = bidx - 64, r2 = r & 63; scan_task<SC_DUAL>(p, cx, j, lds, r2 >> 2, r2 & 3, 1 + (r >> 6)); }
                        return;
                    }
                } else {
                    if (bidx < SCAN_P2) { const int r2 = bidx & 63; scan_task<SC_FULL>(p, cx, j, lds, r2 >> 2, r2 & 3, 1 + (bidx >> 6)); return; }
                    for (int it = ch.samp.bid; it < 256; it += ch.samp.nb) attn_prompt_item(p, cx, j, it, lds);
                }
                if (pass == 1) {
#pragma unroll 1
                    for (int o2 = 0; o2 < 10; ++o2) { if (o2 == 1) continue;
                        run_op<true>(p, ch, L, o2, lds); if (o2 != 9) xcd_barrier(ch.sb); }
                } else {
                    run_op<true>(p, ch, L, 10, lds); xcd_barrier(ch.sb);
#pragma unroll 1
                    for (int o2 = 0; o2 < 9; ++o2) { run_op<true>(p, ch, L + 1, o2, lds); if (o2 != 8) xcd_barrier(ch.sb); }
                }
            }
            return;
        case 4: post_phase(p, cx, j); return;
        case 5: ea.c32 = cx.MOE; if (SAMPLE) ea.ksplit = 4; gemm_phase<EPI_F32>(p, cx.OA, D, (const bf16_t*)(p.ws + W_WOUTE) + (size_t)j * D * D, D, D, lds, ea, cx); return;
        case 6: rownorm_phase(p, cx, cx.MOE, p.in[I_NMPOST] + L * D, p.in[I_NFPRE] + L * D, L == 0); return;
        default: break;
        }
        op -= 7;
    } else {
        switch (op) {
        case 0: ea.o16 = cx.ZU; gemm_phase<EPI_ODDIN>(p, XN, D, (const bf16_t*)(p.ws + W_WINO) + (size_t)j * 2048 * D, 2048, D, lds, ea, cx); return;
        case 1: sgu_ln_phase(p, cx, j); return;
        case 2: sgu_phase<SAMPLE>(p, cx, j, lds); return;
        case 3: ea.c32 = cx.MOO; if (SAMPLE) ea.ksplit = 4; gemm_phase<EPI_F32>(p, cx.Y, D, (const bf16_t*)(p.ws + W_WOUTO) + (size_t)j * D * D, D, D, lds, ea, cx); return;
        case 4: rownorm_phase(p, cx, cx.MOO, p.in[I_NMPOST] + L * D, p.in[I_NFPRE] + L * D); return;
        default: break;
        }
        op -= 5;
    }
    switch (op) {
    case 0: ea.o16 = cx.G; ea.o16b = cx.U; gemm_phase<EPI_GU>(p, XN, D, (const bf16_t*)(p.ws + W_WGU) + (size_t)L * 2 * DFF * D, 2 * DFF, D, lds, ea, cx); return;
    case 1: act_phase<SAMPLE>(p, cx, L); return;
    case 2: ea.c32 = cx.FO; if (SAMPLE) ea.ksplit = 11; gemm_phase<EPI_F32>(p, cx.U, DFF, (const bf16_t*)(p.ws + W_WDN) + (size_t)L * D * DFF, D, DFF, lds, ea, cx); return;
    case 3: rownorm_phase(p, cx, cx.FO, p.in[I_NFPOST] + L * D, L < 3 ? p.in[I_NMPRE] + (L + 1) * D : nullptr); return;
    default: return;
    }
}

__global__ void __launch_bounds__(NT, 2) mega(P p_arg) {
    __shared__ __attribute__((aligned(16))) char lds[LDS_BYTES];
    cg::grid_group grid = cg::this_grid();
    const P& p = *(const P*)__builtin_amdgcn_kernarg_segment_ptr();
    __shared__ uint4 xb_words, xb_words2;
    unsigned* bar = (unsigned*)(p.ws + W_BAR);
    if (threadIdx.x == 0) { xb_words = make_uint4(0u, 0u, 0u, 0u); xb_words2 = make_uint4(0u, 0u, 0u, 0u); }
    __syncthreads();
    XcdBarrier xb = xcd_barrier_post(bar, (volatile LAS unsigned*)&xb_words, gridDim.x);
    p0_phase(p, lds);
    if (p.ws == nullptr) grid.sync();
    xcd_barrier(xb);
    Chains ch;
    {
        char* AR = p.ws + W_AR; char* SA = p.ws + W_SAMP;
        Ctx& m = ch.main;
        m.Z = (bf16_t*)(AR + A_Z); m.LR = (bf16_t*)(AR + A_LR); m.WAG = (bf16_t*)(AR + A_WAG); m.OA = (bf16_t*)(AR + A_OA); m.ZU = (bf16_t*)(AR + A_ZU); m.Y = (bf16_t*)(AR + A_Y);
        m.G = (bf16_t*)(AR + A_G); m.U = (bf16_t*)(AR + A_U); m.MOE = (float*)(AR + A_Z); m.MOO = (float*)(AR + A_MO_ODD); m.FO = (float*)(AR + A_G);
        m.r0 = 0; m.r1 = MP; m.bid = blockIdx.x; m.nb = gridDim.x;
        Ctx& q = ch.samp;
        q.Z = (bf16_t*)(SA + S_Z) - (size_t)MP * EP; q.LR = (bf16_t*)(SA + S_LR) - (size_t)MP * 256; q.WAG = (bf16_t*)(SA + S_WAG) - (size_t)MP * 1536; q.OA = (bf16_t*)(SA + S_OA) - (size_t)MP * D;
        q.ZU = (bf16_t*)(SA + S_ZU) - (size_t)MP * 2048; q.Y = (bf16_t*)(SA + S_Y) - (size_t)MP * D; q.G = (bf16_t*)(SA + S_G) - (size_t)MP * DFF; q.U = (bf16_t*)(SA + S_U) - (size_t)MP * DFF;
        q.MOE = (float*)(SA + S_MO) - (size_t)MP * D; q.MOO = q.MOE; q.FO = q.MOE;
        q.r0 = MP; q.r1 = M; q.bid = (int)blockIdx.x - SCAN_BLOCKS; q.nb = (int)gridDim.x - SCAN_BLOCKS;
        if ((int)blockIdx.x >= SCAN_BLOCKS) ch.sb = xcd_barrier_post(bar + 4096, (volatile LAS unsigned*)&xb_words2, gridDim.x - SCAN_BLOCKS);
        else { ch.sb.bar = bar + 4096; ch.sb.x = 0; ch.sb.st = (volatile LAS unsigned*)&xb_words2; ch.sb.G = 1; }
    }
#pragma unroll 1
    for (int L = 0; L < 4; ++L) {
        const int nops = (L & 1) ? 9 : 12;
#pragma unroll 1
        for (int op = 0; op < nops; ++op) {
            const bool ev = !(L & 1);
            run_op<false>(p, ch, L, (ev && op >= 4) ? op - 1 : op, lds, (ev && op == 4) ? 2 : 1);
            if (!(L == 3 && op == nops - 1)) xcd_barrier(xb);
        }
    }
}

extern "C" void kernel_launch(void* const* d_in, const int* in_sizes, int n_in, void* d_out, int out_size, void* d_ws, size_t ws_size, hipStream_t stream) {
    static int grid_blocks = 0;
    if (!grid_blocks) {
        if (n_in != N_IN || (size_t)out_size != O_END || ws_size < WS_NEED) {
            fprintf(stderr, "kernel_launch: unexpected shapes: n_in %d out %d (want %zu) ws %zu (need %zu)\n", n_in, out_size, (size_t)O_END, ws_size, (size_t)WS_NEED);
            if (ws_size < WS_NEED) return;
        }
        int dev = 0, cus = 0, per_cu = 0;
        hipGetDevice(&dev);
        hipDeviceGetAttribute(&cus, hipDeviceAttributeMultiprocessorCount, dev);
        hipOccupancyMaxActiveBlocksPerMultiprocessor(&per_cu, mega, NT, 0);
        if (per_cu > 2) per_cu = 2;
        if (per_cu < 1) per_cu = 1;
        grid_blocks = cus * per_cu;
        if (grid_blocks != 512) { fprintf(stderr, "kernel_launch: this kernel's phase program is laid out for 512 resident workgroups (256 CUs x 2); the device offers %d: nothing launched\n", grid_blocks); grid_blocks = -1; }
        fprintf(stderr, "kernel_launch: cus %d per_cu %d grid %d ws_need %zu ws %zu\n", cus, per_cu, grid_blocks, (size_t)WS_NEED, ws_size);
    }
    if (grid_blocks < 0) return;
    P p{};
    for (int i = 0; i < N_IN; ++i) p.in[i] = (const float*)d_in[i];
    p.out = (float*)d_out; p.ws = (char*)d_ws;
    void* args[] = {&p};
    if (hipMemsetAsync((char*)d_ws + W_BAR, 0, 32768, stream) != hipSuccess) fprintf(stderr, "kernel_launch: memset of the barrier words failed\n");
    hipError_t e = hipLaunchCooperativeKernel((void*)mega, dim3(grid_blocks), dim3(NT), args, 0, stream);
    if (e != hipSuccess) fprintf(stderr, "cooperative launch failed: %s (grid %d)\n", hipGetErrorString(e), grid_blocks);
}
```

```cpp
#include <hip/hip_runtime.h>
#include <hip/hip_cooperative_groups.h>
#include <cstdio>
namespace cg = cooperative_groups;

typedef unsigned short bf16_t;
typedef short bf16x8 __attribute__((ext_vector_type(8)));
typedef float f32x16 __attribute__((ext_vector_type(16)));

#ifndef REP
#define REP 0
#endif
constexpr int NT = 256;
constexpr int D = 1024, SEQ = 8192, NBAT = 2, MP = NBAT * SEQ, MS = 128, M = MP + MS;
constexpr int EP = 2560, DFF = 2816, ZBW = 1792;
constexpr int LDS_BYTES = 73728;

enum { I_XP = 0, I_XS, I_CK, I_CV, I_WKV, I_SHIFT, I_CONV, I_NMPRE, I_NMPOST, I_NFPRE, I_NFPOST, I_WINE, I_SINK, I_MU, I_W0, I_W2, I_A0, I_A2, I_G2,
       I_KK, I_KA, I_RK, I_GNG, I_GNB, I_WOUTE, I_WINO, I_LNG, I_LNB, I_SGUW, I_SGUB, I_WOUTO, I_WG, I_WU, I_CW, I_CB, I_WD, N_IN };
constexpr size_t O_YP = 0, O_YS = O_YP + (size_t)MP * D, O_WKP = O_YS + (size_t)MS * D, O_WVP = O_WKP + 2 * 2 * 128 * 128, O_WKS = O_WVP + 2 * 2 * 128 * 128,
                 O_WVS = O_WKS + 2 * 128 * 128, O_SP = O_WVS + 2 * 128 * 128, O_SS = O_SP + 2 * 2 * 8 * 4096, O_SHP = O_SS + (size_t)2 * 128 * 8 * 4096,
                 O_SHS = O_SHP + 2 * 2 * ZBW, O_SGV = O_SHS + 2 * 128 * ZBW, O_CP = O_SGV + 2 * 128 * 1024, O_CS = O_CP + 4 * 2 * 2 * DFF, O_END = O_CS + (size_t)4 * 128 * 2 * DFF;
constexpr size_t al(size_t x) { return (x + 255) & ~(size_t)255; }
constexpr size_t W_WINE = 0, W_WOUTE = W_WINE + (size_t)2 * EP * D * 2, W_WINO = W_WOUTE + (size_t)2 * D * D * 2, W_WOUTO = W_WINO + (size_t)2 * 2048 * D * 2,
                 W_WGU = W_WOUTO + (size_t)2 * D * D * 2, W_WDN = W_WGU + (size_t)4 * 2 * DFF * D * 2, W_WLR = W_WDN + (size_t)4 * D * DFF * 2,
                 W_TRIL = W_WLR + (size_t)2 * 1536 * 256 * 2, W_ROPE = W_TRIL + (size_t)2 * 8 * 128 * 128 * 2, W_XN = al(W_ROPE + (size_t)8193 * 32 * 2 * 4),
                 W_AR = al(W_XN + (size_t)M * D * 2);
constexpr size_t A_Z = 0, A_LR = al(A_Z + (size_t)M * EP * 2), A_WAG = al(A_LR + (size_t)M * 256 * 2), A_OA = al(A_WAG + (size_t)M * 1536 * 2), A_EVEN_END = A_OA + (size_t)M * D * 2;
constexpr size_t A_ZU = 0, A_Y = al(A_ZU + (size_t)M * 2048 * 2), A_MO_ODD = al(A_Y + (size_t)M * D * 2);
constexpr size_t A_G = 0, A_U = al(A_G + (size_t)M * DFF * 2), A_FFN_END = A_U + (size_t)M * DFF * 2;
constexpr size_t W_BAR = al(W_AR + A_FFN_END);
constexpr size_t W_SAMP = W_BAR + 32768;
constexpr size_t S_Z = 0, S_LR = S_Z + (size_t)MS * EP * 2, S_WAG = S_LR + (size_t)MS * 256 * 2, S_OA = S_WAG + (size_t)MS * 1536 * 2, S_ZU = S_OA + (size_t)MS * D * 2,
                 S_Y = S_ZU + (size_t)MS * 2048 * 2, S_G = S_Y + (size_t)MS * D * 2, S_U = S_G + (size_t)MS * DFF * 2, S_MO = S_U + (size_t)MS * DFF * 2, S_END = S_MO + (size_t)MS * D * 4;
constexpr size_t W_SCN = al(W_SAMP + S_END);
constexpr size_t WS_NEED = W_SCN + (size_t)16 * 7 * 4096 * 4;

struct P { const float* in[N_IN]; float* out; char* ws; };
struct Ctx { bf16_t *Z, *LR, *WAG, *OA, *ZU, *Y, *G, *U; float *MOE, *MOO, *FO; int r0, r1, bid, nb; };

__device__ __forceinline__ int opaque_tid() { int t = threadIdx.x; asm volatile("" : "+v"(t)); return t; }
__device__ __forceinline__ int opaque_bid() { int t = blockIdx.x; asm volatile("" : "+s"(t)); return t; }
#define TIDX opaque_tid()
#define BIDX opaque_bid()
__device__ __forceinline__ bf16_t f2bf(float f) { unsigned u = __float_as_uint(f); u += 0x7fffu + ((u >> 16) & 1u); return (bf16_t)(u >> 16); }
__device__ __forceinline__ float bf2f(bf16_t h) { return __uint_as_float(((unsigned)h) << 16); }
__device__ __forceinline__ unsigned pk2(float a, float b) { return (unsigned)f2bf(a) | ((unsigned)f2bf(b) << 16); }
__device__ __forceinline__ float lo16(unsigned u) { return __uint_as_float(u << 16); }
__device__ __forceinline__ float hi16(unsigned u) { return __uint_as_float(u & 0xffff0000u); }
__device__ __forceinline__ float wave_sum(float v) {
#pragma unroll
    for (int o = 32; o > 0; o >>= 1) v += __shfl_xor(v, o);
    return v;
}
__device__ __forceinline__ float wave_max(float v) {
#pragma unroll
    for (int o = 32; o > 0; o >>= 1) v = fmaxf(v, __shfl_xor(v, o));
    return v;
}
__device__ __forceinline__ float sigmoidf_(float x) { return 1.f / (1.f + __expf(-x)); }
__device__ __forceinline__ float gelu_erf(float v) {
    const float t = __builtin_amdgcn_rcpf(fabsf(v) * 0.2316418882f + 1.0f);
    float q = t * 0.5307027145f + (-0.7265760135f); q = q * t + 0.7107068705f; q = q * t + (-0.142248368f); q = q * t + 0.127414796f; q = q * t;
    const float m = v * (q * __builtin_amdgcn_exp2f((v * v) * (-0.72134752044f)));
    return v < 0.f ? m : v - m;
}
__device__ __forceinline__ float gelu_tanh(float x) { const float u2 = 1.5957691216057308f * (x + 0.044715f * x * x * x); return x * __frcp_rn(1.f + __expf(-u2)); }
template <int CTRL> __device__ __forceinline__ float dpp_add(float x) {
    int y = __builtin_amdgcn_update_dpp(0, __float_as_int(x), CTRL, 0xf, 0xf, false);
    return x + __int_as_float(y);
}
__device__ __forceinline__ float row16_sum(float x) {
    x = dpp_add<0xB1>(x); x = dpp_add<0x4E>(x); x = dpp_add<0x141>(x); x = dpp_add<0x140>(x); return x;
}


#define XB_TMO      128
#define XB_XCNT(j)  (256  + 64 * (j))
#define XB_XSUB(j)  (1280 + 64 * (j))
#define XB_XGEN(j)  (2304 + 64 * (j))
#define XB_TOP      3328
#define XB_TOPGEN   3392
#define XCD_BAR_WORDS 3456
#define XB_SPIN_CAP (1u << 20)
#define LAS __attribute__((address_space(3)))
__device__ __forceinline__ unsigned xb_ld(unsigned* p)              { return __hip_atomic_load(p, __ATOMIC_RELAXED, __HIP_MEMORY_SCOPE_AGENT); }
__device__ __forceinline__ unsigned xb_add(unsigned* p, unsigned v) { return __hip_atomic_fetch_add(p, v, __ATOMIC_RELAXED, __HIP_MEMORY_SCOPE_AGENT); }
__device__ __forceinline__ unsigned xb_xcc_id() { return (unsigned)__builtin_amdgcn_s_getreg((3 << 11) | 20) & 0xFu; }
#define XB_SPIN(cond, bar) do { unsigned _sp = 0; while (cond) { __builtin_amdgcn_s_sleep(1); \
    if ((++_sp & 255u) == 0u) { if (xb_ld(&(bar)[XB_TMO])) break; if (_sp > XB_SPIN_CAP) { atomicAdd(&(bar)[XB_TMO], 1u); break; } } } } while (0)
struct XcdBarrier { unsigned* bar; unsigned x; volatile LAS unsigned* st; unsigned G; };
__device__ __forceinline__ XcdBarrier xcd_barrier_post(unsigned* bar, volatile LAS unsigned* st, unsigned G) {
    XcdBarrier b; b.bar = bar; b.x = xb_xcc_id(); b.st = st; b.G = G;
    if (threadIdx.x == 0) (void)xb_add(&bar[XB_XCNT(b.x)], 1u);
    return b;
}
__device__ __forceinline__ void xcd_barrier_complete(unsigned* bar, unsigned x, unsigned G, unsigned& nloc, unsigned& nx) {
    unsigned sum, cnt, mine, sp = 0u;
    for (;;) {
        sum = 0u; cnt = 0u; mine = 0u;
#pragma unroll
        for (unsigned j = 0; j < 16; ++j) { const unsigned c = xb_ld(&bar[XB_XCNT(j)]); sum += c; cnt += (c > 0u) ? 1u : 0u; mine = (j == x) ? c : mine; }
        if (sum == G) break;
        __builtin_amdgcn_s_sleep(1);
        if ((++sp & 255u) == 0u) { if (xb_ld(&bar[XB_TMO])) break; if (sp > XB_SPIN_CAP) { atomicAdd(&bar[XB_TMO], 1u); break; } }
    }
    nloc = mine > 0u ? mine : 1u; nx = cnt > 0u ? cnt : 1u;
}
__device__ __forceinline__ void xcd_barrier(const XcdBarrier& b) {
    asm volatile("s_waitcnt vmcnt(0)" ::: "memory");
    __syncthreads();
    if (threadIdx.x == 0) {
        unsigned* bar = b.bar;
        __builtin_amdgcn_s_waitcnt(0);
        unsigned nloc = b.st[0], nx = b.st[1];
        if (nloc == 0u) { xcd_barrier_complete(bar, b.x, b.G, nloc, nx); b.st[0] = nloc; b.st[1] = nx; }
        const unsigned old = xb_add(&bar[XB_XSUB(b.x)], 1u);
        const unsigned gen = old / nloc;
        if (old + 1u == (gen + 1u) * nloc) {
            __builtin_amdgcn_fence(__ATOMIC_RELEASE, "agent");
            asm volatile("s_waitcnt vmcnt(0)" ::: "memory");
            const unsigned og = xb_add(&bar[XB_TOP], 1u);
            const unsigned tg = og / nx;
            if (og + 1u == (tg + 1u) * nx) xb_add(&bar[XB_TOPGEN], 1u);
            else XB_SPIN(xb_ld(&bar[XB_TOPGEN]) == tg, bar);
            __builtin_amdgcn_fence(__ATOMIC_ACQUIRE, "agent");
            xb_add(&bar[XB_XGEN(b.x)], 1u);
            asm volatile("s_waitcnt vmcnt(0)" ::: "memory");
        } else {
            XB_SPIN(xb_ld(&bar[XB_XGEN(b.x)]) == gen, bar);
            __builtin_amdgcn_fence(__ATOMIC_ACQUIRE, "agent");
            asm volatile("s_waitcnt vmcnt(0)" ::: "memory");
        }
    }
    __syncthreads();
}

__device__ __forceinline__ void rownorm_store(const float (&hv)[16], const float* g, bf16_t* xnrow, int lane) {
    float ss = 0.f;
#pragma unroll
    for (int e = 0; e < 16; ++e) ss += hv[e] * hv[e];
    ss = wave_sum(ss);
    const float rs = rsqrtf(ss * (1.f / D) + 1e-6f);
#pragma unroll
    for (int q = 0; q < 4; ++q) {
        const int c = lane * 4 + 256 * q;
        const float4 gv = *(const float4*)(g + c);
        uint2 o; o.x = pk2(hv[4 * q] * rs * gv.x, hv[4 * q + 1] * rs * gv.y); o.y = pk2(hv[4 * q + 2] * rs * gv.z, hv[4 * q + 3] * rs * gv.w);
        *(uint2*)(xnrow + c) = o;
    }
}

__device__ __forceinline__ void p0_phase(const P& p, char* lds) {
    const int tid = TIDX, lane = tid & 63, wave = tid >> 6;
    float* tl = (float*)lds;
    constexpr int TR_ITEMS = 11776;
    for (int it = BIDX; it < TR_ITEMS; it += gridDim.x) {
        const float* src; bf16_t* dst; int K, N; int r = it;
        if (r < 1280) { int jl = r / 640; r %= 640; src = p.in[I_WINE] + (size_t)jl * D * EP; dst = (bf16_t*)(p.ws + W_WINE) + (size_t)jl * EP * D; K = D; N = EP; }
        else if ((r -= 1280) < 512) { int jl = r / 256; r %= 256; src = p.in[I_WOUTE] + (size_t)jl * D * D; dst = (bf16_t*)(p.ws + W_WOUTE) + (size_t)jl * D * D; K = D; N = D; }
        else if ((r -= 512) < 1024) { int jl = r / 512; r %= 512; src = p.in[I_WINO] + (size_t)jl * D * 2048; dst = (bf16_t*)(p.ws + W_WINO) + (size_t)jl * 2048 * D; K = D; N = 2048; }
        else if ((r -= 1024) < 512) { int jl = r / 256; r %= 256; src = p.in[I_WOUTO] + (size_t)jl * D * D; dst = (bf16_t*)(p.ws + W_WOUTO) + (size_t)jl * D * D; K = D; N = D; }
        else if ((r -= 512) < 2816) { int L = r / 704; r %= 704; src = p.in[I_WG] + (size_t)L * D * DFF; dst = (bf16_t*)(p.ws + W_WGU) + (size_t)L * 2 * DFF * D; K = D; N = DFF; }
        else if ((r -= 2816) < 2816) { int L = r / 704; r %= 704; src = p.in[I_WU] + (size_t)L * D * DFF; dst = (bf16_t*)(p.ws + W_WGU) + (size_t)L * 2 * DFF * D + (size_t)DFF * D; K = D; N = DFF; }
        else { r -= 2816; int L = r / 704; r %= 704; src = p.in[I_WD] + (size_t)L * DFF * D; dst = (bf16_t*)(p.ws + W_WDN) + (size_t)L * D * DFF; K = DFF; N = D; }
        const int nb = N / 64, k0 = (r / nb) * 64, n0 = (r % nb) * 64;
#pragma unroll
        for (int q = 0; q < 4; ++q) {
            const int row = (tid >> 4) + 16 * q, c4 = (tid & 15) * 4;
            const float4 v = *(const float4*)(src + (size_t)(k0 + row) * N + n0 + c4);
            tl[row * 65 + c4] = v.x; tl[row * 65 + c4 + 1] = v.y; tl[row * 65 + c4 + 2] = v.z; tl[row * 65 + c4 + 3] = v.w;
        }
        __syncthreads();
#pragma unroll
        for (int q = 0; q < 2; ++q) {
            const int ch = tid + 256 * q, n = ch >> 3, k8 = ch & 7;
            uint4 o;
            o.x = pk2(tl[(k8 * 8 + 0) * 65 + n], tl[(k8 * 8 + 1) * 65 + n]); o.y = pk2(tl[(k8 * 8 + 2) * 65 + n], tl[(k8 * 8 + 3) * 65 + n]);
            o.z = pk2(tl[(k8 * 8 + 4) * 65 + n], tl[(k8 * 8 + 5) * 65 + n]); o.w = pk2(tl[(k8 * 8 + 6) * 65 + n], tl[(k8 * 8 + 7) * 65 + n]);
            *(uint4*)(dst + (size_t)(n0 + n) * K + k0 + k8 * 8) = o;
        }
        __syncthreads();
    }
    const int gt = BIDX * NT + tid, gs = gridDim.x * NT;
    {
        bf16_t* wlr = (bf16_t*)(p.ws + W_WLR);
        for (int e = gt; e < 2 * 1536 * 256; e += gs) {
            const int jl = e / (1536 * 256), n = (e / 256) % 1536, k = e & 255;
            float v = 0.f;
            if (n < 512) { if (k < 64) v = p.in[I_W2][(size_t)jl * 64 * 512 + k * 512 + n]; }
            else if (n < 1024) { if (k >= 64 && k < 128) v = p.in[I_A2][(size_t)jl * 64 * 512 + (k - 64) * 512 + (n - 512)]; }
            else { if (k >= 128) v = p.in[I_G2][(size_t)jl * 128 * 512 + (k - 128) * 512 + (n - 1024)]; }
            wlr[e] = f2bf(v);
        }
        bf16_t* tr = (bf16_t*)(p.ws + W_TRIL);
        for (int e = gt; e < 2 * 8 * 128 * 128; e += gs) { const int t = (e >> 7) & 127, s = e & 127; tr[e] = f2bf(s <= t ? p.in[I_SGUW][e] : 0.f); }
        float* rope = (float*)(p.ws + W_ROPE);
        for (int e = gt; e < 8193 * 32; e += gs) {
            const int pos = e >> 5, i = e & 31;
            double inv = 1.0; for (int q = 0; q < i; ++q) inv *= 0.7498942093324559;
            double x = (double)pos * inv;
            const double TWO_PI = 6.283185307179586;
            double n = rint(x / TWO_PI); x -= n * TWO_PI;
            double qd = rint(x / 1.5707963267948966); double r = x - qd * 1.5707963267948966; int qi = ((int)qd) & 3;
            double r2 = r * r;
            double sn = r * (1.0 + r2 * (-1.0 / 6 + r2 * (1.0 / 120 + r2 * (-1.0 / 5040 + r2 * (1.0 / 362880 + r2 * (-1.0 / 39916800 + r2 * (1.0 / 6227020800.0)))))));
            double cs = 1.0 + r2 * (-0.5 + r2 * (1.0 / 24 + r2 * (-1.0 / 720 + r2 * (1.0 / 40320 + r2 * (-1.0 / 3628800 + r2 * (1.0 / 479001600.0))))));
            double c, s;
            if (qi == 0) { c = cs; s = sn; } else if (qi == 1) { c = -sn; s = cs; } else if (qi == 2) { c = -cs; s = -sn; } else { c = sn; s = -cs; }
            rope[e] = (float)c; rope[8193 * 32 + e] = (float)s;
        }
    }
    for (int row = BIDX * 4 + wave; row < M; row += gridDim.x * 4) {
        const float* xr = row < MP ? p.in[I_XP] + (size_t)row * D : p.in[I_XS] + (size_t)(row - MP) * D;
        float hv[16];
#pragma unroll
        for (int q = 0; q < 4; ++q) { const float4 v = *(const float4*)(xr + lane * 4 + 256 * q); hv[4 * q] = v.x; hv[4 * q + 1] = v.y; hv[4 * q + 2] = v.z; hv[4 * q + 3] = v.w; }
        rownorm_store(hv, p.in[I_NMPRE], (bf16_t*)(p.ws + W_XN) + (size_t)row * D, lane);
    }
}

typedef float f32x4v __attribute__((ext_vector_type(4)));
__device__ __forceinline__ void rownorm_phase(const P& p, const Ctx& cx, const float* mo, const float* gpost, const float* gnext, bool first = false) {
    const int lane = TIDX & 63, wave = TIDX >> 6;
    const int stride = cx.nb * 4;
    f32x4v gp[4], gn[4];
#pragma unroll
    for (int q = 0; q < 4; ++q) { gp[q] = *(const f32x4v*)(gpost + lane * 4 + 256 * q); gn[q] = gnext ? *(const f32x4v*)(gnext + lane * 4 + 256 * q) : (f32x4v){0.f, 0.f, 0.f, 0.f}; }
    for (int row = cx.r0 + cx.bid * 4 + wave; row < cx.r1; row += 2 * stride) {
        const int rowb = row + stride; const bool hasb = rowb < cx.r1; const int rb = hasb ? rowb : row;
        f32x4v ma[4], ha[4], mb[4], hb[4];
        float* hra = p.out + (size_t)row * D + lane * 4; float* hrb = p.out + (size_t)rb * D + lane * 4;
#pragma unroll
        for (int q = 0; q < 4; ++q) { ma[q] = *(const f32x4v*)(mo + (size_t)row * D + lane * 4 + 256 * q); mb[q] = *(const f32x4v*)(mo + (size_t)rb * D + lane * 4 + 256 * q); }
        const float* hsa = first ? (row < MP ? p.in[I_XP] + (size_t)row * D : p.in[I_XS] + (size_t)(row - MP) * D) + lane * 4 : hra;
        const float* hsb = first ? (rb < MP ? p.in[I_XP] + (size_t)rb * D : p.in[I_XS] + (size_t)(rb - MP) * D) + lane * 4 : hrb;
#pragma unroll
        for (int q = 0; q < 4; ++q) { ha[q] = *(const f32x4v*)(hsa + 256 * q); hb[q] = *(const f32x4v*)(hsb + 256 * q); }
        float sa = 0.f, sb = 0.f;
#pragma unroll
        for (int q = 0; q < 4; ++q) { const f32x4v a2 = ma[q] * ma[q], b2 = mb[q] * mb[q]; sa += (a2.x + a2.y) + (a2.z + a2.w); sb += (b2.x + b2.y) + (b2.z + b2.w); }
#pragma unroll
        for (int o = 32; o > 0; o >>= 1) { sa += __shfl_xor(sa, o); sb += __shfl_xor(sb, o); }
        const float rsa = rsqrtf(sa * (1.f / D) + 1e-6f), rsb = rsqrtf(sb * (1.f / D) + 1e-6f);
        float ta = 0.f, tb = 0.f;
#pragma unroll
        for (int q = 0; q < 4; ++q) {
            ha[q] = ha[q] + ma[q] * rsa * gp[q]; hb[q] = hb[q] + mb[q] * rsb * gp[q];
            *(f32x4v*)(hra + 256 * q) = ha[q]; if (hasb) *(f32x4v*)(hrb + 256 * q) = hb[q];
            const f32x4v a2 = ha[q] * ha[q], b2 = hb[q] * hb[q]; ta += (a2.x + a2.y) + (a2.z + a2.w); tb += (b2.x + b2.y) + (b2.z + b2.w);
        }
        if (gnext) {
#pragma unroll
            for (int o = 32; o > 0; o >>= 1) { ta += __shfl_xor(ta, o); tb += __shfl_xor(tb, o); }
            const float ra = rsqrtf(ta * (1.f / D) + 1e-6f), rbb = rsqrtf(tb * (1.f / D) + 1e-6f);
            bf16_t* xa = (bf16_t*)(p.ws + W_XN) + (size_t)row * D + lane * 4; bf16_t* xb = (bf16_t*)(p.ws + W_XN) + (size_t)rb * D + lane * 4;
#pragma unroll
            for (int q = 0; q < 4; ++q) {
                const f32x4v ya = ha[q] * ra * gn[q], yb = hb[q] * rbb * gn[q];
                uint2 oa; oa.x = pk2(ya.x, ya.y); oa.y = pk2(ya.z, ya.w); *(uint2*)(xa + 256 * q) = oa;
                if (hasb) { uint2 ob; ob.x = pk2(yb.x, yb.y); ob.y = pk2(yb.z, yb.w); *(uint2*)(xb + 256 * q) = ob; }
            }
        }
    }
}

constexpr int BM = 128, BN = 128, BK = 64, LROW = 144  , OPB = 128 * LROW  , STG = 2 * OPB;
enum { EPI_F32 = 0, EPI_EVENIN, EPI_LR, EPI_GU, EPI_ODDIN };
struct EA { float* c32; bf16_t* o16; bf16_t* o16b; int layer; int ksplit; };

template <int EPI>
__device__ __forceinline__ void gemm_epilogue(const P& p, const f32x16 (&acc)[2][2], int m0, int n0, int wm, int wn, int lane, const EA& ea, int N) {
    const int h = lane >> 5, lr = lane & 31;
    const int jl = ea.layer >> 1;
#pragma unroll
    for (int i = 0; i < 2; ++i) {
        const int m = m0 + wm * 64 + i * 32 + lr;
        const int hb = n0 + wn * 64;
        float v[2][16];
#pragma unroll
        for (int j = 0; j < 2; ++j)
#pragma unroll
            for (int e = 0; e < 16; ++e) v[j][e] = acc[i][j][e];
        if (EPI == EPI_EVENIN) {
            const bool prompt = m < MP; const int t = m & (SEQ - 1), b = m >> 13, bs = m - MP;
            if (hb < 640) {
                const int pos = prompt ? t : SEQ;
                const float* rc = (const float*)(p.ws + W_ROPE) + (size_t)pos * 32; const float* rsn = rc + 8193 * 32;
#pragma unroll
                for (int g = 0; g < 4; ++g) {
                    const float4 c4 = *(const float4*)(rc + 8 * g + 4 * h), s4 = *(const float4*)(rsn + 8 * g + 4 * h);
                    const float cc[4] = {c4.x, c4.y, c4.z, c4.w}, sn[4] = {s4.x, s4.y, s4.z, s4.w};
#pragma unroll
                    for (int e = 0; e < 4; ++e) { const float x1 = v[0][4 * g + e], x2 = v[1][4 * g + e]; v[0][4 * g + e] = x1 * cc[e] - x2 * sn[e]; v[1][4 * g + e] = x2 * cc[e] + x1 * sn[e]; }
                }
            }
#pragma unroll
            for (int j = 0; j < 2; ++j)
#pragma unroll
                for (int g = 0; g < 4; ++g) {
                    const int dc = j * 32 + 8 * g + 4 * h;
                    uint2 o; o.x = pk2(v[j][4 * g], v[j][4 * g + 1]); o.y = pk2(v[j][4 * g + 2], v[j][4 * g + 3]);
                    *(uint2*)(ea.o16 + (size_t)m * EP + hb + dc) = o;
                    const float4 f4 = make_float4(v[j][4 * g], v[j][4 * g + 1], v[j][4 * g + 2], v[j][4 * g + 3]);
                    if (hb >= 512 && hb < 768) {
                        const int kvh = ((hb - 512) >> 6) & 1; const bool isv = hb >= 640;
                        if (prompt) { if (t >= SEQ - 128) *(float4*)(p.out + (isv ? O_WVP : O_WKP) + ((size_t)((jl * 2 + b) * 128 + (t - (SEQ - 128))) * 2 + kvh) * 64 + dc) = f4; }
                        else *(float4*)(p.out + (isv ? O_WVS : O_WKS) + ((size_t)(jl * 128 + bs) * 2 + kvh) * 64 + dc) = f4;
                    } else if (hb >= 768) {
                        const int zc = hb - 768 + dc;
                        if (prompt) { if (t == SEQ - 1) *(float4*)(p.out + O_SHP + (size_t)(jl * 2 + b) * ZBW + zc) = f4; }
                        else {
                            *(float4*)(p.out + O_SHS + (size_t)(jl * 128 + bs) * ZBW + zc) = f4;
                            if (zc >= 1536) {
                                const float4 pv = *(const float4*)(p.in[I_SHIFT] + (size_t)(jl * 128 + bs) * ZBW + zc), mu4 = *(const float4*)(p.in[I_MU] + jl * ZBW + zc);
                                const float pr[4] = {pv.x, pv.y, pv.z, pv.w}, mm[4] = {mu4.x, mu4.y, mu4.z, mu4.w}; float lo[4];
                                const int c = zc - 1536;
                                const float vq[4] = {f4.x, f4.y, f4.z, f4.w};
#pragma unroll
                                for (int e = 0; e < 4; ++e) { const float zs = vq[e] + (pr[e] - vq[e]) * mm[e]; lo[e] = c < 64 ? tanhf(zs) : (c < 128 ? zs : sigmoidf_(zs)); }
                                uint2 ol; ol.x = pk2(lo[0], lo[1]); ol.y = pk2(lo[2], lo[3]);
                                *(uint2*)(ea.o16b + (size_t)m * 256 + c) = ol;
                            }
                        }
                    }
                }
        } else {
#pragma unroll
            for (int j = 0; j < 2; ++j)
#pragma unroll
                for (int g = 0; g < 4; ++g) {
                    const int col = hb + j * 32 + 8 * g + 4 * h;
                    float x0 = v[j][4 * g], x1 = v[j][4 * g + 1], x2 = v[j][4 * g + 2], x3 = v[j][4 * g + 3];
                    if (EPI == EPI_F32) {
                        float* cp = ea.c32 + (size_t)m * N + col;
                        if (ea.ksplit > 1) { atomicAdd(cp, x0); atomicAdd(cp + 1, x1); atomicAdd(cp + 2, x2); atomicAdd(cp + 3, x3); }
                        else *(float4*)cp = make_float4(x0, x1, x2, x3);
                    } else if (EPI == EPI_ODDIN) {
                        uint2 o; o.x = pk2(gelu_erf(x0), gelu_erf(x1)); o.y = pk2(gelu_erf(x2), gelu_erf(x3));
                        *(uint2*)(ea.o16 + (size_t)m * 2048 + col) = o;
                    } else if (EPI == EPI_LR) {
                        float xs[4] = {x0, x1, x2, x3};
                        if (col < 512) {
                            const float4 w0 = *(const float4*)(p.in[I_W0] + jl * 512 + col); const float ww[4] = {w0.x, w0.y, w0.z, w0.w};
#pragma unroll
                            for (int e = 0; e < 4; ++e) xs[e] = -expm1f(-0.606531f * sigmoidf_(xs[e] + ww[e]));
                        } else if (col < 1024) {
                            const float4 a0 = *(const float4*)(p.in[I_A0] + jl * 512 + col - 512); const float aa[4] = {a0.x, a0.y, a0.z, a0.w};
#pragma unroll
                            for (int e = 0; e < 4; ++e) xs[e] = sigmoidf_(xs[e] + aa[e]);
                        }
                        uint2 o; o.x = pk2(xs[0], xs[1]); o.y = pk2(xs[2], xs[3]);
                        *(uint2*)(ea.o16 + (size_t)m * 1536 + col) = o;
                    } else if (EPI == EPI_GU) {
                        uint2 o; o.x = pk2(x0, x1); o.y = pk2(x2, x3);
                        if (col < DFF) {
                            *(uint2*)(ea.o16 + (size_t)m * DFF + col) = o;
                            const int L = ea.layer;
                            if (m < MP) { const int t = m & (SEQ - 1), b = m >> 13; if (t >= SEQ - 2) *(float4*)(p.out + O_CP + ((size_t)(L * 2 + b) * 2 + (t - (SEQ - 2))) * DFF + col) = make_float4(x0, x1, x2, x3); }
                            else { const int bs = m - MP; const size_t base = ((size_t)(L * 128 + bs) * 2) * DFF + col;
                                *(float4*)(p.out + O_CS + base + DFF) = make_float4(x0, x1, x2, x3);
                                *(float4*)(p.out + O_CS + base) = *(const float4*)(p.in[I_CONV] + base + DFF); }
                        } else *(uint2*)(ea.o16b + (size_t)m * DFF + col - DFF) = o;
                    }
                }
        }
    }
}

typedef unsigned u32x4 __attribute__((ext_vector_type(4)));
struct Stg { u32x4 a0, a1, a2, a3, b0, b1, b2, b3; };
__device__ __forceinline__ void stg_load(Stg& r, const bf16_t* ga, const bf16_t* gb, size_t sa, size_t sb) {
    r.a0 = *(const u32x4*)(ga); r.a1 = *(const u32x4*)(ga + sa); r.a2 = *(const u32x4*)(ga + 2 * sa); r.a3 = *(const u32x4*)(ga + 3 * sa);
    r.b0 = *(const u32x4*)(gb); r.b1 = *(const u32x4*)(gb + sb); r.b2 = *(const u32x4*)(gb + 2 * sb); r.b3 = *(const u32x4*)(gb + 3 * sb);
}
__device__ __forceinline__ void stg_store(const Stg& r, char* w) {
    *(u32x4*)(w) = r.a0; *(u32x4*)(w + 32 * LROW) = r.a1; *(u32x4*)(w + 64 * LROW) = r.a2; *(u32x4*)(w + 96 * LROW) = r.a3;
    *(u32x4*)(w + OPB) = r.b0; *(u32x4*)(w + OPB + 32 * LROW) = r.b1; *(u32x4*)(w + OPB + 64 * LROW) = r.b2; *(u32x4*)(w + OPB + 96 * LROW) = r.b3;
}
__device__ __forceinline__ void gemm_ktile(f32x16 (&acc)[2][2], const char* sA, const char* sB) {
    __builtin_amdgcn_s_setprio(1);
#pragma unroll
    for (int ks = 0; ks < 4; ++ks) {
        bf16x8 xa[2], wb[2];
#pragma unroll
        for (int i = 0; i < 2; ++i) xa[i] = *(const bf16x8*)(sA + i * 32 * LROW + ks * 32);
#pragma unroll
        for (int j = 0; j < 2; ++j) wb[j] = *(const bf16x8*)(sB + j * 32 * LROW + ks * 32);
#pragma unroll
        for (int i = 0; i < 2; ++i)
#pragma unroll
            for (int j = 0; j < 2; ++j) acc[i][j] = __builtin_amdgcn_mfma_f32_32x32x16_bf16(wb[j], xa[i], acc[i][j], 0, 0, 0);
    }
    __builtin_amdgcn_s_setprio(0);
}
template <int EPI>
__device__ __forceinline__ void gemm_phase(const P& p, const bf16_t* __restrict__ A, int lda, const bf16_t* __restrict__ Bt, int N, int K, char* lds, EA ea, const Ctx& cx) {
    const int tid = TIDX, lane = tid & 63, wave = tid >> 6, wm = wave >> 1, wn = wave & 1;
    const int ks_n = ea.ksplit, ntn = N / BN, mt0 = cx.r0 / BM, ntiles = ((cx.r1 - cx.r0) / BM) * ntn * ks_n, nk = K / BK / ks_n;
    const int lrow = tid >> 3, lc8 = tid & 7;
    const size_t sa = (size_t)32 * lda, sb = (size_t)32 * K;
    for (int tile = cx.bid; tile < ntiles; tile += cx.nb) {
        const int kpart = tile % ks_n, t2 = tile / ks_n;
        int mt, nt;
        if (cx.r0 == 0 && (cx.nb & 7) == 0) {
            const int x = cx.bid & 7, per = cx.nb >> 3, i = (cx.bid >> 3) + per * ((tile - cx.bid) / cx.nb);
            const int mi = i & 7, rest = i >> 3, nn = rest % ntn, mg = rest / ntn;
            mt = 16 * x + 8 * mg + mi; nt = nn;
        } else { mt = mt0 + t2 / ntn; nt = t2 % ntn; }
        const int m0 = mt * BM, n0 = nt * BN;
        const bf16_t* ga = A + (size_t)(m0 + lrow) * lda + lc8 * 8 + kpart * nk * BK;
        const bf16_t* gb = Bt + (size_t)(n0 + lrow) * K + lc8 * 8 + kpart * nk * BK;
        Stg r0, r1;
        stg_load(r0, ga, gb, sa, sb);
        stg_load(r1, ga + BK, gb + BK, sa, sb);
        f32x16 acc[2][2];
#pragma unroll
        for (int i = 0; i < 2; ++i)
#pragma unroll
            for (int j = 0; j < 2; ++j)
#pragma unroll
                for (int e = 0; e < 16; ++e) acc[i][j][e] = 0.f;
        char* wA = lds + lrow * LROW + lc8 * 16;
        stg_store(r0, wA);
        __syncthreads();
        const char* sA0 = lds + (wm * 64 + (lane & 31)) * LROW + (lane >> 5) * 16;
        const char* sB0 = lds + OPB + (wn * 64 + (lane & 31)) * LROW + (lane >> 5) * 16;
        for (int kt = 0; kt < nk; kt += 2) {
            if (kt + 2 < nk) stg_load(r0, ga + (kt + 2) * BK, gb + (kt + 2) * BK, sa, sb);
            __builtin_amdgcn_sched_barrier(0);
            gemm_ktile(acc, sA0, sB0);
            stg_store(r1, wA + STG);
            __syncthreads();
            if (kt + 3 < nk) stg_load(r1, ga + (kt + 3) * BK, gb + (kt + 3) * BK, sa, sb);
            __builtin_amdgcn_sched_barrier(0);
            gemm_ktile(acc, sA0 + STG, sB0 + STG);
            if (kt + 2 < nk) stg_store(r0, wA);
            __syncthreads();
        }
        gemm_epilogue<EPI>(p, acc, m0, n0, wm, wn, lane, ea, N);
    }
}

__device__ __forceinline__ void lr_phase(const P& p, const Ctx& cx, int jl) {
    const bf16_t* Z = cx.Z; bf16_t* LR = cx.LR;
    const int gt = cx.bid * NT + TIDX, gs = cx.nb * NT;
    for (int it = gt; it < (cx.r1 - cx.r0) * 32; it += gs) {
        const int m = cx.r0 + (it >> 5), c8 = it & 31, zc = 1536 + c8 * 8;
        const uint4 cur = *(const uint4*)(Z + (size_t)m * EP + 768 + zc);
        float pv[8];
        if (m < MP) {
            if ((m & (SEQ - 1)) == 0) { for (int e = 0; e < 8; ++e) pv[e] = 0.f; }
            else { const uint4 pr = *(const uint4*)(Z + (size_t)(m - 1) * EP + 768 + zc); pv[0] = lo16(pr.x); pv[1] = hi16(pr.x); pv[2] = lo16(pr.y); pv[3] = hi16(pr.y); pv[4] = lo16(pr.z); pv[5] = hi16(pr.z); pv[6] = lo16(pr.w); pv[7] = hi16(pr.w); }
        } else { const float* st = p.in[I_SHIFT] + (size_t)(jl * 128 + (m - MP)) * ZBW + zc; for (int e = 0; e < 8; ++e) pv[e] = st[e]; }
        const float cv[8] = {lo16(cur.x), hi16(cur.x), lo16(cur.y), hi16(cur.y), lo16(cur.z), hi16(cur.z), lo16(cur.w), hi16(cur.w)};
        const float* mu = p.in[I_MU] + jl * ZBW + zc;
        float o[8];
#pragma unroll
        for (int e = 0; e < 8; ++e) { const float zs = cv[e] + (pv[e] - cv[e]) * mu[e]; o[e] = c8 < 8 ? tanhf(zs) : (c8 < 16 ? zs : sigmoidf_(zs)); }
        uint4 ov; ov.x = pk2(o[0], o[1]); ov.y = pk2(o[2], o[3]); ov.z = pk2(o[4], o[5]); ov.w = pk2(o[6], o[7]);
        *(uint4*)(LR + (size_t)m * 256 + c8 * 8) = ov;
    }
}

__device__ __forceinline__ float zs_val(const P& p, const bf16_t* Z, int jl, int m, int c) {
    const float cur = bf2f(Z[(size_t)m * EP + 768 + c]);
    float prev;
    if (m < MP) prev = (m & (SEQ - 1)) == 0 ? 0.f : bf2f(Z[(size_t)(m - 1) * EP + 768 + c]);
    else prev = p.in[I_SHIFT][(size_t)(jl * 128 + (m - MP)) * ZBW + c];
    return cur + (prev - cur) * p.in[I_MU][jl * ZBW + c];
}

constexpr int TC = 32;
typedef float f32x2 __attribute__((ext_vector_type(2)));
typedef float f32x4 __attribute__((ext_vector_type(4)));
struct ScanRaw { u32x4 cr, ck, cv, pr, pk, pv, ep, av; };
__device__ __forceinline__ void scan_load(ScanRaw& R, const bf16_t* Z, const bf16_t* WAG, int m, int t, int c) {
    const bf16_t* zr = Z + (size_t)m * EP + 768;
    R.cr = *(const u32x4*)(zr + c); R.ck = *(const u32x4*)(zr + 512 + c); R.cv = *(const u32x4*)(zr + 1024 + c);
    R.pr = (u32x4){0u, 0u, 0u, 0u}; R.pk = R.pr; R.pv = R.pr;
    if (t > 0) { R.pr = *(const u32x4*)(zr - EP + c); R.pk = *(const u32x4*)(zr - EP + 512 + c); R.pv = *(const u32x4*)(zr - EP + 1024 + c); }
    R.ep = *(const u32x4*)(WAG + (size_t)m * 1536 + c); R.av = *(const u32x4*)(WAG + (size_t)m * 1536 + 512 + c);
}
constexpr int NCH = 5, SCAN_P1 = 256, SCAN_P2 = 256, SCAN_BLOCKS = 256;
__device__ __forceinline__ int chunk_begin(int c) { return c >= NCH ? SEQ : (c == 0 ? 0 : 2080 + (c - 1) * 1536); }
enum { SC_FULL = 0, SC_DUAL = 3 };
template <int mode>
__device__ __forceinline__ void scan_task(const P& p, const Ctx& cx, int jl, char* lds, int seq, int rg, int chunk) {
    const bf16_t* Z = cx.Z; const bf16_t* WAG = cx.WAG; bf16_t* OA = cx.OA;
    float* SEND0 = (float*)(p.ws + W_SCN); float* PM = SEND0 + 16 * 4096; float* LOC = PM + 16 * (NCH - 2) * 4096;
    const int b = seq >> 3, hd = seq & 7;
    const int tid = TIDX, lane = tid & 63, wave = tid >> 6;
    const int rowl = wave * 4 + (lane >> 4), row = rg * 16 + rowl, c4 = (lane & 15) * 4;
    float* sW = (float*)lds; float* sKK = sW + TC * 64; float* sBB = sKK + TC * 64; float* sK2 = sBB + TC * 64; float* sR = sK2 + TC * 64; float* sV = sR + TC * 64;
    float* sQ = sV + TC * 64;
    f32x4 x = {0.f, 0.f, 0.f, 0.f};
    f32x2 p01 = {(c4 == row) ? 1.f : 0.f, (c4 + 1 == row) ? 1.f : 0.f}, p23 = {(c4 + 2 == row) ? 1.f : 0.f, (c4 + 3 == row) ? 1.f : 0.f};
    if (mode == SC_FULL && chunk > 0) {
        x = *(const f32x4*)(SEND0 + (size_t)seq * 4096 + row * 64 + c4);
        for (int cc = 1; cc < chunk; ++cc) {
            *(f32x4*)(sQ + rowl * 64 + c4) = x;
            __syncthreads();
            const float* pm = PM + ((size_t)seq * (NCH - 2) + (cc - 1)) * 4096 + c4;
            f32x4 acc = *(const f32x4*)(LOC + ((size_t)seq * (NCH - 2) + (cc - 1)) * 4096 + row * 64 + c4);
#pragma unroll 8
            for (int j = 0; j < 64; ++j) { const float a = sQ[rowl * 64 + j]; const f32x4 pv = *(const f32x4*)(pm + j * 64); acc += pv * a; }
            __syncthreads();
            x = acc;
        }
    }
    f32x2 s01 = x.lo, s23 = x.hi;
    const int ptt = tid >> 3, pj0 = (tid & 7) * 8, pc = hd * 64 + pj0;
    const float* mu = p.in[I_MU] + jl * ZBW;
    float mur[8], muk[8], muv[8], kkw[8], kaw[8];
#pragma unroll
    for (int e = 0; e < 8; ++e) { mur[e] = mu[pc + e]; muk[e] = mu[512 + pc + e]; muv[e] = mu[1024 + pc + e]; kkw[e] = p.in[I_KK][jl * 512 + pc + e]; kaw[e] = p.in[I_KA][jl * 512 + pc + e]; }
    const int tb = chunk_begin(chunk), te = chunk_begin(chunk + 1);
    ScanRaw R;
    scan_load(R, Z, WAG, b * SEQ + tb + ptt, tb + ptt, pc);
    const float vscale = 1.f;
    for (int t0 = tb; t0 < te; t0 += TC) {
        {
            const unsigned crr[4] = {R.cr.x, R.cr.y, R.cr.z, R.cr.w}, ckk[4] = {R.ck.x, R.ck.y, R.ck.z, R.ck.w}, cvv[4] = {R.cv.x, R.cv.y, R.cv.z, R.cv.w};
            const unsigned prr[4] = {R.pr.x, R.pr.y, R.pr.z, R.pr.w}, pkk[4] = {R.pk.x, R.pk.y, R.pk.z, R.pk.w}, pv4[4] = {R.pv.x, R.pv.y, R.pv.z, R.pv.w};
            const unsigned epp[4] = {R.ep.x, R.ep.y, R.ep.z, R.ep.w}, avv[4] = {R.av.x, R.av.y, R.av.z, R.av.w};
            float rr[8], kx[8], vx[8], kkr[8], aa[8], ee[8]; float ssq = 0.f;
#pragma unroll
            for (int e = 0; e < 8; ++e) {
                const int w_ = e >> 1; const bool hi = e & 1;
                const float r_c = hi ? hi16(crr[w_]) : lo16(crr[w_]), r_p = hi ? hi16(prr[w_]) : lo16(prr[w_]);
                const float k_c = hi ? hi16(ckk[w_]) : lo16(ckk[w_]), k_p = hi ? hi16(pkk[w_]) : lo16(pkk[w_]);
                const float v_c = hi ? hi16(cvv[w_]) : lo16(cvv[w_]), v_p = hi ? hi16(pv4[w_]) : lo16(pv4[w_]);
                rr[e] = r_c + (r_p - r_c) * mur[e]; kx[e] = k_c + (k_p - k_c) * muk[e]; vx[e] = (v_c + (v_p - v_c) * muv[e]) * vscale;
                ee[e] = hi ? hi16(epp[w_]) : lo16(epp[w_]); aa[e] = hi ? hi16(avv[w_]) : lo16(avv[w_]);
                kkr[e] = kx[e] * kkw[e]; ssq += kkr[e] * kkr[e];
            }
            ssq += __shfl_xor(ssq, 1); ssq += __shfl_xor(ssq, 2); ssq += __shfl_xor(ssq, 4);
            const float inv = 1.f / fmaxf(sqrtf(ssq), 1e-12f);
            float ow[8], okk[8], obb[8], ok2[8];
#pragma unroll
            for (int e = 0; e < 8; ++e) { const float kkn = kkr[e] * inv; ow[e] = 1.f - ee[e]; okk[e] = kkn; obb[e] = kkn * aa[e]; ok2[e] = kx[e] * (1.f + (aa[e] - 1.f) * kaw[e]); }
            const int o = ptt * 64 + pj0;
            *(float4*)(sW + o) = make_float4(ow[0], ow[1], ow[2], ow[3]); *(float4*)(sW + o + 4) = make_float4(ow[4], ow[5], ow[6], ow[7]);
            *(float4*)(sKK + o) = make_float4(okk[0], okk[1], okk[2], okk[3]); *(float4*)(sKK + o + 4) = make_float4(okk[4], okk[5], okk[6], okk[7]);
            *(float4*)(sBB + o) = make_float4(obb[0], obb[1], obb[2], obb[3]); *(float4*)(sBB + o + 4) = make_float4(obb[4], obb[5], obb[6], obb[7]);
            *(float4*)(sK2 + o) = make_float4(ok2[0], ok2[1], ok2[2], ok2[3]); *(float4*)(sK2 + o + 4) = make_float4(ok2[4], ok2[5], ok2[6], ok2[7]);
            *(float4*)(sR + o) = make_float4(rr[0], rr[1], rr[2], rr[3]); *(float4*)(sR + o + 4) = make_float4(rr[4], rr[5], rr[6], rr[7]);
            *(float4*)(sV + o) = make_float4(vx[0], vx[1], vx[2], vx[3]); *(float4*)(sV + o + 4) = make_float4(vx[4], vx[5], vx[6], vx[7]);
        }
        __syncthreads();
        if (t0 + TC < te) scan_load(R, Z, WAG, b * SEQ + t0 + TC + ptt, t0 + TC + ptt, pc);
        {
            const float* base = sW + c4;
            float* qdst = ((lane & 3) == 0) ? (sQ + rowl * 4 + ((lane & 15) >> 2)) : (sQ + TC * 64 + lane);
            const int qstep = ((lane & 3) == 0) ? 64 : 0;
            const float* vb = sV + row;
            f32x4 kk = *(const f32x4*)(base + TC * 64), w = *(const f32x4*)(base), bb = *(const f32x4*)(base + 2 * TC * 64), k2 = *(const f32x4*)(base + 3 * TC * 64), r = *(const f32x4*)(base + 4 * TC * 64);
            float vi = vb[0];
            f32x4 kk1 = *(const f32x4*)(base + TC * 64 + 64), w1 = *(const f32x4*)(base + 64), bb1 = *(const f32x4*)(base + 2 * TC * 64 + 64), k21 = *(const f32x4*)(base + 3 * TC * 64 + 64), r1 = *(const f32x4*)(base + 4 * TC * 64 + 64);
            float vi1 = vb[64];
#pragma unroll 16
            for (int tt = 0; tt < TC; ++tt) {
                const int tn = (tt + 2 < TC) ? tt + 2 : TC - 1;
                const f32x4 nkk = *(const f32x4*)(base + TC * 64 + tn * 64), nw = *(const f32x4*)(base + tn * 64), nbb = *(const f32x4*)(base + 2 * TC * 64 + tn * 64),
                            nk2 = *(const f32x4*)(base + 3 * TC * 64 + tn * 64), nr = *(const f32x4*)(base + 4 * TC * 64 + tn * 64);
                const float nvi = vb[tn * 64];
                const f32x2 viv = {vi, vi};
                const f32x2 tp = s01 * kk.lo + s23 * kk.hi;
                float pp = tp.x + tp.y;
                const f32x2 t01 = s01 * w.lo + viv * k2.lo, t23 = s23 * w.hi + viv * k2.hi;
                if (mode == SC_DUAL) {
                    const f32x2 tq = p01 * kk.lo + p23 * kk.hi;
                    float pq = tq.x + tq.y;
                    const f32x2 u01 = p01 * w.lo, u23 = p23 * w.hi;
                    pq = row16_sum(pq);
                    const f32x2 sap = {-pq, -pq};
                    p01 = sap * bb.lo + u01; p23 = sap * bb.hi + u23;
                }
                pp = row16_sum(pp);
                const f32x2 sav = {-pp, -pp};
                s01 = sav * bb.lo + t01; s23 = sav * bb.hi + t23;
                if (mode == SC_FULL) {
                    const f32x2 uq = s01 * r.lo + s23 * r.hi;
                    float q = uq.x + uq.y;
                    q = dpp_add<0xB1>(q); q = dpp_add<0x4E>(q);
                    qdst[tt * qstep] = q;
                }
                kk = kk1; w = w1; bb = bb1; k2 = k21; r = r1; vi = vi1;
                kk1 = nkk; w1 = nw; bb1 = nbb; k21 = nk2; r1 = nr; vi1 = nvi;
            }
        }
        __syncthreads();
        if (mode == SC_FULL) {
            const int tt = tid >> 3, r2 = (tid & 7) * 2; const int m = b * SEQ + t0 + tt;
            const float4 qa = *(const float4*)(sQ + (tt * 16 + r2) * 4), qb = *(const float4*)(sQ + (tt * 16 + r2 + 1) * 4);
            *(unsigned*)(OA + (size_t)m * D + 512 + hd * 64 + rg * 16 + r2) = pk2((qa.x + qa.y) + (qa.z + qa.w), (qb.x + qb.y) + (qb.z + qb.w));
        }
    }
    const f32x4 fin = {s01.x, s01.y, s23.x, s23.y};
    if (mode == SC_FULL) {
        if (chunk == 0) *(f32x4*)(SEND0 + (size_t)seq * 4096 + row * 64 + c4) = fin;
        if (chunk == NCH - 1) *(f32x4*)(p.out + O_SP + ((size_t)((jl * 2 + b) * 8 + hd) * 64 + row) * 64 + c4) = fin;
    } else {
        *(f32x4*)(LOC + ((size_t)seq * (NCH - 2) + (chunk - 1)) * 4096 + row * 64 + c4) = fin;
        const f32x4 pf = {p01.x, p01.y, p23.x, p23.y};
        *(f32x4*)(PM + ((size_t)seq * (NCH - 2) + (chunk - 1)) * 4096 + row * 64 + c4) = pf;
    }
    __syncthreads();
}

__device__ __forceinline__ void attn_prompt_item(const P& p, const Ctx& cx, int jl, int item, char* lds) {
    const bf16_t* Z = cx.Z; bf16_t* OA = cx.OA;
    const int kvh = item & 1, qb = (item >> 1) & 63, b = item >> 7;
    const int tid = TIDX, lane = tid & 63, wave = tid >> 6, lr = lane & 31, h = lane >> 5;
    constexpr int KROW = 144, VROW = 528;
    char* sK = lds; char* sVt = lds + 256 * KROW;
#pragma unroll 2
    for (int q = 0; q < 8; ++q) {
        const int ch = tid + 256 * q, key = ch >> 3, c8 = ch & 7; const int tk = (qb - 1) * 128 + key;
        uint4 kv = make_uint4(0, 0, 0, 0), vv = kv;
        if (tk >= 0) { const bf16_t* zr = Z + (size_t)(b * SEQ + tk) * EP; kv = *(const uint4*)(zr + 512 + kvh * 64 + c8 * 8); vv = *(const uint4*)(zr + 640 + kvh * 64 + c8 * 8); }
        *(uint4*)(sK + key * KROW + c8 * 16) = kv;
        const unsigned vw[4] = {vv.x, vv.y, vv.z, vv.w};
#pragma unroll
        for (int e = 0; e < 8; ++e) *(bf16_t*)(sVt + (c8 * 8 + e) * VROW + key * 2) = (bf16_t)((e & 1) ? (vw[e >> 1] >> 16) : (vw[e >> 1] & 0xffff));
    }
    __syncthreads();
    const int qs = wave;
    const int qrow = b * SEQ + qb * 128 + qs * 32 + lr;
    const int qloc = qs * 32 + lr;
#pragma unroll 1
    for (int g = 0; g < 4; ++g) {
        const int qh = kvh * 4 + g;
        bf16x8 qf[4];
#pragma unroll
        for (int s = 0; s < 4; ++s) qf[s] = *(const bf16x8*)(Z + (size_t)qrow * EP + qh * 64 + s * 16 + h * 8);
        f32x16 sc[5];
#pragma unroll
        for (int u = 0; u < 5; ++u) {
#pragma unroll
            for (int e = 0; e < 16; ++e) sc[u][e] = 0.f;
#pragma unroll
            for (int s = 0; s < 4; ++s) {
                const bf16x8 kf = *(const bf16x8*)(sK + ((qs + u) * 32 + lr) * KROW + s * 32 + h * 16);
                sc[u] = __builtin_amdgcn_mfma_f32_32x32x16_bf16(kf, qf[s], sc[u], 0, 0, 0);
            }
            __builtin_amdgcn_sched_barrier(0);
        }
        const float sink = p.in[I_SINK][jl * 8 + qh];
        float mx = -3e38f;
#pragma unroll
        for (int u = 0; u < 5; ++u)
#pragma unroll
            for (int e = 0; e < 16; ++e) {
                const int kj = (qs + u) * 32 + (e & 3) + 8 * (e >> 2) + 4 * h;
                const int diff = 128 + qloc - kj;
                const bool vis = diff >= 0 && diff <= 128 && (qb > 0 || kj >= 128);
                const float sv = vis ? sc[u][e] * 0.125f : -1e30f;
                sc[u][e] = sv; mx = fmaxf(mx, sv);
            }
        mx = fmaxf(mx, __shfl_xor(mx, 32)); mx = fmaxf(mx, sink);
        float sum = 0.f;
#pragma unroll
        for (int u = 0; u < 5; ++u)
#pragma unroll
            for (int e = 0; e < 16; ++e) { const float pe = __expf(sc[u][e] - mx); sc[u][e] = pe; sum += pe; }
        sum += __shfl_xor(sum, 32);
        const float rden = 1.f / (sum + __expf(sink - mx));
        f32x16 oacc[2];
#pragma unroll
        for (int d2 = 0; d2 < 2; ++d2)
#pragma unroll
            for (int e = 0; e < 16; ++e) oacc[d2][e] = 0.f;
#pragma unroll
        for (int u = 0; u < 5; ++u)
#pragma unroll
            for (int s2 = 0; s2 < 2; ++s2) {
                union { bf16x8 v; unsigned w[4]; } pf;
#pragma unroll
                for (int e2 = 0; e2 < 4; ++e2) pf.w[e2] = pk2(sc[u][8 * s2 + 2 * e2] * rden, sc[u][8 * s2 + 2 * e2 + 1] * rden);
                const int kbase = (qs + u) * 32 + 16 * s2 + 4 * h;
#pragma unroll
                for (int d2 = 0; d2 < 2; ++d2) {
                    union { bf16x8 v; uint2 w[2]; } vf;
                    const char* vp = sVt + (d2 * 32 + lr) * VROW + kbase * 2;
                    vf.w[0] = *(const uint2*)vp; vf.w[1] = *(const uint2*)(vp + 16);
                    oacc[d2] = __builtin_amdgcn_mfma_f32_32x32x16_bf16(vf.v, pf.v, oacc[d2], 0, 0, 0);
                }
                __builtin_amdgcn_sched_barrier(0);
            }
#pragma unroll
        for (int d2 = 0; d2 < 2; ++d2)
#pragma unroll
            for (int g2 = 0; g2 < 4; ++g2) {
                uint2 o; o.x = pk2(oacc[d2][4 * g2], oacc[d2][4 * g2 + 1]); o.y = pk2(oacc[d2][4 * g2 + 2], oacc[d2][4 * g2 + 3]);
                *(uint2*)(OA + (size_t)qrow * D + qh * 64 + d2 * 32 + 8 * g2 + 4 * h) = o;
            }
    }
    __syncthreads();
}

__device__ __forceinline__ void attn_sample_item(const P& p, const Ctx& cx, int jl, int item, char* lds) {
    const bf16_t* Z = cx.Z; bf16_t* OA = cx.OA;
    const int kvh = item & 1, bs = item >> 1, m = MP + bs;
    const int tid = TIDX, lane = tid & 63, wave = tid >> 6, qh = kvh * 4 + wave;
    float* sq = (float*)lds + wave * 64; float* sp = (float*)lds + 256 + wave * 132;
    sq[lane] = bf2f(Z[(size_t)m * EP + qh * 64 + lane]);
    __syncthreads();
    const float* kc = p.in[I_CK] + ((size_t)(jl * 128 + bs) * 128) * 128 + kvh * 64;
    const float* vc = p.in[I_CV] + ((size_t)(jl * 128 + bs) * 128) * 128 + kvh * 64;
    float sc0 = 0.f, sc1 = 0.f, sc2 = 0.f;
#pragma unroll 4
    for (int d = 0; d < 64; d += 4) {
        const float4 k0 = *(const float4*)(kc + (size_t)lane * 128 + d), k1 = *(const float4*)(kc + (size_t)(lane + 64) * 128 + d);
        const float4 q4 = *(const float4*)(sq + d);
        sc0 += k0.x * q4.x + k0.y * q4.y + k0.z * q4.z + k0.w * q4.w; sc1 += k1.x * q4.x + k1.y * q4.y + k1.z * q4.z + k1.w * q4.w;
    }
    sc2 = wave_sum(bf2f(Z[(size_t)m * EP + 512 + kvh * 64 + lane]) * sq[lane]);
    sc0 *= 0.125f; sc1 *= 0.125f; sc2 *= 0.125f;
    const float sink = p.in[I_SINK][jl * 8 + qh];
    float mx = wave_max(fmaxf(sc0, sc1)); mx = fmaxf(fmaxf(mx, sc2), sink);
    const float p0 = __expf(sc0 - mx), p1 = __expf(sc1 - mx), p2 = __expf(sc2 - mx);
    const float den = wave_sum(p0 + p1) + p2 + __expf(sink - mx), rd = 1.f / den;
    sp[lane] = p0 * rd; sp[lane + 64] = p1 * rd; if (lane == 0) sp[128] = p2 * rd;
    __syncthreads();
    float o = 0.f;
#pragma unroll 32
    for (int j = 0; j < 128; ++j) o += sp[j] * vc[(size_t)j * 128 + lane];
    o += sp[128] * bf2f(Z[(size_t)m * EP + 640 + kvh * 64 + lane]);
    OA[(size_t)m * D + qh * 64 + lane] = f2bf(o);
    __syncthreads();
}

__device__ __forceinline__ void rwkv_sample_item(const P& p, const Ctx& cx, int jl, int item, char* lds) {
    const bf16_t* Z = cx.Z; const bf16_t* WAG = cx.WAG; bf16_t* OA = cx.OA;
    const int hd = item & 7, bs = item >> 3, m = MP + bs;
    const int tid = TIDX;
    float* sW = (float*)lds; float* sKK = sW + 64; float* sBB = sKK + 64; float* sK2 = sBB + 64; float* sR = sK2 + 64; float* sV = sR + 64;
    if (tid < 64) {
        const int c = hd * 64 + tid;
        const float r = zs_val(p, Z, jl, m, c), k = zs_val(p, Z, jl, m, 512 + c), v = zs_val(p, Z, jl, m, 1024 + c);
        const float eps = bf2f(WAG[(size_t)m * 1536 + c]), a = bf2f(WAG[(size_t)m * 1536 + 512 + c]);
        const float kkr = k * p.in[I_KK][jl * 512 + c];
        const float ssq = wave_sum(kkr * kkr);
        const float kkn = kkr / fmaxf(sqrtf(ssq), 1e-12f);
        sW[tid] = 1.f - eps; sKK[tid] = kkn; sBB[tid] = kkn * a; sK2[tid] = k * (1.f + (a - 1.f) * p.in[I_KA][jl * 512 + c]); sR[tid] = r; sV[tid] = v;
    }
    __syncthreads();
    const int i = tid >> 2, q = tid & 3;
    const float* sp = p.in[I_WKV] + ((size_t)((jl * 128 + bs) * 8 + hd) * 64 + i) * 64 + q * 16;
    float s[16]; float pp = 0.f;
#pragma unroll
    for (int e4 = 0; e4 < 4; ++e4) { const float4 v = *(const float4*)(sp + 4 * e4); s[4 * e4] = v.x; s[4 * e4 + 1] = v.y; s[4 * e4 + 2] = v.z; s[4 * e4 + 3] = v.w; }
#pragma unroll
    for (int e = 0; e < 16; ++e) pp += s[e] * sKK[q * 16 + e];
    pp += __shfl_xor(pp, 1); pp += __shfl_xor(pp, 2);
    const float sa = -pp, vi = sV[i];
    float qq = 0.f;
#pragma unroll
    for (int e = 0; e < 16; ++e) { const int j = q * 16 + e; s[e] = s[e] * sW[j] + sa * sBB[j] + vi * sK2[j]; qq += s[e] * sR[j]; }
    qq += __shfl_xor(qq, 1); qq += __shfl_xor(qq, 2);
    float* so = p.out + O_SS + ((size_t)((jl * 128 + bs) * 8 + hd) * 64 + i) * 64 + q * 16;
#pragma unroll
    for (int e4 = 0; e4 < 4; ++e4) *(float4*)(so + 4 * e4) = make_float4(s[4 * e4], s[4 * e4 + 1], s[4 * e4 + 2], s[4 * e4 + 3]);
    if (q == 0) OA[(size_t)m * D + 512 + hd * 64 + i] = f2bf(qq);
    __syncthreads();
}

__device__ __forceinline__ void mix_sample(const P& p, const Ctx& cx, int jl, char* lds) {
    for (int it = cx.bid; it < 256 + 1024; it += cx.nb) {
        if (it < 256) attn_sample_item(p, cx, jl, it, lds);
        else rwkv_sample_item(p, cx, jl, it - 256, lds);
    }
}

__device__ __forceinline__ void unpack8(const uint4& u, float (&o)[8]) { o[0] = lo16(u.x); o[1] = hi16(u.x); o[2] = lo16(u.y); o[3] = hi16(u.y); o[4] = lo16(u.z); o[5] = hi16(u.z); o[6] = lo16(u.w); o[7] = hi16(u.w); }
__device__ __forceinline__ void load8f(const float* p_, float (&o)[8]) { const float4 a = *(const float4*)p_, b = *(const float4*)(p_ + 4); o[0] = a.x; o[1] = a.y; o[2] = a.z; o[3] = a.w; o[4] = b.x; o[5] = b.y; o[6] = b.z; o[7] = b.w; }
__device__ __forceinline__ float group8_sum(float x) { x = dpp_add<0xB1>(x); x = dpp_add<0x4E>(x); x = dpp_add<0x141>(x); return x; }
__device__ __forceinline__ void post_phase(const P& p, const Ctx& cx, int jl) {
    if (cx.r0 == MP) { float* mo = cx.MOE + (size_t)MP * D; for (int i = cx.bid * NT + TIDX; i < MS * D / 4; i += cx.nb * NT) *(float4*)(mo + 4 * i) = make_float4(0.f, 0.f, 0.f, 0.f); }
    const bf16_t* Z = cx.Z; const bf16_t* WAG = cx.WAG; bf16_t* OA = cx.OA;
    const int tid = TIDX, lane = tid & 63, wave = tid >> 6, c = lane * 8;
    float mur[8], muk[8], muv[8], ka[8], rkw[8], gg[8], gb[8];
    load8f(p.in[I_MU] + jl * ZBW + c, mur); load8f(p.in[I_MU] + jl * ZBW + 512 + c, muk); load8f(p.in[I_MU] + jl * ZBW + 1024 + c, muv);
    load8f(p.in[I_KA] + jl * 512 + c, ka); load8f(p.in[I_RK] + jl * 512 + c, rkw); load8f(p.in[I_GNG] + jl * 512 + c, gg); load8f(p.in[I_GNB] + jl * 512 + c, gb);
    for (int m = cx.r0 + cx.bid * 4 + wave; m < cx.r1; m += cx.nb * 4) {
        const bf16_t* zr = Z + (size_t)m * EP + 768 + c;
        float r[8], k[8], v[8], pr[8], pk[8], pv[8], a[8], g[8], o[8];
        unpack8(*(const uint4*)zr, r); unpack8(*(const uint4*)(zr + 512), k); unpack8(*(const uint4*)(zr + 1024), v);
        unpack8(*(const uint4*)(WAG + (size_t)m * 1536 + 512 + c), a); unpack8(*(const uint4*)(WAG + (size_t)m * 1536 + 1024 + c), g);
        unpack8(*(const uint4*)(OA + (size_t)m * D + 512 + c), o);
        if (m < MP) {
            if ((m & (SEQ - 1)) == 0) {
#pragma unroll
                for (int e = 0; e < 8; ++e) { pr[e] = 0.f; pk[e] = 0.f; pv[e] = 0.f; }
            } else { unpack8(*(const uint4*)(zr - EP), pr); unpack8(*(const uint4*)(zr - EP + 512), pk); unpack8(*(const uint4*)(zr - EP + 1024), pv); }
        } else { const float* st = p.in[I_SHIFT] + (size_t)(jl * 128 + (m - MP)) * ZBW + c; load8f(st, pr); load8f(st + 512, pk); load8f(st + 1024, pv); }
        float rk = 0.f, so = 0.f;
#pragma unroll
        for (int e = 0; e < 8; ++e) {
            r[e] += (pr[e] - r[e]) * mur[e]; k[e] += (pk[e] - k[e]) * muk[e]; v[e] += (pv[e] - v[e]) * muv[e];
            const float k2 = k[e] * (1.f + (a[e] - 1.f) * ka[e]);
            rk += r[e] * k2 * rkw[e]; so += o[e];
        }
        rk = group8_sum(rk);
        const float mean = group8_sum(so) * (1.f / 64);
        float sv = 0.f;
#pragma unroll
        for (int e = 0; e < 8; ++e) { o[e] -= mean; sv += o[e] * o[e]; }
        const float rstd = rsqrtf(group8_sum(sv) * (1.f / 64) + 64e-5f);
        float res[8];
#pragma unroll
        for (int e = 0; e < 8; ++e) res[e] = (o[e] * rstd * gg[e] + gb[e] + rk * v[e]) * g[e];
        uint4 ov; ov.x = pk2(res[0], res[1]); ov.y = pk2(res[2], res[3]); ov.z = pk2(res[4], res[5]); ov.w = pk2(res[6], res[7]);
        *(uint4*)(OA + (size_t)m * D + 512 + c) = ov;
    }
}

__device__ __forceinline__ void sgu_ln_phase(const P& p, const Ctx& cx, int jo) {
    bf16_t* ZU = cx.ZU;
    const int lane = TIDX & 63, wave = TIDX >> 6;
    for (int m = cx.r0 + cx.bid * 4 + wave; m < cx.r1; m += cx.nb * 4) {
        bf16_t* vr = ZU + (size_t)m * 2048 + 1024;
        float x[16]; float s = 0.f;
#pragma unroll
        for (int q = 0; q < 2; ++q) { const uint4 u = *(const uint4*)(vr + lane * 8 + 512 * q);
            x[8 * q] = lo16(u.x); x[8 * q + 1] = hi16(u.x); x[8 * q + 2] = lo16(u.y); x[8 * q + 3] = hi16(u.y); x[8 * q + 4] = lo16(u.z); x[8 * q + 5] = hi16(u.z); x[8 * q + 6] = lo16(u.w); x[8 * q + 7] = hi16(u.w); }
#pragma unroll
        for (int e = 0; e < 16; ++e) s += x[e];
        const float mean = wave_sum(s) * (1.f / 1024);
        float s2 = 0.f;
#pragma unroll
        for (int e = 0; e < 16; ++e) { x[e] -= mean; s2 += x[e] * x[e]; }
        const float rstd = rsqrtf(wave_sum(s2) * (1.f / 1024) + 1e-5f);
#pragma unroll
        for (int q = 0; q < 2; ++q) {
            const int c = lane * 8 + 512 * q; float o[8];
#pragma unroll
            for (int e = 0; e < 8; ++e) o[e] = x[8 * q + e] * rstd * p.in[I_LNG][jo * 1024 + c + e] + p.in[I_LNB][jo * 1024 + c + e];
            uint4 ov; ov.x = pk2(o[0], o[1]); ov.y = pk2(o[2], o[3]); ov.z = pk2(o[4], o[5]); ov.w = pk2(o[6], o[7]);
            *(uint4*)(vr + c) = ov;
            if (m >= MP) { float* so = p.out + O_SGV + (size_t)(jo * 128 + (m - MP)) * 1024 + c; *(float4*)so = make_float4(o[0], o[1], o[2], o[3]); *(float4*)(so + 4) = make_float4(o[4], o[5], o[6], o[7]); }
        }
    }
}

template <bool SAMPLE>
__device__ __forceinline__ void sgu_phase(const P& p, const Ctx& cx, int jo, char* lds) {
    const bf16_t* ZU = cx.ZU; bf16_t* Y = cx.Y;
    const bf16_t* TR = (const bf16_t*)(p.ws + W_TRIL) + (size_t)jo * 8 * 128 * 128;
    const int tid = TIDX, lane = tid & 63, wave = tid >> 6, wm = wave >> 1, wn = wave & 1, lr = lane & 31, h = lane >> 5;
    constexpr int SROW = 272;
    char* sA = lds; char* sB = lds + 128 * SROW;
    if (!SAMPLE) for (int item = cx.bid; item < 1024; item += cx.nb) {
        const int hh = item & 7, n = (item >> 3) & 63, b = item >> 9;
        const int mbase = b * SEQ + n * 128;
#pragma unroll
        for (int q = 0; q < 8; ++q) {
            const int ch = tid + 256 * q, r = ch >> 4, c8 = ch & 15;
            *(uint4*)(sA + r * SROW + c8 * 16) = *(const uint4*)(TR + (size_t)hh * 16384 + r * 128 + c8 * 8);
            const uint4 vv = *(const uint4*)(ZU + (size_t)(mbase + r) * 2048 + 1024 + hh * 128 + c8 * 8);
            const unsigned vw[4] = {vv.x, vv.y, vv.z, vv.w};
#pragma unroll
            for (int e = 0; e < 8; ++e) *(bf16_t*)(sB + (c8 * 8 + e) * SROW + r * 2) = (bf16_t)((e & 1) ? (vw[e >> 1] >> 16) : (vw[e >> 1] & 0xffff));
        }
        __syncthreads();
        f32x16 acc[2][2];
#pragma unroll
        for (int i = 0; i < 2; ++i)
#pragma unroll
            for (int j = 0; j < 2; ++j)
#pragma unroll
                for (int e = 0; e < 16; ++e) acc[i][j][e] = 0.f;
#pragma unroll
        for (int ks = 0; ks < 8; ++ks) {
            bf16x8 xa[2], wb[2];
#pragma unroll
            for (int i = 0; i < 2; ++i) xa[i] = *(const bf16x8*)(sA + (wm * 64 + i * 32 + lr) * SROW + ks * 32 + h * 16);
#pragma unroll
            for (int j = 0; j < 2; ++j) wb[j] = *(const bf16x8*)(sB + (wn * 64 + j * 32 + lr) * SROW + ks * 32 + h * 16);
#pragma unroll
            for (int i = 0; i < 2; ++i)
#pragma unroll
                for (int j = 0; j < 2; ++j) acc[i][j] = __builtin_amdgcn_mfma_f32_32x32x16_bf16(wb[j], xa[i], acc[i][j], 0, 0, 0);
        }
#pragma unroll
        for (int i = 0; i < 2; ++i) {
            const int t = wm * 64 + i * 32 + lr; const float bias = p.in[I_SGUB][(jo * 8 + hh) * 128 + t];
#pragma unroll
            for (int j = 0; j < 2; ++j)
#pragma unroll
                for (int g = 0; g < 4; ++g) {
                    const int c = hh * 128 + wn * 64 + j * 32 + 8 * g + 4 * h;
                    const uint2 uu = *(const uint2*)(ZU + (size_t)(mbase + t) * 2048 + c);
                    uint2 o; o.x = pk2(lo16(uu.x) * (acc[i][j][4 * g] + bias), hi16(uu.x) * (acc[i][j][4 * g + 1] + bias));
                    o.y = pk2(lo16(uu.y) * (acc[i][j][4 * g + 2] + bias), hi16(uu.y) * (acc[i][j][4 * g + 3] + bias));
                    *(uint2*)(Y + (size_t)(mbase + t) * D + c) = o;
                }
        }
        __syncthreads();
    }
    const int gt = cx.bid * NT + tid, gs = cx.nb * NT;
    if (cx.r0 == MP) { float* mo = cx.MOE + (size_t)MP * D; for (int i = cx.bid * NT + tid; i < MS * D / 4; i += cx.nb * NT) *(float4*)(mo + 4 * i) = make_float4(0.f, 0.f, 0.f, 0.f); }
    if (SAMPLE) for (int it = gt; it < MS * 1024; it += gs) {
        const int m = MP + (it >> 10), c = it & 1023, hh = c >> 7;
        const float u = bf2f(ZU[(size_t)m * 2048 + c]), vn = bf2f(ZU[(size_t)m * 2048 + 1024 + c]);
        Y[(size_t)m * D + c] = f2bf(u * (p.in[I_SGUW][(size_t)(jo * 8 + hh) * 16384] * vn + p.in[I_SGUB][(jo * 8 + hh) * 128]));
    }
}

__device__ __forceinline__ void unpack8v(const u32x4& u, float (&o)[8]) { o[0] = lo16(u.x); o[1] = hi16(u.x); o[2] = lo16(u.y); o[3] = hi16(u.y); o[4] = lo16(u.z); o[5] = hi16(u.z); o[6] = lo16(u.w); o[7] = hi16(u.w); }
template <bool SAMPLE>
__device__ __forceinline__ void act_phase(const P& p, const Ctx& cx, int L) {
    const bf16_t* G = cx.G; bf16_t* U = cx.U;
    const int gt = cx.bid * NT + TIDX, gs = cx.nb * NT;
    const float* cw = p.in[I_CW] + (size_t)L * 3 * DFF; const float* cb = p.in[I_CB] + (size_t)L * DFF;
    constexpr int CG = DFF / 8, RC = 16;
    if (!SAMPLE) for (int it = gt; it < (MP / RC) * CG; it += gs) {
        const int m0 = (it / CG) * RC, c = (it % CG) * 8;
        float w0[8], w1[8], w2[8], bb[8], g1[8], g2[8];
        load8f(cw + c, w0); load8f(cw + DFF + c, w1); load8f(cw + 2 * DFF + c, w2); load8f(cb + c, bb);
        if ((m0 & (SEQ - 1)) == 0) {
#pragma unroll
            for (int e = 0; e < 8; ++e) { g1[e] = 0.f; g2[e] = 0.f; }
        } else { unpack8v(*(const u32x4*)(G + (size_t)(m0 - 1) * DFF + c), g1); unpack8v(*(const u32x4*)(G + (size_t)(m0 - 2) * DFF + c), g2); }
#pragma unroll
        for (int hf = 0; hf < RC / 8; ++hf) {
            u32x4 gq[8], uq[8];
#pragma unroll
            for (int r = 0; r < 8; ++r) { gq[r] = *(const u32x4*)(G + (size_t)(m0 + hf * 8 + r) * DFF + c); uq[r] = *(const u32x4*)(U + (size_t)(m0 + hf * 8 + r) * DFF + c); }
#pragma unroll
            for (int r = 0; r < 8; ++r) {
                float gc[8], uv[8], o[8];
                unpack8v(gq[r], gc); unpack8v(uq[r], uv);
#pragma unroll
                for (int e = 0; e < 8; ++e) { const float cv = bb[e] + w2[e] * gc[e] + w1[e] * g1[e] + w0[e] * g2[e]; o[e] = gelu_tanh(cv) * uv[e]; g2[e] = g1[e]; g1[e] = gc[e]; }
                u32x4 ov; ov.x = pk2(o[0], o[1]); ov.y = pk2(o[2], o[3]); ov.z = pk2(o[4], o[5]); ov.w = pk2(o[6], o[7]);
                *(u32x4*)(U + (size_t)(m0 + hf * 8 + r) * DFF + c) = ov;
            }
        }
    }
    if (cx.r0 == MP) { float* mo = cx.MOE + (size_t)MP * D; for (int i = cx.bid * NT + TIDX; i < MS * D / 4; i += cx.nb * NT) *(float4*)(mo + 4 * i) = make_float4(0.f, 0.f, 0.f, 0.f); }
    if (SAMPLE) for (int it = gt; it < MS * CG; it += gs) {
        const int m = MP + it / CG, c = (it % CG) * 8;
        float w0[8], w1[8], w2[8], bb[8], g1[8], g2[8], gc[8], uv[8], o[8];
        load8f(cw + c, w0); load8f(cw + DFF + c, w1); load8f(cw + 2 * DFF + c, w2); load8f(cb + c, bb);
        const float* st = p.in[I_CONV] + ((size_t)(L * 128 + (m - MP)) * 2) * DFF + c;
        load8f(st, g2); load8f(st + DFF, g1);
        unpack8v(*(const u32x4*)(G + (size_t)m * DFF + c), gc); unpack8v(*(const u32x4*)(U + (size_t)m * DFF + c), uv);
#pragma unroll
        for (int e = 0; e < 8; ++e) { const float cv = bb[e] + w2[e] * gc[e] + w1[e] * g1[e] + w0[e] * g2[e]; o[e] = gelu_tanh(cv) * uv[e]; }
        u32x4 ov; ov.x = pk2(o[0], o[1]); ov.y = pk2(o[2], o[3]); ov.z = pk2(o[4], o[5]); ov.w = pk2(o[6], o[7]);
        *(u32x4*)(U + (size_t)m * DFF + c) = ov;
    }
}

struct Chains { Ctx main, samp; XcdBarrier sb; };

template <bool SAMPLE>
__device__ __forceinline__ void run_op(const P& p, Chains& ch, int L, int op, char* lds, int pass = 1) {
    const Ctx& cx = SAMPLE ? ch.samp : ch.main;
    const int j = L >> 1; const bool even = (L & 1) == 0;
    bf16_t* XN = (bf16_t*)(p.ws + W_XN);
    EA ea; ea.c32 = nullptr; ea.o16 = nullptr; ea.o16b = nullptr; ea.layer = L; ea.ksplit = 1;
    if (even) {
        switch (op) {
        case 0: ea.o16 = cx.Z; ea.o16b = cx.LR; gemm_phase<EPI_EVENIN>(p, XN, D, (const bf16_t*)(p.ws + W_WINE) + (size_t)j * EP * D, EP, D, lds, ea, cx); return;
        case 1: lr_phase(p, cx, j); return;
        case 2: ea.o16 = cx.WAG; gemm_phase<EPI_LR>(p, cx.LR, 256, (const bf16_t*)(p.ws + W_WLR) + (size_t)j * 1536 * 256, 1536, 256, lds, ea, cx); return;
        case 3:
            if constexpr (SAMPLE) mix_sample(p, cx, j, lds);
            else {
                const int bidx = BIDX;
                if (pass == 1) {
                    if (bidx < SCAN_P1) {
                        if (bidx < 64) scan_task<SC_FULL>(p, cx, j, lds, bidx >> 2, bidx & 3, 0);
                        else { const int r = bidx - 64, r2 = r & 63; scan_task<SC_DUAL>(p, cx, j, lds, r2 >> 2, r2 & 3, 1 + (r >> 6)); }
                        return;
                    }
                } else {
                    if (bidx < SCAN_P2) { const int r2 = bidx & 63; scan_task<SC_FULL>(p, cx, j, lds, r2 >> 2, r2 & 3, 1 + (bidx >> 6)); return; }
                    for (int it = ch.samp.bid; it < 256; it += ch.samp.nb) attn_prompt_item(p, cx, j, it, lds);
                }
                if (pass == 1) {
#pragma unroll 1
                    for (int o2 = 0; o2 < 10; ++o2) { if (o2 == 1) continue;
                        run_op<true>(p, ch, L, o2, lds); if (o2 != 9) xcd_barrier(ch.sb); }
                } else {
                    run_op<true>(p, ch, L, 10, lds); xcd_barrier(ch.sb);
#pragma unroll 1
                    for (int o2 = 0; o2 < 9; ++o2) { run_op<true>(p, ch, L + 1, o2, lds); if (o2 != 8) xcd_barrier(ch.sb); }
                }
            }
            return;
        case 4: post_phase(p, cx, j); return;
        case 5: ea.c32 = cx.MOE; if (SAMPLE) ea.ksplit = 4; gemm_phase<EPI_F32>(p, cx.OA, D, (const bf16_t*)(p.ws + W_WOUTE) + (size_t)j * D * D, D, D, lds, ea, cx); return;
        case 6: rownorm_phase(p, cx, cx.MOE, p.in[I_NMPOST] + L * D, p.in[I_NFPRE] + L * D, L == 0); return;
        default: break;
        }
        op -= 7;
    } else {
        switch (op) {
        case 0: ea.o16 = cx.ZU; gemm_phase<EPI_ODDIN>(p, XN, D, (const bf16_t*)(p.ws + W_WINO) + (size_t)j * 2048 * D, 2048, D, lds, ea, cx); return;
        case 1: sgu_ln_phase(p, cx, j); return;
        case 2: sgu_phase<SAMPLE>(p, cx, j, lds); return;
        case 3: ea.c32 = cx.MOO; if (SAMPLE) ea.ksplit = 4; gemm_phase<EPI_F32>(p, cx.Y, D, (const bf16_t*)(p.ws + W_WOUTO) + (size_t)j * D * D, D, D, lds, ea, cx); return;
        case 4: rownorm_phase(p, cx, cx.MOO, p.in[I_NMPOST] + L * D, p.in[I_NFPRE] + L * D); return;
        default: break;
        }
        op -= 5;
    }
    switch (op) {
    case 0: ea.o16 = cx.G; ea.o16b = cx.U; gemm_phase<EPI_GU>(p, XN, D, (const bf16_t*)(p.ws + W_WGU) + (size_t)L * 2 * DFF * D, 2 * DFF, D, lds, ea, cx); return;
    case 1: act_phase<SAMPLE>(p, cx, L); return;
    case 2: ea.c32 = cx.FO; if (SAMPLE) ea.ksplit = 11; gemm_phase<EPI_F32>(p, cx.U, DFF, (const bf16_t*)(p.ws + W_WDN) + (size_t)L * D * DFF, D, DFF, lds, ea, cx); return;
    case 3: rownorm_phase(p, cx, cx.FO, p.in[I_NFPOST] + L * D, L < 3 ? p.in[I_NMPRE] + (L + 1) * D : nullptr); return;
    default: return;
    }
}

__global__ void __launch_bounds__(NT, 2) mega(P p_arg) {
    __shared__ __attribute__((aligned(16))) char lds[LDS_BYTES];
    cg::grid_group grid = cg::this_grid();
    const P& p = *(const P*)__builtin_amdgcn_kernarg_segment_ptr();
    __shared__ uint4 xb_words, xb_words2;
    unsigned* bar = (unsigned*)(p.ws + W_BAR);
    if (threadIdx.x == 0) { xb_words = make_uint4(0u, 0u, 0u, 0u); xb_words2 = make_uint4(0u, 0u, 0u, 0u); }
    __syncthreads();
    XcdBarrier xb = xcd_barrier_post(bar, (volatile LAS unsigned*)&xb_words, gridDim.x);
    p0_phase(p, lds);
    if (p.ws == nullptr) grid.sync();
    xcd_barrier(xb);
    Chains ch;
    {
        char* AR = p.ws + W_AR; char* SA = p.ws + W_SAMP;
        Ctx& m = ch.main;
        m.Z = (bf16_t*)(AR + A_Z); m.LR = (bf16_t*)(AR + A_LR); m.WAG = (bf16_t*)(AR + A_WAG); m.OA = (bf16_t*)(AR + A_OA); m.ZU = (bf16_t*)(AR + A_ZU); m.Y = (bf16_t*)(AR + A_Y);
        m.G = (bf16_t*)(AR + A_G); m.U = (bf16_t*)(AR + A_U); m.MOE = (float*)(AR + A_Z); m.MOO = (float*)(AR + A_MO_ODD); m.FO = (float*)(AR + A_G);
        m.r0 = 0; m.r1 = MP; m.bid = blockIdx.x; m.nb = gridDim.x;
        Ctx& q = ch.samp;
        q.Z = (bf16_t*)(SA + S_Z) - (size_t)MP * EP; q.LR = (bf16_t*)(SA + S_LR) - (size_t)MP * 256; q.WAG = (bf16_t*)(SA + S_WAG) - (size_t)MP * 1536; q.OA = (bf16_t*)(SA + S_OA) - (size_t)MP * D;
        q.ZU = (bf16_t*)(SA + S_ZU) - (size_t)MP * 2048; q.Y = (bf16_t*)(SA + S_Y) - (size_t)MP * D; q.G = (bf16_t*)(SA + S_G) - (size_t)MP * DFF; q.U = (bf16_t*)(SA + S_U) - (size_t)MP * DFF;
        q.MOE = (float*)(SA + S_MO) - (size_t)MP * D; q.MOO = q.MOE; q.FO = q.MOE;
        q.r0 = MP; q.r1 = M; q.bid = (int)blockIdx.x - SCAN_BLOCKS; q.nb = (int)gridDim.x - SCAN_BLOCKS;
        if ((int)blockIdx.x >= SCAN_BLOCKS) ch.sb = xcd_barrier_post(bar + 4096, (volatile LAS unsigned*)&xb_words2, gridDim.x - SCAN_BLOCKS);
        else { ch.sb.bar = bar + 4096; ch.sb.x = 0; ch.sb.st = (volatile LAS unsigned*)&xb_words2; ch.sb.G = 1; }
    }
#pragma unroll 1
    for (int L = 0; L < 4; ++L) {
        const int nops = (L & 1) ? 9 : 12;
#pragma unroll 1
        for (int op = 0; op < nops; ++op) {
            const bool ev = !(L & 1);
            run_op<false>(p, ch, L, (ev && op >= 4) ? op - 1 : op, lds, (ev && op == 4) ? 2 : 1);
            if (!(L == 3 && op == nops - 1)) xcd_barrier(xb);
        }
    }
}

extern "C" void kernel_launch(void* const* d_in, const int* in_sizes, int n_in, void* d_out, int out_size, void* d_ws, size_t ws_size, hipStream_t stream) {
    static int grid_blocks = 0;
    if (!grid_blocks) {
        if (n_in != N_IN || (size_t)out_size != O_END || ws_size < WS_NEED) {
            fprintf(stderr, "kernel_launch: unexpected shapes: n_in %d out %d (want %zu) ws %zu (need %zu)\n", n_in, out_size, (size_t)O_END, ws_size, (size_t)WS_NEED);
            if (ws_size < WS_NEED) return;
        }
        int dev = 0, cus = 0, per_cu = 0;
        hipGetDevice(&dev);
        hipDeviceGetAttribute(&cus, hipDeviceAttributeMultiprocessorCount, dev);
        hipOccupancyMaxActiveBlocksPerMultiprocessor(&per_cu, mega, NT, 0);
        if (per_cu > 2) per_cu = 2;
        if (per_cu < 1) per_cu = 1;
        grid_blocks = cus * per_cu;
        if (grid_blocks != 512) { fprintf(stderr, "kernel_launch: this kernel's phase program is laid out for 512 resident workgroups (256 CUs x 2); the device offers %d: nothing launched\n", grid_blocks); grid_blocks = -1; }
        fprintf(stderr, "kernel_launch: cus %d per_cu %d grid %d ws_need %zu ws %zu\n", cus, per_cu, grid_blocks, (size_t)WS_NEED, ws_size);
    }
    if (grid_blocks < 0) return;
    P p{};
    for (int i = 0; i < N_IN; ++i) p.in[i] = (const float*)d_in[i];
    p.out = (float*)d_out; p.ws = (char*)d_ws;
    void* args[] = {&p};
    if (hipMemsetAsync((char*)d_ws + W_BAR, 0, 32768, stream) != hipSuccess) fprintf(stderr, "kernel_launch: memset of the barrier words failed\n");
    hipError_t e = hipLaunchCooperativeKernel((void*)mega, dim3(grid_blocks), dim3(NT), args, 0, stream);
    if (e != hipSuccess) fprintf(stderr, "cooperative launch failed: %s (grid %d)\n", hipGetErrorString(e), grid_blocks);
}
```

```cpp
#include <hip/hip_runtime.h>
#include <hip/hip_cooperative_groups.h>
#include <cstdio>
namespace cg = cooperative_groups;

typedef unsigned short bf16_t;
typedef short bf16x8 __attribute__((ext_vector_type(8)));
typedef float f32x16 __attribute__((ext_vector_type(16)));

#ifndef REP
#define REP 0
#endif
constexpr int NT = 256;
constexpr int D = 1024, SEQ = 8192, NBAT = 2, MP = NBAT * SEQ, MS = 128, M = MP + MS;
constexpr int EP = 2560, DFF = 2816, ZBW = 1792;
constexpr int LDS_BYTES = 73728;

enum { I_XP = 0, I_XS, I_CK, I_CV, I_WKV, I_SHIFT, I_CONV, I_NMPRE, I_NMPOST, I_NFPRE, I_NFPOST, I_WINE, I_SINK, I_MU, I_W0, I_W2, I_A0, I_A2, I_G2,
       I_KK, I_KA, I_RK, I_GNG, I_GNB, I_WOUTE, I_WINO, I_LNG, I_LNB, I_SGUW, I_SGUB, I_WOUTO, I_WG, I_WU, I_CW, I_CB, I_WD, N_IN };
constexpr size_t O_YP = 0, O_YS = O_YP + (size_t)MP * D, O_WKP = O_YS + (size_t)MS * D, O_WVP = O_WKP + 2 * 2 * 128 * 128, O_WKS = O_WVP + 2 * 2 * 128 * 128,
                 O_WVS = O_WKS + 2 * 128 * 128, O_SP = O_WVS + 2 * 128 * 128, O_SS = O_SP + 2 * 2 * 8 * 4096, O_SHP = O_SS + (size_t)2 * 128 * 8 * 4096,
                 O_SHS = O_SHP + 2 * 2 * ZBW, O_SGV = O_SHS + 2 * 128 * ZBW, O_CP = O_SGV + 2 * 128 * 1024, O_CS = O_CP + 4 * 2 * 2 * DFF, O_END = O_CS + (size_t)4 * 128 * 2 * DFF;
constexpr size_t al(size_t x) { return (x + 255) & ~(size_t)255; }
constexpr size_t W_WINE = 0, W_WOUTE = W_WINE + (size_t)2 * EP * D * 2, W_WINO = W_WOUTE + (size_t)2 * D * D * 2, W_WOUTO = W_WINO + (size_t)2 * 2048 * D * 2,
                 W_WGU = W_WOUTO + (size_t)2 * D * D * 2, W_WDN = W_WGU + (size_t)4 * 2 * DFF * D * 2, W_WLR = W_WDN + (size_t)4 * D * DFF * 2,
                 W_TRIL = W_WLR + (size_t)2 * 1536 * 256 * 2, W_ROPE = W_TRIL + (size_t)2 * 8 * 128 * 128 * 2, W_XN = al(W_ROPE + (size_t)8193 * 32 * 2 * 4),
                 W_AR = al(W_XN + (size_t)M * D * 2);
constexpr size_t A_Z = 0, A_LR = al(A_Z + (size_t)M * EP * 2), A_WAG = al(A_LR + (size_t)M * 256 * 2), A_OA = al(A_WAG + (size_t)M * 1536 * 2), A_EVEN_END = A_OA + (size_t)M * D * 2;
constexpr size_t A_ZU = 0, A_Y = al(A_ZU + (size_t)M * 2048 * 2), A_MO_ODD = al(A_Y + (size_t)M * D * 2);
constexpr size_t A_G = 0, A_U = al(A_G + (size_t)M * DFF * 2), A_FFN_END = A_U + (size_t)M * DFF * 2;
constexpr size_t W_BAR = al(W_AR + A_FFN_END);
constexpr size_t W_SAMP = W_BAR + 32768;
constexpr size_t S_Z = 0, S_LR = S_Z + (size_t)MS * EP * 2, S_WAG = S_LR + (size_t)MS * 256 * 2, S_OA = S_WAG + (size_t)MS * 1536 * 2, S_ZU = S_OA + (size_t)MS * D * 2,
                 S_Y = S_ZU + (size_t)MS * 2048 * 2, S_G = S_Y + (size_t)MS * D * 2, S_U = S_G + (size_t)MS * DFF * 2, S_MO = S_U + (size_t)MS * DFF * 2, S_END = S_MO + (size_t)MS * D * 4;
constexpr size_t W_SCN = al(W_SAMP + S_END);
constexpr size_t WS_NEED = W_SCN + (size_t)16 * 7 * 4096 * 4;

struct P { const float* in[N_IN]; float* out; char* ws; };
struct Ctx { bf16_t *Z, *LR, *WAG, *OA, *ZU, *Y, *G, *U; float *MOE, *MOO, *FO; int r0, r1, bid, nb; };

__device__ __forceinline__ int opaque_tid() { int t = threadIdx.x; asm volatile("" : "+v"(t)); return t; }
__device__ __forceinline__ int opaque_bid() { int t = blockIdx.x; asm volatile("" : "+s"(t)); return t; }
#define TIDX opaque_tid()
#define BIDX opaque_bid()
__device__ __forceinline__ bf16_t f2bf(float f) { unsigned u = __float_as_uint(f); u += 0x7fffu + ((u >> 16) & 1u); return (bf16_t)(u >> 16); }
__device__ __forceinline__ float bf2f(bf16_t h) { return __uint_as_float(((unsigned)h) << 16); }
__device__ __forceinline__ unsigned pk2(float a, float b) { return (unsigned)f2bf(a) | ((unsigned)f2bf(b) << 16); }
__device__ __forceinline__ float lo16(unsigned u) { return __uint_as_float(u << 16); }
__device__ __forceinline__ float hi16(unsigned u) { return __uint_as_float(u & 0xffff0000u); }
__device__ __forceinline__ float wave_sum(float v) {
#pragma unroll
    for (int o = 32; o > 0; o >>= 1) v += __shfl_xor(v, o);
    return v;
}
__device__ __forceinline__ float wave_max(float v) {
#pragma unroll
    for (int o = 32; o > 0; o >>= 1) v = fmaxf(v, __shfl_xor(v, o));
    return v;
}
__device__ __forceinline__ float sigmoidf_(float x) { return __builtin_amdgcn_rcpf(1.f + __expf(-x)); }
__device__ __forceinline__ float tanh_fast(float x) { return 1.f - 2.f * __builtin_amdgcn_rcpf(1.f + __expf(2.f * x)); }
__device__ __forceinline__ float gelu_erf(float v) {
    const float t = __builtin_amdgcn_rcpf(fabsf(v) * 0.2316418882f + 1.0f);
    float q = t * 0.5307027145f + (-0.7265760135f); q = q * t + 0.7107068705f; q = q * t + (-0.142248368f); q = q * t + 0.127414796f; q = q * t;
    const float m = v * (q * __builtin_amdgcn_exp2f((v * v) * (-0.72134752044f)));
    return v < 0.f ? m : v - m;
}
__device__ __forceinline__ float gelu_tanh(float x) { const float u2 = 1.5957691216057308f * (x + 0.044715f * x * x * x); return x * __frcp_rn(1.f + __expf(-u2)); }
template <int CTRL> __device__ __forceinline__ float dpp_add(float x) {
    int y = __builtin_amdgcn_update_dpp(0, __float_as_int(x), CTRL, 0xf, 0xf, false);
    return x + __int_as_float(y);
}
__device__ __forceinline__ float row16_sum(float x) {
    x = dpp_add<0xB1>(x); x = dpp_add<0x4E>(x); x = dpp_add<0x141>(x); x = dpp_add<0x140>(x); return x;
}


#define XB_TMO      128
#define XB_XCNT(j)  (256  + 64 * (j))
#define XB_XSUB(j)  (1280 + 64 * (j))
#define XB_XGEN(j)  (2304 + 64 * (j))
#define XB_TOP      3328
#define XB_TOPGEN   3392
#define XCD_BAR_WORDS 3456
#define XB_SPIN_CAP (1u << 20)
#define LAS __attribute__((address_space(3)))
__device__ __forceinline__ unsigned xb_ld(unsigned* p)              { return __hip_atomic_load(p, __ATOMIC_RELAXED, __HIP_MEMORY_SCOPE_AGENT); }
__device__ __forceinline__ unsigned xb_add(unsigned* p, unsigned v) { return __hip_atomic_fetch_add(p, v, __ATOMIC_RELAXED, __HIP_MEMORY_SCOPE_AGENT); }
__device__ __forceinline__ unsigned xb_xcc_id() { return (unsigned)__builtin_amdgcn_s_getreg((3 << 11) | 20) & 0xFu; }
#define XB_SPIN(cond, bar) do { unsigned _sp = 0; while (cond) { __builtin_amdgcn_s_sleep(1); \
    if ((++_sp & 255u) == 0u) { if (xb_ld(&(bar)[XB_TMO])) break; if (_sp > XB_SPIN_CAP) { atomicAdd(&(bar)[XB_TMO], 1u); break; } } } } while (0)
struct XcdBarrier { unsigned* bar; unsigned x; volatile LAS unsigned* st; unsigned G; };
__device__ __forceinline__ XcdBarrier xcd_barrier_post(unsigned* bar, volatile LAS unsigned* st, unsigned G) {
    XcdBarrier b; b.bar = bar; b.x = xb_xcc_id(); b.st = st; b.G = G;
    if (threadIdx.x == 0) (void)xb_add(&bar[XB_XCNT(b.x)], 1u);
    return b;
}
__device__ __forceinline__ void xcd_barrier_complete(unsigned* bar, unsigned x, unsigned G, unsigned& nloc, unsigned& nx) {
    unsigned sum, cnt, mine, sp = 0u;
    for (;;) {
        sum = 0u; cnt = 0u; mine = 0u;
#pragma unroll
        for (unsigned j = 0; j < 16; ++j) { const unsigned c = xb_ld(&bar[XB_XCNT(j)]); sum += c; cnt += (c > 0u) ? 1u : 0u; mine = (j == x) ? c : mine; }
        if (sum == G) break;
        __builtin_amdgcn_s_sleep(1);
        if ((++sp & 255u) == 0u) { if (xb_ld(&bar[XB_TMO])) break; if (sp > XB_SPIN_CAP) { atomicAdd(&bar[XB_TMO], 1u); break; } }
    }
    nloc = mine > 0u ? mine : 1u; nx = cnt > 0u ? cnt : 1u;
}
__device__ __forceinline__ void xcd_barrier(const XcdBarrier& b) {
    asm volatile("s_waitcnt vmcnt(0)" ::: "memory");
    __syncthreads();
    if (threadIdx.x == 0) {
        unsigned* bar = b.bar;
        __builtin_amdgcn_s_waitcnt(0);
        unsigned nloc = b.st[0], nx = b.st[1];
        if (nloc == 0u) { xcd_barrier_complete(bar, b.x, b.G, nloc, nx); b.st[0] = nloc; b.st[1] = nx; }
        const unsigned old = xb_add(&bar[XB_XSUB(b.x)], 1u);
        const unsigned gen = old / nloc;
        if (old + 1u == (gen + 1u) * nloc) {
            __builtin_amdgcn_fence(__ATOMIC_RELEASE, "agent");
            asm volatile("s_waitcnt vmcnt(0)" ::: "memory");
            const unsigned og = xb_add(&bar[XB_TOP], 1u);
            const unsigned tg = og / nx;
            if (og + 1u == (tg + 1u) * nx) xb_add(&bar[XB_TOPGEN], 1u);
            else XB_SPIN(xb_ld(&bar[XB_TOPGEN]) == tg, bar);
            __builtin_amdgcn_fence(__ATOMIC_ACQUIRE, "agent");
            xb_add(&bar[XB_XGEN(b.x)], 1u);
            asm volatile("s_waitcnt vmcnt(0)" ::: "memory");
        } else {
            XB_SPIN(xb_ld(&bar[XB_XGEN(b.x)]) == gen, bar);
            __builtin_amdgcn_fence(__ATOMIC_ACQUIRE, "agent");
            asm volatile("s_waitcnt vmcnt(0)" ::: "memory");
        }
    }
    __syncthreads();
}

__device__ __forceinline__ void rownorm_store(const float (&hv)[16], const float* g, bf16_t* xnrow, int lane) {
    float ss = 0.f;
#pragma unroll
    for (int e = 0; e < 16; ++e) ss += hv[e] * hv[e];
    ss = wave_sum(ss);
    const float rs = rsqrtf(ss * (1.f / D) + 1e-6f);
#pragma unroll
    for (int q = 0; q < 4; ++q) {
        const int c = lane * 4 + 256 * q;
        const float4 gv = *(const float4*)(g + c);
        uint2 o; o.x = pk2(hv[4 * q] * rs * gv.x, hv[4 * q + 1] * rs * gv.y); o.y = pk2(hv[4 * q + 2] * rs * gv.z, hv[4 * q + 3] * rs * gv.w);
        *(uint2*)(xnrow + c) = o;
    }
}

__device__ __forceinline__ void p0_phase(const P& p, char* lds) {
    const int tid = TIDX, lane = tid & 63, wave = tid >> 6;
    float* tl = (float*)lds;
    constexpr int TR_ITEMS = 11776;
    for (int it = BIDX; it < TR_ITEMS; it += gridDim.x) {
        const float* src; bf16_t* dst; int K, N; int r = it;
        if (r < 1280) { int jl = r / 640; r %= 640; src = p.in[I_WINE] + (size_t)jl * D * EP; dst = (bf16_t*)(p.ws + W_WINE) + (size_t)jl * EP * D; K = D; N = EP; }
        else if ((r -= 1280) < 512) { int jl = r / 256; r %= 256; src = p.in[I_WOUTE] + (size_t)jl * D * D; dst = (bf16_t*)(p.ws + W_WOUTE) + (size_t)jl * D * D; K = D; N = D; }
        else if ((r -= 512) < 1024) { int jl = r / 512; r %= 512; src = p.in[I_WINO] + (size_t)jl * D * 2048; dst = (bf16_t*)(p.ws + W_WINO) + (size_t)jl * 2048 * D; K = D; N = 2048; }
        else if ((r -= 1024) < 512) { int jl = r / 256; r %= 256; src = p.in[I_WOUTO] + (size_t)jl * D * D; dst = (bf16_t*)(p.ws + W_WOUTO) + (size_t)jl * D * D; K = D; N = D; }
        else if ((r -= 512) < 2816) { int L = r / 704; r %= 704; src = p.in[I_WG] + (size_t)L * D * DFF; dst = (bf16_t*)(p.ws + W_WGU) + (size_t)L * 2 * DFF * D; K = D; N = DFF; }
        else if ((r -= 2816) < 2816) { int L = r / 704; r %= 704; src = p.in[I_WU] + (size_t)L * D * DFF; dst = (bf16_t*)(p.ws + W_WGU) + (size_t)L * 2 * DFF * D + (size_t)DFF * D; K = D; N = DFF; }
        else { r -= 2816; int L = r / 704; r %= 704; src = p.in[I_WD] + (size_t)L * DFF * D; dst = (bf16_t*)(p.ws + W_WDN) + (size_t)L * D * DFF; K = DFF; N = D; }
        const int nb = N / 64, k0 = (r / nb) * 64, n0 = (r % nb) * 64;
#pragma unroll
        for (int q = 0; q < 4; ++q) {
            const int row = (tid >> 4) + 16 * q, c4 = (tid & 15) * 4;
            const float4 v = *(const float4*)(src + (size_t)(k0 + row) * N + n0 + c4);
            tl[row * 65 + c4] = v.x; tl[row * 65 + c4 + 1] = v.y; tl[row * 65 + c4 + 2] = v.z; tl[row * 65 + c4 + 3] = v.w;
        }
        __syncthreads();
#pragma unroll
        for (int q = 0; q < 2; ++q) {
            const int ch = tid + 256 * q, n = ch >> 3, k8 = ch & 7;
            uint4 o;
            o.x = pk2(tl[(k8 * 8 + 0) * 65 + n], tl[(k8 * 8 + 1) * 65 + n]); o.y = pk2(tl[(k8 * 8 + 2) * 65 + n], tl[(k8 * 8 + 3) * 65 + n]);
            o.z = pk2(tl[(k8 * 8 + 4) * 65 + n], tl[(k8 * 8 + 5) * 65 + n]); o.w = pk2(tl[(k8 * 8 + 6) * 65 + n], tl[(k8 * 8 + 7) * 65 + n]);
            *(uint4*)(dst + (size_t)(n0 + n) * K + k0 + k8 * 8) = o;
        }
        __syncthreads();
    }
    const int gt = BIDX * NT + tid, gs = gridDim.x * NT;
    {
        bf16_t* wlr = (bf16_t*)(p.ws + W_WLR);
        for (int e = gt; e < 2 * 1536 * 256; e += gs) {
            const int jl = e / (1536 * 256), n = (e / 256) % 1536, k = e & 255;
            float v = 0.f;
            if (n < 512) { if (k < 64) v = p.in[I_W2][(size_t)jl * 64 * 512 + k * 512 + n]; }
            else if (n < 1024) { if (k >= 64 && k < 128) v = p.in[I_A2][(size_t)jl * 64 * 512 + (k - 64) * 512 + (n - 512)]; }
            else { if (k >= 128) v = p.in[I_G2][(size_t)jl * 128 * 512 + (k - 128) * 512 + (n - 1024)]; }
            wlr[e] = f2bf(v);
        }
        bf16_t* tr = (bf16_t*)(p.ws + W_TRIL);
        for (int e = gt; e < 2 * 8 * 128 * 128; e += gs) { const int t = (e >> 7) & 127, s = e & 127; tr[e] = f2bf(s <= t ? p.in[I_SGUW][e] : 0.f); }
        float* rope = (float*)(p.ws + W_ROPE);
        for (int e = gt; e < 8193 * 32; e += gs) {
            const int pos = e >> 5, i = e & 31;
            double inv = 1.0; for (int q = 0; q < i; ++q) inv *= 0.7498942093324559;
            double x = (double)pos * inv;
            const double TWO_PI = 6.283185307179586;
            double n = rint(x / TWO_PI); x -= n * TWO_PI;
            double qd = rint(x / 1.5707963267948966); double r = x - qd * 1.5707963267948966; int qi = ((int)qd) & 3;
            double r2 = r * r;
            double sn = r * (1.0 + r2 * (-1.0 / 6 + r2 * (1.0 / 120 + r2 * (-1.0 / 5040 + r2 * (1.0 / 362880 + r2 * (-1.0 / 39916800 + r2 * (1.0 / 6227020800.0)))))));
            double cs = 1.0 + r2 * (-0.5 + r2 * (1.0 / 24 + r2 * (-1.0 / 720 + r2 * (1.0 / 40320 + r2 * (-1.0 / 3628800 + r2 * (1.0 / 479001600.0))))));
            double c, s;
            if (qi == 0) { c = cs; s = sn; } else if (qi == 1) { c = -sn; s = cs; } else if (qi == 2) { c = -cs; s = -sn; } else { c = sn; s = -cs; }
            rope[e] = (float)c; rope[8193 * 32 + e] = (float)s;
        }
    }
    for (int row = BIDX * 4 + wave; row < M; row += gridDim.x * 4) {
        const float* xr = row < MP ? p.in[I_XP] + (size_t)row * D : p.in[I_XS] + (size_t)(row - MP) * D;
        float hv[16];
#pragma unroll
        for (int q = 0; q < 4; ++q) { const float4 v = *(const float4*)(xr + lane * 4 + 256 * q); hv[4 * q] = v.x; hv[4 * q + 1] = v.y; hv[4 * q + 2] = v.z; hv[4 * q + 3] = v.w; }
        rownorm_store(hv, p.in[I_NMPRE], (bf16_t*)(p.ws + W_XN) + (size_t)row * D, lane);
    }
}

typedef float f32x4v __attribute__((ext_vector_type(4)));
__device__ __forceinline__ void rownorm_phase(const P& p, const Ctx& cx, const float* mo, const float* gpost, const float* gnext, bool first = false) {
    const int lane = TIDX & 63, wave = TIDX >> 6;
    const int stride = cx.nb * 4;
    f32x4v gp[4], gn[4];
#pragma unroll
    for (int q = 0; q < 4; ++q) { gp[q] = *(const f32x4v*)(gpost + lane * 4 + 256 * q); gn[q] = gnext ? *(const f32x4v*)(gnext + lane * 4 + 256 * q) : (f32x4v){0.f, 0.f, 0.f, 0.f}; }
    for (int row = cx.r0 + cx.bid * 4 + wave; row < cx.r1; row += 2 * stride) {
        const int rowb = row + stride; const bool hasb = rowb < cx.r1; const int rb = hasb ? rowb : row;
        f32x4v ma[4], ha[4], mb[4], hb[4];
        float* hra = p.out + (size_t)row * D + lane * 4; float* hrb = p.out + (size_t)rb * D + lane * 4;
#pragma unroll
        for (int q = 0; q < 4; ++q) { ma[q] = *(const f32x4v*)(mo + (size_t)row * D + lane * 4 + 256 * q); mb[q] = *(const f32x4v*)(mo + (size_t)rb * D + lane * 4 + 256 * q); }
        const float* hsa = first ? (row < MP ? p.in[I_XP] + (size_t)row * D : p.in[I_XS] + (size_t)(row - MP) * D) + lane * 4 : hra;
        const float* hsb = first ? (rb < MP ? p.in[I_XP] + (size_t)rb * D : p.in[I_XS] + (size_t)(rb - MP) * D) + lane * 4 : hrb;
#pragma unroll
        for (int q = 0; q < 4; ++q) { ha[q] = *(const f32x4v*)(hsa + 256 * q); hb[q] = *(const f32x4v*)(hsb + 256 * q); }
        float sa = 0.f, sb = 0.f;
#pragma unroll
        for (int q = 0; q < 4; ++q) { const f32x4v a2 = ma[q] * ma[q], b2 = mb[q] * mb[q]; sa += (a2.x + a2.y) + (a2.z + a2.w); sb += (b2.x + b2.y) + (b2.z + b2.w); }
#pragma unroll
        for (int o = 32; o > 0; o >>= 1) { sa += __shfl_xor(sa, o); sb += __shfl_xor(sb, o); }
        const float rsa = rsqrtf(sa * (1.f / D) + 1e-6f), rsb = rsqrtf(sb * (1.f / D) + 1e-6f);
        float ta = 0.f, tb = 0.f;
#pragma unroll
        for (int q = 0; q < 4; ++q) {
            ha[q] = ha[q] + ma[q] * rsa * gp[q]; hb[q] = hb[q] + mb[q] * rsb * gp[q];
            *(f32x4v*)(hra + 256 * q) = ha[q]; if (hasb) *(f32x4v*)(hrb + 256 * q) = hb[q];
            const f32x4v a2 = ha[q] * ha[q], b2 = hb[q] * hb[q]; ta += (a2.x + a2.y) + (a2.z + a2.w); tb += (b2.x + b2.y) + (b2.z + b2.w);
        }
        if (gnext) {
#pragma unroll
            for (int o = 32; o > 0; o >>= 1) { ta += __shfl_xor(ta, o); tb += __shfl_xor(tb, o); }
            const float ra = rsqrtf(ta * (1.f / D) + 1e-6f), rbb = rsqrtf(tb * (1.f / D) + 1e-6f);
            bf16_t* xa = (bf16_t*)(p.ws + W_XN) + (size_t)row * D + lane * 4; bf16_t* xb = (bf16_t*)(p.ws + W_XN) + (size_t)rb * D + lane * 4;
#pragma unroll
            for (int q = 0; q < 4; ++q) {
                const f32x4v ya = ha[q] * ra * gn[q], yb = hb[q] * rbb * gn[q];
                uint2 oa; oa.x = pk2(ya.x, ya.y); oa.y = pk2(ya.z, ya.w); *(uint2*)(xa + 256 * q) = oa;
                if (hasb) { uint2 ob; ob.x = pk2(yb.x, yb.y); ob.y = pk2(yb.z, yb.w); *(uint2*)(xb + 256 * q) = ob; }
            }
        }
    }
}

constexpr int BM = 128, BN = 128, BK = 64, LROW = 144  , OPB = 128 * LROW  , STG = 2 * OPB;
enum { EPI_F32 = 0, EPI_EVENIN, EPI_LR, EPI_GU, EPI_ODDIN };
struct EA { float* c32; bf16_t* o16; bf16_t* o16b; int layer; int ksplit; };

template <int EPI>
__device__ __forceinline__ void gemm_epilogue(const P& p, const f32x16 (&acc)[2][2], int m0, int n0, int wm, int wn, int lane, const EA& ea, int N) {
    const int h = lane >> 5, lr = lane & 31;
    const int jl = ea.layer >> 1;
#pragma unroll
    for (int i = 0; i < 2; ++i) {
        const int m = m0 + wm * 64 + i * 32 + lr;
        const int hb = n0 + wn * 64;
        float v[2][16];
#pragma unroll
        for (int j = 0; j < 2; ++j)
#pragma unroll
            for (int e = 0; e < 16; ++e) v[j][e] = acc[i][j][e];
        if (EPI == EPI_EVENIN) {
            const bool prompt = m < MP; const int t = m & (SEQ - 1), b = m >> 13, bs = m - MP;
            if (hb < 640) {
                const int pos = prompt ? t : SEQ;
                const float* rc = (const float*)(p.ws + W_ROPE) + (size_t)pos * 32; const float* rsn = rc + 8193 * 32;
#pragma unroll
                for (int g = 0; g < 4; ++g) {
                    const float4 c4 = *(const float4*)(rc + 8 * g + 4 * h), s4 = *(const float4*)(rsn + 8 * g + 4 * h);
                    const float cc[4] = {c4.x, c4.y, c4.z, c4.w}, sn[4] = {s4.x, s4.y, s4.z, s4.w};
#pragma unroll
                    for (int e = 0; e < 4; ++e) { const float x1 = v[0][4 * g + e], x2 = v[1][4 * g + e]; v[0][4 * g + e] = x1 * cc[e] - x2 * sn[e]; v[1][4 * g + e] = x2 * cc[e] + x1 * sn[e]; }
                }
            }
#pragma unroll
            for (int j = 0; j < 2; ++j)
#pragma unroll
                for (int g = 0; g < 4; ++g) {
                    const int dc = j * 32 + 8 * g + 4 * h;
                    uint2 o; o.x = pk2(v[j][4 * g], v[j][4 * g + 1]); o.y = pk2(v[j][4 * g + 2], v[j][4 * g + 3]);
                    *(uint2*)(ea.o16 + (size_t)m * EP + hb + dc) = o;
                    const float4 f4 = make_float4(v[j][4 * g], v[j][4 * g + 1], v[j][4 * g + 2], v[j][4 * g + 3]);
                    if (hb >= 512 && hb < 768) {
                        const int kvh = ((hb - 512) >> 6) & 1; const bool isv = hb >= 640;
                        if (prompt) { if (t >= SEQ - 128) *(float4*)(p.out + (isv ? O_WVP : O_WKP) + ((size_t)((jl * 2 + b) * 128 + (t - (SEQ - 128))) * 2 + kvh) * 64 + dc) = f4; }
                        else *(float4*)(p.out + (isv ? O_WVS : O_WKS) + ((size_t)(jl * 128 + bs) * 2 + kvh) * 64 + dc) = f4;
                    } else if (hb >= 768) {
                        const int zc = hb - 768 + dc;
                        if (prompt) { if (t == SEQ - 1) *(float4*)(p.out + O_SHP + (size_t)(jl * 2 + b) * ZBW + zc) = f4; }
                        else {
                            *(float4*)(p.out + O_SHS + (size_t)(jl * 128 + bs) * ZBW + zc) = f4;
                            if (zc >= 1536) {
                                const float4 pv = *(const float4*)(p.in[I_SHIFT] + (size_t)(jl * 128 + bs) * ZBW + zc), mu4 = *(const float4*)(p.in[I_MU] + jl * ZBW + zc);
                                const float pr[4] = {pv.x, pv.y, pv.z, pv.w}, mm[4] = {mu4.x, mu4.y, mu4.z, mu4.w}; float lo[4];
                                const int c = zc - 1536;
                                const float vq[4] = {f4.x, f4.y, f4.z, f4.w};
#pragma unroll
                                for (int e = 0; e < 4; ++e) { const float zs = vq[e] + (pr[e] - vq[e]) * mm[e]; lo[e] = c < 64 ? tanh_fast(zs) : (c < 128 ? zs : sigmoidf_(zs)); }
                                uint2 ol; ol.x = pk2(lo[0], lo[1]); ol.y = pk2(lo[2], lo[3]);
                                *(uint2*)(ea.o16b + (size_t)m * 256 + c) = ol;
                            }
                        }
                    }
                }
        } else {
#pragma unroll
            for (int j = 0; j < 2; ++j)
#pragma unroll
                for (int g = 0; g < 4; ++g) {
                    const int col = hb + j * 32 + 8 * g + 4 * h;
                    float x0 = v[j][4 * g], x1 = v[j][4 * g + 1], x2 = v[j][4 * g + 2], x3 = v[j][4 * g + 3];
                    if (EPI == EPI_F32) {
                        float* cp = ea.c32 + (size_t)m * N + col;
                        if (ea.ksplit > 1) { atomicAdd(cp, x0); atomicAdd(cp + 1, x1); atomicAdd(cp + 2, x2); atomicAdd(cp + 3, x3); }
                        else *(float4*)cp = make_float4(x0, x1, x2, x3);
                    } else if (EPI == EPI_ODDIN) {
                        uint2 o; o.x = pk2(gelu_erf(x0), gelu_erf(x1)); o.y = pk2(gelu_erf(x2), gelu_erf(x3));
                        *(uint2*)(ea.o16 + (size_t)m * 2048 + col) = o;
                    } else if (EPI == EPI_LR) {
                        float xs[4] = {x0, x1, x2, x3};
                        if (col < 512) {
                            const float4 w0 = *(const float4*)(p.in[I_W0] + jl * 512 + col); const float ww[4] = {w0.x, w0.y, w0.z, w0.w};
#pragma unroll
                            for (int e = 0; e < 4; ++e) xs[e] = 1.f - __expf(-0.606531f * sigmoidf_(xs[e] + ww[e]));
                        } else if (col < 1024) {
                            const float4 a0 = *(const float4*)(p.in[I_A0] + jl * 512 + col - 512); const float aa[4] = {a0.x, a0.y, a0.z, a0.w};
#pragma unroll
                            for (int e = 0; e < 4; ++e) xs[e] = sigmoidf_(xs[e] + aa[e]);
                        }
                        uint2 o; o.x = pk2(xs[0], xs[1]); o.y = pk2(xs[2], xs[3]);
                        *(uint2*)(ea.o16 + (size_t)m * 1536 + col) = o;
                    } else if (EPI == EPI_GU) {
                        uint2 o; o.x = pk2(x0, x1); o.y = pk2(x2, x3);
                        if (col < DFF) {
                            *(uint2*)(ea.o16 + (size_t)m * DFF + col) = o;
                            const int L = ea.layer;
                            if (m < MP) { const int t = m & (SEQ - 1), b = m >> 13; if (t >= SEQ - 2) *(float4*)(p.out + O_CP + ((size_t)(L * 2 + b) * 2 + (t - (SEQ - 2))) * DFF + col) = make_float4(x0, x1, x2, x3); }
                            else { const int bs = m - MP; const size_t base = ((size_t)(L * 128 + bs) * 2) * DFF + col;
                                *(float4*)(p.out + O_CS + base + DFF) = make_float4(x0, x1, x2, x3);
                                *(float4*)(p.out + O_CS + base) = *(const float4*)(p.in[I_CONV] + base + DFF); }
                        } else *(uint2*)(ea.o16b + (size_t)m * DFF + col - DFF) = o;
                    }
                }
        }
    }
}

typedef unsigned u32x4 __attribute__((ext_vector_type(4)));
struct Stg { u32x4 a0, a1, a2, a3, b0, b1, b2, b3; };
__device__ __forceinline__ void stg_load(Stg& r, const bf16_t* ga, const bf16_t* gb, size_t sa, size_t sb) {
    r.a0 = *(const u32x4*)(ga); r.a1 = *(const u32x4*)(ga + sa); r.a2 = *(const u32x4*)(ga + 2 * sa); r.a3 = *(const u32x4*)(ga + 3 * sa);
    r.b0 = *(const u32x4*)(gb); r.b1 = *(const u32x4*)(gb + sb); r.b2 = *(const u32x4*)(gb + 2 * sb); r.b3 = *(const u32x4*)(gb + 3 * sb);
}
__device__ __forceinline__ void stg_store(const Stg& r, char* w) {
    *(u32x4*)(w) = r.a0; *(u32x4*)(w + 32 * LROW) = r.a1; *(u32x4*)(w + 64 * LROW) = r.a2; *(u32x4*)(w + 96 * LROW) = r.a3;
    *(u32x4*)(w + OPB) = r.b0; *(u32x4*)(w + OPB + 32 * LROW) = r.b1; *(u32x4*)(w + OPB + 64 * LROW) = r.b2; *(u32x4*)(w + OPB + 96 * LROW) = r.b3;
}
__device__ __forceinline__ void gemm_ktile(f32x16 (&acc)[2][2], const char* sA, const char* sB) {
    __builtin_amdgcn_s_setprio(1);
#pragma unroll
    for (int ks = 0; ks < 4; ++ks) {
        bf16x8 xa[2], wb[2];
#pragma unroll
        for (int i = 0; i < 2; ++i) xa[i] = *(const bf16x8*)(sA + i * 32 * LROW + ks * 32);
#pragma unroll
        for (int j = 0; j < 2; ++j) wb[j] = *(const bf16x8*)(sB + j * 32 * LROW + ks * 32);
#pragma unroll
        for (int i = 0; i < 2; ++i)
#pragma unroll
            for (int j = 0; j < 2; ++j) acc[i][j] = __builtin_amdgcn_mfma_f32_32x32x16_bf16(wb[j], xa[i], acc[i][j], 0, 0, 0);
    }
    __builtin_amdgcn_s_setprio(0);
}
template <int EPI>
__device__ __forceinline__ void gemm_phase(const P& p, const bf16_t* __restrict__ A, int lda, const bf16_t* __restrict__ Bt, int N, int K, char* lds, EA ea, const Ctx& cx) {
    const int tid = TIDX, lane = tid & 63, wave = tid >> 6, wm = wave >> 1, wn = wave & 1;
    const int ks_n = ea.ksplit, ntn = N / BN, mt0 = cx.r0 / BM, ntiles = ((cx.r1 - cx.r0) / BM) * ntn * ks_n, nk = K / BK / ks_n;
    const int lrow = tid >> 3, lc8 = tid & 7;
    const size_t sa = (size_t)32 * lda, sb = (size_t)32 * K;
    for (int tile = cx.bid; tile < ntiles; tile += cx.nb) {
        const int kpart = tile % ks_n, t2 = tile / ks_n;
        int mt, nt;
        if (cx.r0 == 0 && (cx.nb & 7) == 0) {
            const int x = cx.bid & 7, per = cx.nb >> 3, i = (cx.bid >> 3) + per * ((tile - cx.bid) / cx.nb);
            const int mi = i & 7, rest = i >> 3, nn = rest % ntn, mg = rest / ntn;
            mt = 16 * x + 8 * mg + mi; nt = nn;
        } else { mt = mt0 + t2 / ntn; nt = t2 % ntn; }
        const int m0 = mt * BM, n0 = nt * BN;
        const bf16_t* ga = A + (size_t)(m0 + lrow) * lda + lc8 * 8 + kpart * nk * BK;
        const bf16_t* gb = Bt + (size_t)(n0 + lrow) * K + lc8 * 8 + kpart * nk * BK;
        Stg r0, r1;
        stg_load(r0, ga, gb, sa, sb);
        stg_load(r1, ga + BK, gb + BK, sa, sb);
        f32x16 acc[2][2];
#pragma unroll
        for (int i = 0; i < 2; ++i)
#pragma unroll
            for (int j = 0; j < 2; ++j)
#pragma unroll
                for (int e = 0; e < 16; ++e) acc[i][j][e] = 0.f;
        char* wA = lds + lrow * LROW + lc8 * 16;
        stg_store(r0, wA);
        __syncthreads();
        const char* sA0 = lds + (wm * 64 + (lane & 31)) * LROW + (lane >> 5) * 16;
        const char* sB0 = lds + OPB + (wn * 64 + (lane & 31)) * LROW + (lane >> 5) * 16;
        for (int kt = 0; kt < nk; kt += 2) {
            if (kt + 2 < nk) stg_load(r0, ga + (kt + 2) * BK, gb + (kt + 2) * BK, sa, sb);
            __builtin_amdgcn_sched_barrier(0);
            gemm_ktile(acc, sA0, sB0);
            stg_store(r1, wA + STG);
            __syncthreads();
            if (kt + 3 < nk) stg_load(r1, ga + (kt + 3) * BK, gb + (kt + 3) * BK, sa, sb);
            __builtin_amdgcn_sched_barrier(0);
            gemm_ktile(acc, sA0 + STG, sB0 + STG);
            if (kt + 2 < nk) stg_store(r0, wA);
            __syncthreads();
        }
        gemm_epilogue<EPI>(p, acc, m0, n0, wm, wn, lane, ea, N);
    }
}

__device__ __forceinline__ void lr_phase(const P& p, const Ctx& cx, int jl) {
    const bf16_t* Z = cx.Z; bf16_t* LR = cx.LR;
    const int gt = cx.bid * NT + TIDX, gs = cx.nb * NT;
    for (int it = gt; it < (cx.r1 - cx.r0) * 32; it += gs) {
        const int m = cx.r0 + (it >> 5), c8 = it & 31, zc = 1536 + c8 * 8;
        const uint4 cur = *(const uint4*)(Z + (size_t)m * EP + 768 + zc);
        float pv[8];
        if (m < MP) {
            if ((m & (SEQ - 1)) == 0) { for (int e = 0; e < 8; ++e) pv[e] = 0.f; }
            else { const uint4 pr = *(const uint4*)(Z + (size_t)(m - 1) * EP + 768 + zc); pv[0] = lo16(pr.x); pv[1] = hi16(pr.x); pv[2] = lo16(pr.y); pv[3] = hi16(pr.y); pv[4] = lo16(pr.z); pv[5] = hi16(pr.z); pv[6] = lo16(pr.w); pv[7] = hi16(pr.w); }
        } else { const float* st = p.in[I_SHIFT] + (size_t)(jl * 128 + (m - MP)) * ZBW + zc; for (int e = 0; e < 8; ++e) pv[e] = st[e]; }
        const float cv[8] = {lo16(cur.x), hi16(cur.x), lo16(cur.y), hi16(cur.y), lo16(cur.z), hi16(cur.z), lo16(cur.w), hi16(cur.w)};
        const float* mu = p.in[I_MU] + jl * ZBW + zc;
        float o[8];
#pragma unroll
        for (int e = 0; e < 8; ++e) { const float zs = cv[e] + (pv[e] - cv[e]) * mu[e]; o[e] = c8 < 8 ? tanh_fast(zs) : (c8 < 16 ? zs : sigmoidf_(zs)); }
        uint4 ov; ov.x = pk2(o[0], o[1]); ov.y = pk2(o[2], o[3]); ov.z = pk2(o[4], o[5]); ov.w = pk2(o[6], o[7]);
        *(uint4*)(LR + (size_t)m * 256 + c8 * 8) = ov;
    }
}

__device__ __forceinline__ float zs_val(const P& p, const bf16_t* Z, int jl, int m, int c) {
    const float cur = bf2f(Z[(size_t)m * EP + 768 + c]);
    float prev;
    if (m < MP) prev = (m & (SEQ - 1)) == 0 ? 0.f : bf2f(Z[(size_t)(m - 1) * EP + 768 + c]);
    else prev = p.in[I_SHIFT][(size_t)(jl * 128 + (m - MP)) * ZBW + c];
    return cur + (prev - cur) * p.in[I_MU][jl * ZBW + c];
}

constexpr int TC = 32;
typedef float f32x2 __attribute__((ext_vector_type(2)));
typedef float f32x4 __attribute__((ext_vector_type(4)));
struct ScanRaw { u32x4 cr, ck, cv, pr, pk, pv, ep, av; };
__device__ __forceinline__ void scan_load(ScanRaw& R, const bf16_t* Z, const bf16_t* WAG, int m, int t, int c) {
    const bf16_t* zr = Z + (size_t)m * EP + 768;
    R.cr = *(const u32x4*)(zr + c); R.ck = *(const u32x4*)(zr + 512 + c); R.cv = *(const u32x4*)(zr + 1024 + c);
    R.pr = (u32x4){0u, 0u, 0u, 0u}; R.pk = R.pr; R.pv = R.pr;
    if (t > 0) { R.pr = *(const u32x4*)(zr - EP + c); R.pk = *(const u32x4*)(zr - EP + 512 + c); R.pv = *(const u32x4*)(zr - EP + 1024 + c); }
    R.ep = *(const u32x4*)(WAG + (size_t)m * 1536 + c); R.av = *(const u32x4*)(WAG + (size_t)m * 1536 + 512 + c);
}
constexpr int NCH = 5, SCAN_P1 = 256, SCAN_P2 = 256, SCAN_BLOCKS = 256;
__device__ __forceinline__ int chunk_begin(int c) { return c >= NCH ? SEQ : (c == 0 ? 0 : 2080 + (c - 1) * 1536); }
enum { SC_FULL = 0, SC_DUAL = 3 };
template <int mode>
__device__ __forceinline__ void scan_task(const P& p, const Ctx& cx, int jl, char* lds, int seq, int rg, int chunk) {
    const bf16_t* Z = cx.Z; const bf16_t* WAG = cx.WAG; bf16_t* OA = cx.OA;
    float* SEND0 = (float*)(p.ws + W_SCN); float* PM = SEND0 + 16 * 4096; float* LOC = PM + 16 * (NCH - 2) * 4096;
    const int b = seq >> 3, hd = seq & 7;
    const int tid = TIDX, lane = tid & 63, wave = tid >> 6;
    const int rowl = wave * 4 + (lane >> 4), row = rg * 16 + rowl, c4 = (lane & 15) * 4;
    float* sW = (float*)lds; float* sKK = sW + TC * 64; float* sBB = sKK + TC * 64; float* sK2 = sBB + TC * 64; float* sR = sK2 + TC * 64; float* sV = sR + TC * 64;
    float* sQ = sV + TC * 64;
    f32x4 x = {0.f, 0.f, 0.f, 0.f};
    f32x2 p01 = {(c4 == row) ? 1.f : 0.f, (c4 + 1 == row) ? 1.f : 0.f}, p23 = {(c4 + 2 == row) ? 1.f : 0.f, (c4 + 3 == row) ? 1.f : 0.f};
    if (mode == SC_FULL && chunk > 0) {
        x = *(const f32x4*)(SEND0 + (size_t)seq * 4096 + row * 64 + c4);
        for (int cc = 1; cc < chunk; ++cc) {
            *(f32x4*)(sQ + rowl * 64 + c4) = x;
            __syncthreads();
            const float* pm = PM + ((size_t)seq * (NCH - 2) + (cc - 1)) * 4096 + c4;
            f32x4 acc = *(const f32x4*)(LOC + ((size_t)seq * (NCH - 2) + (cc - 1)) * 4096 + row * 64 + c4);
#pragma unroll 8
            for (int j = 0; j < 64; ++j) { const float a = sQ[rowl * 64 + j]; const f32x4 pv = *(const f32x4*)(pm + j * 64); acc += pv * a; }
            __syncthreads();
            x = acc;
        }
    }
    f32x2 s01 = x.lo, s23 = x.hi;
    const int ptt = tid >> 3, pj0 = (tid & 7) * 8, pc = hd * 64 + pj0;
    const float* mu = p.in[I_MU] + jl * ZBW;
    float mur[8], muk[8], muv[8], kkw[8], kaw[8];
#pragma unroll
    for (int e = 0; e < 8; ++e) { mur[e] = mu[pc + e]; muk[e] = mu[512 + pc + e]; muv[e] = mu[1024 + pc + e]; kkw[e] = p.in[I_KK][jl * 512 + pc + e]; kaw[e] = p.in[I_KA][jl * 512 + pc + e]; }
    const int tb = chunk_begin(chunk), te = chunk_begin(chunk + 1);
    ScanRaw R;
    scan_load(R, Z, WAG, b * SEQ + tb + ptt, tb + ptt, pc);
    const float vscale = 1.f;
    for (int t0 = tb; t0 < te; t0 += TC) {
        {
            const unsigned crr[4] = {R.cr.x, R.cr.y, R.cr.z, R.cr.w}, ckk[4] = {R.ck.x, R.ck.y, R.ck.z, R.ck.w}, cvv[4] = {R.cv.x, R.cv.y, R.cv.z, R.cv.w};
            const unsigned prr[4] = {R.pr.x, R.pr.y, R.pr.z, R.pr.w}, pkk[4] = {R.pk.x, R.pk.y, R.pk.z, R.pk.w}, pv4[4] = {R.pv.x, R.pv.y, R.pv.z, R.pv.w};
            const unsigned epp[4] = {R.ep.x, R.ep.y, R.ep.z, R.ep.w}, avv[4] = {R.av.x, R.av.y, R.av.z, R.av.w};
            float rr[8], kx[8], vx[8], kkr[8], aa[8], ee[8]; float ssq = 0.f;
#pragma unroll
            for (int e = 0; e < 8; ++e) {
                const int w_ = e >> 1; const bool hi = e & 1;
                const float r_c = hi ? hi16(crr[w_]) : lo16(crr[w_]), r_p = hi ? hi16(prr[w_]) : lo16(prr[w_]);
                const float k_c = hi ? hi16(ckk[w_]) : lo16(ckk[w_]), k_p = hi ? hi16(pkk[w_]) : lo16(pkk[w_]);
                const float v_c = hi ? hi16(cvv[w_]) : lo16(cvv[w_]), v_p = hi ? hi16(pv4[w_]) : lo16(pv4[w_]);
                rr[e] = r_c + (r_p - r_c) * mur[e]; kx[e] = k_c + (k_p - k_c) * muk[e]; vx[e] = (v_c + (v_p - v_c) * muv[e]) * vscale;
                ee[e] = hi ? hi16(epp[w_]) : lo16(epp[w_]); aa[e] = hi ? hi16(avv[w_]) : lo16(avv[w_]);
                kkr[e] = kx[e] * kkw[e]; ssq += kkr[e] * kkr[e];
            }
            ssq += __shfl_xor(ssq, 1); ssq += __shfl_xor(ssq, 2); ssq += __shfl_xor(ssq, 4);
            const float inv = 1.f / fmaxf(sqrtf(ssq), 1e-12f);
            float ow[8], okk[8], obb[8], ok2[8];
#pragma unroll
            for (int e = 0; e < 8; ++e) { const float kkn = kkr[e] * inv; ow[e] = 1.f - ee[e]; okk[e] = kkn; obb[e] = kkn * aa[e]; ok2[e] = kx[e] * (1.f + (aa[e] - 1.f) * kaw[e]); }
            const int o = ptt * 64 + pj0;
            *(float4*)(sW + o) = make_float4(ow[0], ow[1], ow[2], ow[3]); *(float4*)(sW + o + 4) = make_float4(ow[4], ow[5], ow[6], ow[7]);
            *(float4*)(sKK + o) = make_float4(okk[0], okk[1], okk[2], okk[3]); *(float4*)(sKK + o + 4) = make_float4(okk[4], okk[5], okk[6], okk[7]);
            *(float4*)(sBB + o) = make_float4(obb[0], obb[1], obb[2], obb[3]); *(float4*)(sBB + o + 4) = make_float4(obb[4], obb[5], obb[6], obb[7]);
            *(float4*)(sK2 + o) = make_float4(ok2[0], ok2[1], ok2[2], ok2[3]); *(float4*)(sK2 + o + 4) = make_float4(ok2[4], ok2[5], ok2[6], ok2[7]);
            *(float4*)(sR + o) = make_float4(rr[0], rr[1], rr[2], rr[3]); *(float4*)(sR + o + 4) = make_float4(rr[4], rr[5], rr[6], rr[7]);
            *(float4*)(sV + o) = make_float4(vx[0], vx[1], vx[2], vx[3]); *(float4*)(sV + o + 4) = make_float4(vx[4], vx[5], vx[6], vx[7]);
        }
        __syncthreads();
        if (t0 + TC < te) scan_load(R, Z, WAG, b * SEQ + t0 + TC + ptt, t0 + TC + ptt, pc);
        {
            const float* base = sW + c4;
            float* qdst = ((lane & 3) == 0) ? (sQ + rowl * 4 + ((lane & 15) >> 2)) : (sQ + TC * 64 + lane);
            const int qstep = ((lane & 3) == 0) ? 64 : 0;
            const float* vb = sV + row;
            f32x4 kk = *(const f32x4*)(base + TC * 64), w = *(const f32x4*)(base), bb = *(const f32x4*)(base + 2 * TC * 64), k2 = *(const f32x4*)(base + 3 * TC * 64), r = *(const f32x4*)(base + 4 * TC * 64);
            float vi = vb[0];
            f32x4 kk1 = *(const f32x4*)(base + TC * 64 + 64), w1 = *(const f32x4*)(base + 64), bb1 = *(const f32x4*)(base + 2 * TC * 64 + 64), k21 = *(const f32x4*)(base + 3 * TC * 64 + 64), r1 = *(const f32x4*)(base + 4 * TC * 64 + 64);
            float vi1 = vb[64];
#pragma unroll 16
            for (int tt = 0; tt < TC; ++tt) {
                const int tn = (tt + 2 < TC) ? tt + 2 : TC - 1;
                const f32x4 nkk = *(const f32x4*)(base + TC * 64 + tn * 64), nw = *(const f32x4*)(base + tn * 64), nbb = *(const f32x4*)(base + 2 * TC * 64 + tn * 64),
                            nk2 = *(const f32x4*)(base + 3 * TC * 64 + tn * 64), nr = *(const f32x4*)(base + 4 * TC * 64 + tn * 64);
                const float nvi = vb[tn * 64];
                const f32x2 viv = {vi, vi};
                const f32x2 tp = s01 * kk.lo + s23 * kk.hi;
                float pp = tp.x + tp.y;
                const f32x2 t01 = s01 * w.lo + viv * k2.lo, t23 = s23 * w.hi + viv * k2.hi;
                if (mode == SC_DUAL) {
                    const f32x2 tq = p01 * kk.lo + p23 * kk.hi;
                    float pq = tq.x + tq.y;
                    const f32x2 u01 = p01 * w.lo, u23 = p23 * w.hi;
                    pq = row16_sum(pq);
                    const f32x2 sap = {-pq, -pq};
                    p01 = sap * bb.lo + u01; p23 = sap * bb.hi + u23;
                }
                pp = row16_sum(pp);
                const f32x2 sav = {-pp, -pp};
                s01 = sav * bb.lo + t01; s23 = sav * bb.hi + t23;
                if (mode == SC_FULL) {
                    const f32x2 uq = s01 * r.lo + s23 * r.hi;
                    float q = uq.x + uq.y;
                    q = dpp_add<0xB1>(q); q = dpp_add<0x4E>(q);
                    qdst[tt * qstep] = q;
                }
                kk = kk1; w = w1; bb = bb1; k2 = k21; r = r1; vi = vi1;
                kk1 = nkk; w1 = nw; bb1 = nbb; k21 = nk2; r1 = nr; vi1 = nvi;
            }
        }
        __syncthreads();
        if (mode == SC_FULL) {
            const int tt = tid >> 3, r2 = (tid & 7) * 2; const int m = b * SEQ + t0 + tt;
            const float4 qa = *(const float4*)(sQ + (tt * 16 + r2) * 4), qb = *(const float4*)(sQ + (tt * 16 + r2 + 1) * 4);
            *(unsigned*)(OA + (size_t)m * D + 512 + hd * 64 + rg * 16 + r2) = pk2((qa.x + qa.y) + (qa.z + qa.w), (qb.x + qb.y) + (qb.z + qb.w));
        }
    }
    const f32x4 fin = {s01.x, s01.y, s23.x, s23.y};
    if (mode == SC_FULL) {
        if (chunk == 0) *(f32x4*)(SEND0 + (size_t)seq * 4096 + row * 64 + c4) = fin;
        if (chunk == NCH - 1) *(f32x4*)(p.out + O_SP + ((size_t)((jl * 2 + b) * 8 + hd) * 64 + row) * 64 + c4) = fin;
    } else {
        *(f32x4*)(LOC + ((size_t)seq * (NCH - 2) + (chunk - 1)) * 4096 + row * 64 + c4) = fin;
        const f32x4 pf = {p01.x, p01.y, p23.x, p23.y};
        *(f32x4*)(PM + ((size_t)seq * (NCH - 2) + (chunk - 1)) * 4096 + row * 64 + c4) = pf;
    }
    __syncthreads();
}

__device__ __forceinline__ void attn_prompt_item(const P& p, const Ctx& cx, int jl, int item, char* lds) {
    const bf16_t* Z = cx.Z; bf16_t* OA = cx.OA;
    const int kvh = item & 1, qb = (item >> 1) & 63, b = item >> 7;
    const int tid = TIDX, lane = tid & 63, wave = tid >> 6, lr = lane & 31, h = lane >> 5;
    constexpr int KROW = 144, VROW = 528;
    char* sK = lds; char* sVt = lds + 256 * KROW;
#pragma unroll 2
    for (int q = 0; q < 8; ++q) {
        const int ch = tid + 256 * q, key = ch >> 3, c8 = ch & 7; const int tk = (qb - 1) * 128 + key;
        uint4 kv = make_uint4(0, 0, 0, 0), vv = kv;
        if (tk >= 0) { const bf16_t* zr = Z + (size_t)(b * SEQ + tk) * EP; kv = *(const uint4*)(zr + 512 + kvh * 64 + c8 * 8); vv = *(const uint4*)(zr + 640 + kvh * 64 + c8 * 8); }
        *(uint4*)(sK + key * KROW + c8 * 16) = kv;
        const unsigned vw[4] = {vv.x, vv.y, vv.z, vv.w};
#pragma unroll
        for (int e = 0; e < 8; ++e) *(bf16_t*)(sVt + (c8 * 8 + e) * VROW + key * 2) = (bf16_t)((e & 1) ? (vw[e >> 1] >> 16) : (vw[e >> 1] & 0xffff));
    }
    __syncthreads();
    const int qs = wave;
    const int qrow = b * SEQ + qb * 128 + qs * 32 + lr;
    const int qloc = qs * 32 + lr;
#pragma unroll 1
    for (int g = 0; g < 4; ++g) {
        const int qh = kvh * 4 + g;
        bf16x8 qf[4];
#pragma unroll
        for (int s = 0; s < 4; ++s) qf[s] = *(const bf16x8*)(Z + (size_t)qrow * EP + qh * 64 + s * 16 + h * 8);
        f32x16 sc[5];
#pragma unroll
        for (int u = 0; u < 5; ++u) {
#pragma unroll
            for (int e = 0; e < 16; ++e) sc[u][e] = 0.f;
#pragma unroll
            for (int s = 0; s < 4; ++s) {
                const bf16x8 kf = *(const bf16x8*)(sK + ((qs + u) * 32 + lr) * KROW + s * 32 + h * 16);
                sc[u] = __builtin_amdgcn_mfma_f32_32x32x16_bf16(kf, qf[s], sc[u], 0, 0, 0);
            }
            __builtin_amdgcn_sched_barrier(0);
        }
        const float sink = p.in[I_SINK][jl * 8 + qh];
        float mx = -3e38f;
#pragma unroll
        for (int u = 0; u < 5; ++u)
#pragma unroll
            for (int e = 0; e < 16; ++e) {
                const int kj = (qs + u) * 32 + (e & 3) + 8 * (e >> 2) + 4 * h;
                const int diff = 128 + qloc - kj;
                const bool vis = diff >= 0 && diff <= 128 && (qb > 0 || kj >= 128);
                const float sv = vis ? sc[u][e] * 0.125f : -1e30f;
                sc[u][e] = sv; mx = fmaxf(mx, sv);
            }
        mx = fmaxf(mx, __shfl_xor(mx, 32)); mx = fmaxf(mx, sink);
        float sum = 0.f;
#pragma unroll
        for (int u = 0; u < 5; ++u)
#pragma unroll
            for (int e = 0; e < 16; ++e) { const float pe = __expf(sc[u][e] - mx); sc[u][e] = pe; sum += pe; }
        sum += __shfl_xor(sum, 32);
        const float rden = 1.f / (sum + __expf(sink - mx));
        f32x16 oacc[2];
#pragma unroll
        for (int d2 = 0; d2 < 2; ++d2)
#pragma unroll
            for (int e = 0; e < 16; ++e) oacc[d2][e] = 0.f;
#pragma unroll
        for (int u = 0; u < 5; ++u)
#pragma unroll
            for (int s2 = 0; s2 < 2; ++s2) {
                union { bf16x8 v; unsigned w[4]; } pf;
#pragma unroll
                for (int e2 = 0; e2 < 4; ++e2) pf.w[e2] = pk2(sc[u][8 * s2 + 2 * e2] * rden, sc[u][8 * s2 + 2 * e2 + 1] * rden);
                const int kbase = (qs + u) * 32 + 16 * s2 + 4 * h;
#pragma unroll
                for (int d2 = 0; d2 < 2; ++d2) {
                    union { bf16x8 v; uint2 w[2]; } vf;
                    const char* vp = sVt + (d2 * 32 + lr) * VROW + kbase * 2;
                    vf.w[0] = *(const uint2*)vp; vf.w[1] = *(const uint2*)(vp + 16);
                    oacc[d2] = __builtin_amdgcn_mfma_f32_32x32x16_bf16(vf.v, pf.v, oacc[d2], 0, 0, 0);
                }
                __builtin_amdgcn_sched_barrier(0);
            }
#pragma unroll
        for (int d2 = 0; d2 < 2; ++d2)
#pragma unroll
            for (int g2 = 0; g2 < 4; ++g2) {
                uint2 o; o.x = pk2(oacc[d2][4 * g2], oacc[d2][4 * g2 + 1]); o.y = pk2(oacc[d2][4 * g2 + 2], oacc[d2][4 * g2 + 3]);
                *(uint2*)(OA + (size_t)qrow * D + qh * 64 + d2 * 32 + 8 * g2 + 4 * h) = o;
            }
    }
    __syncthreads();
}

__device__ __forceinline__ void attn_sample_item(const P& p, const Ctx& cx, int jl, int item, char* lds) {
    const bf16_t* Z = cx.Z; bf16_t* OA = cx.OA;
    const int kvh = item & 1, bs = item >> 1, m = MP + bs;
    const int tid = TIDX, lane = tid & 63, wave = tid >> 6, qh = kvh * 4 + wave;
    float* sq = (float*)lds + wave * 64; float* sp = (float*)lds + 256 + wave * 132;
    sq[lane] = bf2f(Z[(size_t)m * EP + qh * 64 + lane]);
    __syncthreads();
    const float* kc = p.in[I_CK] + ((size_t)(jl * 128 + bs) * 128) * 128 + kvh * 64;
    const float* vc = p.in[I_CV] + ((size_t)(jl * 128 + bs) * 128) * 128 + kvh * 64;
    float sc0 = 0.f, sc1 = 0.f, sc2 = 0.f;
#pragma unroll 4
    for (int d = 0; d < 64; d += 4) {
        const float4 k0 = *(const float4*)(kc + (size_t)lane * 128 + d), k1 = *(const float4*)(kc + (size_t)(lane + 64) * 128 + d);
        const float4 q4 = *(const float4*)(sq + d);
        sc0 += k0.x * q4.x + k0.y * q4.y + k0.z * q4.z + k0.w * q4.w; sc1 += k1.x * q4.x + k1.y * q4.y + k1.z * q4.z + k1.w * q4.w;
    }
    sc2 = wave_sum(bf2f(Z[(size_t)m * EP + 512 + kvh * 64 + lane]) * sq[lane]);
    sc0 *= 0.125f; sc1 *= 0.125f; sc2 *= 0.125f;
    const float sink = p.in[I_SINK][jl * 8 + qh];
    float mx = wave_max(fmaxf(sc0, sc1)); mx = fmaxf(fmaxf(mx, sc2), sink);
    const float p0 = __expf(sc0 - mx), p1 = __expf(sc1 - mx), p2 = __expf(sc2 - mx);
    const float den = wave_sum(p0 + p1) + p2 + __expf(sink - mx), rd = 1.f / den;
    sp[lane] = p0 * rd; sp[lane + 64] = p1 * rd; if (lane == 0) sp[128] = p2 * rd;
    __syncthreads();
    float o = 0.f;
#pragma unroll 32
    for (int j = 0; j < 128; ++j) o += sp[j] * vc[(size_t)j * 128 + lane];
    o += sp[128] * bf2f(Z[(size_t)m * EP + 640 + kvh * 64 + lane]);
    OA[(size_t)m * D + qh * 64 + lane] = f2bf(o);
    __syncthreads();
}

__device__ __forceinline__ void rwkv_sample_item(const P& p, const Ctx& cx, int jl, int item, char* lds) {
    const bf16_t* Z = cx.Z; const bf16_t* WAG = cx.WAG; bf16_t* OA = cx.OA;
    const int hd = item & 7, bs = item >> 3, m = MP + bs;
    const int tid = TIDX;
    float* sW = (float*)lds; float* sKK = sW + 64; float* sBB = sKK + 64; float* sK2 = sBB + 64; float* sR = sK2 + 64; float* sV = sR + 64;
    if (tid < 64) {
        const int c = hd * 64 + tid;
        const float r = zs_val(p, Z, jl, m, c), k = zs_val(p, Z, jl, m, 512 + c), v = zs_val(p, Z, jl, m, 1024 + c);
        const float eps = bf2f(WAG[(size_t)m * 1536 + c]), a = bf2f(WAG[(size_t)m * 1536 + 512 + c]);
        const float kkr = k * p.in[I_KK][jl * 512 + c];
        const float ssq = wave_sum(kkr * kkr);
        const float kkn = kkr / fmaxf(sqrtf(ssq), 1e-12f);
        sW[tid] = 1.f - eps; sKK[tid] = kkn; sBB[tid] = kkn * a; sK2[tid] = k * (1.f + (a - 1.f) * p.in[I_KA][jl * 512 + c]); sR[tid] = r; sV[tid] = v;
    }
    __syncthreads();
    const int i = tid >> 2, q = tid & 3;
    const float* sp = p.in[I_WKV] + ((size_t)((jl * 128 + bs) * 8 + hd) * 64 + i) * 64 + q * 16;
    float s[16]; float pp = 0.f;
#pragma unroll
    for (int e4 = 0; e4 < 4; ++e4) { const float4 v = *(const float4*)(sp + 4 * e4); s[4 * e4] = v.x; s[4 * e4 + 1] = v.y; s[4 * e4 + 2] = v.z; s[4 * e4 + 3] = v.w; }
#pragma unroll
    for (int e = 0; e < 16; ++e) pp += s[e] * sKK[q * 16 + e];
    pp += __shfl_xor(pp, 1); pp += __shfl_xor(pp, 2);
    const float sa = -pp, vi = sV[i];
    float qq = 0.f;
#pragma unroll
    for (int e = 0; e < 16; ++e) { const int j = q * 16 + e; s[e] = s[e] * sW[j] + sa * sBB[j] + vi * sK2[j]; qq += s[e] * sR[j]; }
    qq += __shfl_xor(qq, 1); qq += __shfl_xor(qq, 2);
    float* so = p.out + O_SS + ((size_t)((jl * 128 + bs) * 8 + hd) * 64 + i) * 64 + q * 16;
#pragma unroll
    for (int e4 = 0; e4 < 4; ++e4) *(float4*)(so + 4 * e4) = make_float4(s[4 * e4], s[4 * e4 + 1], s[4 * e4 + 2], s[4 * e4 + 3]);
    if (q == 0) OA[(size_t)m * D + 512 + hd * 64 + i] = f2bf(qq);
    __syncthreads();
}

__device__ __forceinline__ void mix_sample(const P& p, const Ctx& cx, int jl, char* lds) {
    for (int it = cx.bid; it < 256 + 1024; it += cx.nb) {
        if (it < 256) attn_sample_item(p, cx, jl, it, lds);
        else rwkv_sample_item(p, cx, jl, it - 256, lds);
    }
}

__device__ __forceinline__ void unpack8(const uint4& u, float (&o)[8]) { o[0] = lo16(u.x); o[1] = hi16(u.x); o[2] = lo16(u.y); o[3] = hi16(u.y); o[4] = lo16(u.z); o[5] = hi16(u.z); o[6] = lo16(u.w); o[7] = hi16(u.w); }
__device__ __forceinline__ void load8f(const float* p_, float (&o)[8]) { const float4 a = *(const float4*)p_, b = *(const float4*)(p_ + 4); o[0] = a.x; o[1] = a.y; o[2] = a.z; o[3] = a.w; o[4] = b.x; o[5] = b.y; o[6] = b.z; o[7] = b.w; }
__device__ __forceinline__ float group8_sum(float x) { x = dpp_add<0xB1>(x); x = dpp_add<0x4E>(x); x = dpp_add<0x141>(x); return x; }
__device__ __forceinline__ void post_phase(const P& p, const Ctx& cx, int jl) {
    if (cx.r0 == MP) { float* mo = cx.MOE + (size_t)MP * D; for (int i = cx.bid * NT + TIDX; i < MS * D / 4; i += cx.nb * NT) *(float4*)(mo + 4 * i) = make_float4(0.f, 0.f, 0.f, 0.f); }
    const bf16_t* Z = cx.Z; const bf16_t* WAG = cx.WAG; bf16_t* OA = cx.OA;
    const int tid = TIDX, lane = tid & 63, wave = tid >> 6, c = lane * 8;
    float mur[8], muk[8], muv[8], ka[8], rkw[8], gg[8], gb[8];
    load8f(p.in[I_MU] + jl * ZBW + c, mur); load8f(p.in[I_MU] + jl * ZBW + 512 + c, muk); load8f(p.in[I_MU] + jl * ZBW + 1024 + c, muv);
    load8f(p.in[I_KA] + jl * 512 + c, ka); load8f(p.in[I_RK] + jl * 512 + c, rkw); load8f(p.in[I_GNG] + jl * 512 + c, gg); load8f(p.in[I_GNB] + jl * 512 + c, gb);
    for (int m = cx.r0 + cx.bid * 4 + wave; m < cx.r1; m += cx.nb * 4) {
        const bf16_t* zr = Z + (size_t)m * EP + 768 + c;
        float r[8], k[8], v[8], pr[8], pk[8], pv[8], a[8], g[8], o[8];
        unpack8(*(const uint4*)zr, r); unpack8(*(const uint4*)(zr + 512), k); unpack8(*(const uint4*)(zr + 1024), v);
        unpack8(*(const uint4*)(WAG + (size_t)m * 1536 + 512 + c), a); unpack8(*(const uint4*)(WAG + (size_t)m * 1536 + 1024 + c), g);
        unpack8(*(const uint4*)(OA + (size_t)m * D + 512 + c), o);
        if (m < MP) {
            if ((m & (SEQ - 1)) == 0) {
#pragma unroll
                for (int e = 0; e < 8; ++e) { pr[e] = 0.f; pk[e] = 0.f; pv[e] = 0.f; }
            } else { unpack8(*(const uint4*)(zr - EP), pr); unpack8(*(const uint4*)(zr - EP + 512), pk); unpack8(*(const uint4*)(zr - EP + 1024), pv); }
        } else { const float* st = p.in[I_SHIFT] + (size_t)(jl * 128 + (m - MP)) * ZBW + c; load8f(st, pr); load8f(st + 512, pk); load8f(st + 1024, pv); }
        float rk = 0.f, so = 0.f;
#pragma unroll
        for (int e = 0; e < 8; ++e) {
            r[e] += (pr[e] - r[e]) * mur[e]; k[e] += (pk[e] - k[e]) * muk[e]; v[e] += (pv[e] - v[e]) * muv[e];
            const float k2 = k[e] * (1.f + (a[e] - 1.f) * ka[e]);
            rk += r[e] * k2 * rkw[e]; so += o[e];
        }
        rk = group8_sum(rk);
        const float mean = group8_sum(so) * (1.f / 64);
        float sv = 0.f;
#pragma unroll
        for (int e = 0; e < 8; ++e) { o[e] -= mean; sv += o[e] * o[e]; }
        const float rstd = rsqrtf(group8_sum(sv) * (1.f / 64) + 64e-5f);
        float res[8];
#pragma unroll
        for (int e = 0; e < 8; ++e) res[e] = (o[e] * rstd * gg[e] + gb[e] + rk * v[e]) * g[e];
        uint4 ov; ov.x = pk2(res[0], res[1]); ov.y = pk2(res[2], res[3]); ov.z = pk2(res[4], res[5]); ov.w = pk2(res[6], res[7]);
        *(uint4*)(OA + (size_t)m * D + 512 + c) = ov;
    }
}

__device__ __forceinline__ void sgu_ln_phase(const P& p, const Ctx& cx, int jo) {
    bf16_t* ZU = cx.ZU;
    const int lane = TIDX & 63, wave = TIDX >> 6;
    for (int m = cx.r0 + cx.bid * 4 + wave; m < cx.r1; m += cx.nb * 4) {
        bf16_t* vr = ZU + (size_t)m * 2048 + 1024;
        float x[16]; float s = 0.f;
#pragma unroll
        for (int q = 0; q < 2; ++q) { const uint4 u = *(const uint4*)(vr + lane * 8 + 512 * q);
            x[8 * q] = lo16(u.x); x[8 * q + 1] = hi16(u.x); x[8 * q + 2] = lo16(u.y); x[8 * q + 3] = hi16(u.y); x[8 * q + 4] = lo16(u.z); x[8 * q + 5] = hi16(u.z); x[8 * q + 6] = lo16(u.w); x[8 * q + 7] = hi16(u.w); }
#pragma unroll
        for (int e = 0; e < 16; ++e) s += x[e];
        const float mean = wave_sum(s) * (1.f / 1024);
        float s2 = 0.f;
#pragma unroll
        for (int e = 0; e < 16; ++e) { x[e] -= mean; s2 += x[e] * x[e]; }
        const float rstd = rsqrtf(wave_sum(s2) * (1.f / 1024) + 1e-5f);
#pragma unroll
        for (int q = 0; q < 2; ++q) {
            const int c = lane * 8 + 512 * q; float o[8];
#pragma unroll
            for (int e = 0; e < 8; ++e) o[e] = x[8 * q + e] * rstd * p.in[I_LNG][jo * 1024 + c + e] + p.in[I_LNB][jo * 1024 + c + e];
            uint4 ov; ov.x = pk2(o[0], o[1]); ov.y = pk2(o[2], o[3]); ov.z = pk2(o[4], o[5]); ov.w = pk2(o[6], o[7]);
            *(uint4*)(vr + c) = ov;
            if (m >= MP) { float* so = p.out + O_SGV + (size_t)(jo * 128 + (m - MP)) * 1024 + c; *(float4*)so = make_float4(o[0], o[1], o[2], o[3]); *(float4*)(so + 4) = make_float4(o[4], o[5], o[6], o[7]); }
        }
    }
}

template <bool SAMPLE>
__device__ __forceinline__ void sgu_phase(const P& p, const Ctx& cx, int jo, char* lds) {
    const bf16_t* ZU = cx.ZU; bf16_t* Y = cx.Y;
    const bf16_t* TR = (const bf16_t*)(p.ws + W_TRIL) + (size_t)jo * 8 * 128 * 128;
    const int tid = TIDX, lane = tid & 63, wave = tid >> 6, wm = wave >> 1, wn = wave & 1, lr = lane & 31, h = lane >> 5;
    constexpr int SROW = 272;
    char* sA = lds; char* sB = lds + 128 * SROW;
    if (!SAMPLE) for (int item = cx.bid; item < 1024; item += cx.nb) {
        const int hh = item & 7, n = (item >> 3) & 63, b = item >> 9;
        const int mbase = b * SEQ + n * 128;
#pragma unroll
        for (int q = 0; q < 8; ++q) {
            const int ch = tid + 256 * q, r = ch >> 4, c8 = ch & 15;
            *(uint4*)(sA + r * SROW + c8 * 16) = *(const uint4*)(TR + (size_t)hh * 16384 + r * 128 + c8 * 8);
            const uint4 vv = *(const uint4*)(ZU + (size_t)(mbase + r) * 2048 + 1024 + hh * 128 + c8 * 8);
            const unsigned vw[4] = {vv.x, vv.y, vv.z, vv.w};
#pragma unroll
            for (int e = 0; e < 8; ++e) *(bf16_t*)(sB + (c8 * 8 + e) * SROW + r * 2) = (bf16_t)((e & 1) ? (vw[e >> 1] >> 16) : (vw[e >> 1] & 0xffff));
        }
        __syncthreads();
        f32x16 acc[2][2];
#pragma unroll
        for (int i = 0; i < 2; ++i)
#pragma unroll
            for (int j = 0; j < 2; ++j)
#pragma unroll
                for (int e = 0; e < 16; ++e) acc[i][j][e] = 0.f;
#pragma unroll
        for (int ks = 0; ks < 8; ++ks) {
            bf16x8 xa[2], wb[2];
#pragma unroll
            for (int i = 0; i < 2; ++i) xa[i] = *(const bf16x8*)(sA + (wm * 64 + i * 32 + lr) * SROW + ks * 32 + h * 16);
#pragma unroll
            for (int j = 0; j < 2; ++j) wb[j] = *(const bf16x8*)(sB + (wn * 64 + j * 32 + lr) * SROW + ks * 32 + h * 16);
#pragma unroll
            for (int i = 0; i < 2; ++i)
#pragma unroll
                for (int j = 0; j < 2; ++j) acc[i][j] = __builtin_amdgcn_mfma_f32_32x32x16_bf16(wb[j], xa[i], acc[i][j], 0, 0, 0);
        }
#pragma unroll
        for (int i = 0; i < 2; ++i) {
            const int t = wm * 64 + i * 32 + lr; const float bias = p.in[I_SGUB][(jo * 8 + hh) * 128 + t];
#pragma unroll
            for (int j = 0; j < 2; ++j)
#pragma unroll
                for (int g = 0; g < 4; ++g) {
                    const int c = hh * 128 + wn * 64 + j * 32 + 8 * g + 4 * h;
                    const uint2 uu = *(const uint2*)(ZU + (size_t)(mbase + t) * 2048 + c);
                    uint2 o; o.x = pk2(lo16(uu.x) * (acc[i][j][4 * g] + bias), hi16(uu.x) * (acc[i][j][4 * g + 1] + bias));
                    o.y = pk2(lo16(uu.y) * (acc[i][j][4 * g + 2] + bias), hi16(uu.y) * (acc[i][j][4 * g + 3] + bias));
                    *(uint2*)(Y + (size_t)(mbase + t) * D + c) = o;
                }
        }
        __syncthreads();
    }
    const int gt = cx.bid * NT + tid, gs = cx.nb * NT;
    if (cx.r0 == MP) { float* mo = cx.MOE + (size_t)MP * D; for (int i = cx.bid * NT + tid; i < MS * D / 4; i += cx.nb * NT) *(float4*)(mo + 4 * i) = make_float4(0.f, 0.f, 0.f, 0.f); }
    if (SAMPLE) for (int it = gt; it < MS * 1024; it += gs) {
        const int m = MP + (it >> 10), c = it & 1023, hh = c >> 7;
        const float u = bf2f(ZU[(size_t)m * 2048 + c]), vn = bf2f(ZU[(size_t)m * 2048 + 1024 + c]);
        Y[(size_t)m * D + c] = f2bf(u * (p.in[I_SGUW][(size_t)(jo * 8 + hh) * 16384] * vn + p.in[I_SGUB][(jo * 8 + hh) * 128]));
    }
}

__device__ __forceinline__ void unpack8v(const u32x4& u, float (&o)[8]) { o[0] = lo16(u.x); o[1] = hi16(u.x); o[2] = lo16(u.y); o[3] = hi16(u.y); o[4] = lo16(u.z); o[5] = hi16(u.z); o[6] = lo16(u.w); o[7] = hi16(u.w); }
template <bool SAMPLE>
__device__ __forceinline__ void act_phase(const P& p, const Ctx& cx, int L) {
    const bf16_t* G = cx.G; bf16_t* U = cx.U;
    const int gt = cx.bid * NT + TIDX, gs = cx.nb * NT;
    const float* cw = p.in[I_CW] + (size_t)L * 3 * DFF; const float* cb = p.in[I_CB] + (size_t)L * DFF;
    constexpr int CG = DFF / 8, RC = 16;
    if (!SAMPLE) for (int it = gt; it < (MP / RC) * CG; it += gs) {
        const int m0 = (it / CG) * RC, c = (it % CG) * 8;
        float w0[8], w1[8], w2[8], bb[8], g1[8], g2[8];
        load8f(cw + c, w0); load8f(cw + DFF + c, w1); load8f(cw + 2 * DFF + c, w2); load8f(cb + c, bb);
        if ((m0 & (SEQ - 1)) == 0) {
#pragma unroll
            for (int e = 0; e < 8; ++e) { g1[e] = 0.f; g2[e] = 0.f; }
        } else { unpack8v(*(const u32x4*)(G + (size_t)(m0 - 1) * DFF + c), g1); unpack8v(*(const u32x4*)(G + (size_t)(m0 - 2) * DFF + c), g2); }
#pragma unroll
        for (int hf = 0; hf < RC / 8; ++hf) {
            u32x4 gq[8], uq[8];
#pragma unroll
            for (int r = 0; r < 8; ++r) { gq[r] = *(const u32x4*)(G + (size_t)(m0 + hf * 8 + r) * DFF + c); uq[r] = *(const u32x4*)(U + (size_t)(m0 + hf * 8 + r) * DFF + c); }
#pragma unroll
            for (int r = 0; r < 8; ++r) {
                float gc[8], uv[8], o[8];
                unpack8v(gq[r], gc); unpack8v(uq[r], uv);
#pragma unroll
                for (int e = 0; e < 8; ++e) { const float cv = bb[e] + w2[e] * gc[e] + w1[e] * g1[e] + w0[e] * g2[e]; o[e] = gelu_tanh(cv) * uv[e]; g2[e] = g1[e]; g1[e] = gc[e]; }
                u32x4 ov; ov.x = pk2(o[0], o[1]); ov.y = pk2(o[2], o[3]); ov.z = pk2(o[4], o[5]); ov.w = pk2(o[6], o[7]);
                *(u32x4*)(U + (size_t)(m0 + hf * 8 + r) * DFF + c) = ov;
            }
        }
    }
    if (cx.r0 == MP) { float* mo = cx.MOE + (size_t)MP * D; for (int i = cx.bid * NT + TIDX; i < MS * D / 4; i += cx.nb * NT) *(float4*)(mo + 4 * i) = make_float4(0.f, 0.f, 0.f, 0.f); }
    if (SAMPLE) for (int it = gt; it < MS * CG; it += gs) {
        const int m = MP + it / CG, c = (it % CG) * 8;
        float w0[8], w1[8], w2[8], bb[8], g1[8], g2[8], gc[8], uv[8], o[8];
        load8f(cw + c, w0); load8f(cw + DFF + c, w1); load8f(cw + 2 * DFF + c, w2); load8f(cb + c, bb);
        const float* st = p.in[I_CONV] + ((size_t)(L * 128 + (m - MP)) * 2) * DFF + c;
        load8f(st, g2); load8f(st + DFF, g1);
        unpack8v(*(const u32x4*)(G + (size_t)m * DFF + c), gc); unpack8v(*(const u32x4*)(U + (size_t)m * DFF + c), uv);
#pragma unroll
        for (int e = 0; e < 8; ++e) { const float cv = bb[e] + w2[e] * gc[e] + w1[e] * g1[e] + w0[e] * g2[e]; o[e] = gelu_tanh(cv) * uv[e]; }
        u32x4 ov; ov.x = pk2(o[0], o[1]); ov.y = pk2(o[2], o[3]); ov.z = pk2(o[4], o[5]); ov.w = pk2(o[6], o[7]);
        *(u32x4*)(U + (size_t)m * DFF + c) = ov;
    }
}

struct Chains { Ctx main, samp; XcdBarrier sb; };

template <bool SAMPLE>
__device__ __forceinline__ void run_op(const P& p, Chains& ch, int L, int op, char* lds, int pass = 1) {
    const Ctx& cx = SAMPLE ? ch.samp : ch.main;
    const int j = L >> 1; const bool even = (L & 1) == 0;
    bf16_t* XN = (bf16_t*)(p.ws + W_XN);
    EA ea; ea.c32 = nullptr; ea.o16 = nullptr; ea.o16b = nullptr; ea.layer = L; ea.ksplit = 1;
    if (even) {
        switch (op) {
        case 0: ea.o16 = cx.Z; ea.o16b = cx.LR; gemm_phase<EPI_EVENIN>(p, XN, D, (const bf16_t*)(p.ws + W_WINE) + (size_t)j * EP * D, EP, D, lds, ea, cx); return;
        case 1: lr_phase(p, cx, j); return;
        case 2: ea.o16 = cx.WAG; gemm_phase<EPI_LR>(p, cx.LR, 256, (const bf16_t*)(p.ws + W_WLR) + (size_t)j * 1536 * 256, 1536, 256, lds, ea, cx); return;
        case 3:
            if constexpr (SAMPLE) mix_sample(p, cx, j, lds);
            else {
                const int bidx = BIDX;
                if (pass == 1) {
                    if (bidx < SCAN_P1) {
                        if (bidx < 64) scan_task<SC_FULL>(p, cx, j, lds, bidx >> 2, bidx & 3, 0);
                        else { const int r = bidx - 64, r2 = r & 63; scan_task<SC_DUAL>(p, cx, j, lds, r2 >> 2, r2 & 3, 1 + (r >> 6)); }
                        return;
                    }
                } else {
                    if (bidx < SCAN_P2) { const int r2 = bidx & 63; scan_task<SC_FULL>(p, cx, j, lds, r2 >> 2, r2 & 3, 1 + (bidx >> 6)); return; }
                    for (int it = ch.samp.bid; it < 256; it += ch.samp.nb) attn_prompt_item(p, cx, j, it, lds);
                }
                if (pass == 1) {
#pragma unroll 1
                    for (int o2 = 0; o2 < 10; ++o2) { if (o2 == 1) continue;
                        run_op<true>(p, ch, L, o2, lds); if (o2 != 9) xcd_barrier(ch.sb); }
                } else {
                    run_op<true>(p, ch, L, 10, lds); xcd_barrier(ch.sb);
#pragma unroll 1
                    for (int o2 = 0; o2 < 9; ++o2) { run_op<true>(p, ch, L + 1, o2, lds); if (o2 != 8) xcd_barrier(ch.sb); }
                }
            }
            return;
        case 4: post_phase(p, cx, j); return;
        case 5: ea.c32 = cx.MOE; if (SAMPLE) ea.ksplit = 4; gemm_phase<EPI_F32>(p, cx.OA, D, (const bf16_t*)(p.ws + W_WOUTE) + (size_t)j * D * D, D, D, lds, ea, cx); return;
        case 6: rownorm_phase(p, cx, cx.MOE, p.in[I_NMPOST] + L * D, p.in[I_NFPRE] + L * D, L == 0); return;
        default: break;
        }
        op -= 7;
    } else {
        switch (op) {
        case 0: ea.o16 = cx.ZU; gemm_phase<EPI_ODDIN>(p, XN, D, (const bf16_t*)(p.ws + W_WINO) + (size_t)j * 2048 * D, 2048, D, lds, ea, cx); return;
        case 1: sgu_ln_phase(p, cx, j); return;
        case 2: sgu_phase<SAMPLE>(p, cx, j, lds); return;
        case 3: ea.c32 = cx.MOO; if (SAMPLE) ea.ksplit = 4; gemm_phase<EPI_F32>(p, cx.Y, D, (const bf16_t*)(p.ws + W_WOUTO) + (size_t)j * D * D, D, D, lds, ea, cx); return;
        case 4: rownorm_phase(p, cx, cx.MOO, p.in[I_NMPOST] + L * D, p.in[I_NFPRE] + L * D); return;
        default: break;
        }
        op -= 5;
    }
    switch (op) {
    case 0: ea.o16 = cx.G; ea.o16b = cx.U; gemm_phase<EPI_GU>(p, XN, D, (const bf16_t*)(p.ws + W_WGU) + (size_t)L * 2 * DFF * D, 2 * DFF, D, lds, ea, cx); return;
    case 1: act_phase<SAMPLE>(p, cx, L); return;
    case 2: ea.c32 = cx.FO; if (SAMPLE) ea.ksplit = 11; gemm_phase<EPI_F32>(p, cx.U, DFF, (const bf16_t*)(p.ws + W_WDN) + (size_t)L * D * DFF, D, DFF, lds, ea, cx); return;
    case 3: rownorm_phase(p, cx, cx.FO, p.in[I_NFPOST] + L * D, L < 3 ? p.in[I_NMPRE] + (L + 1) * D : nullptr); return;
    default: return;
    }
}

__global__ void __launch_bounds__(NT, 2) mega(P p_arg) {
    __shared__ __attribute__((aligned(16))) char lds[LDS_BYTES];
    cg::grid_group grid = cg::this_grid();
    const P& p = *(const P*)__builtin_amdgcn_kernarg_segment_ptr();
    __shared__ uint4 xb_words, xb_words2;
    unsigned* bar = (unsigned*)(p.ws + W_BAR);
    if (threadIdx.x == 0) { xb_words = make_uint4(0u, 0u, 0u, 0u); xb_words2 = make_uint4(0u, 0u, 0u, 0u); }
    __syncthreads();
    XcdBarrier xb = xcd_barrier_post(bar, (volatile LAS unsigned*)&xb_words, gridDim.x);
    p0_phase(p, lds);
    if (p.ws == nullptr) grid.sync();
    xcd_barrier(xb);
    Chains ch;
    {
        char* AR = p.ws + W_AR; char* SA = p.ws + W_SAMP;
        Ctx& m = ch.main;
        m.Z = (bf16_t*)(AR + A_Z); m.LR = (bf16_t*)(AR + A_LR); m.WAG = (bf16_t*)(AR + A_WAG); m.OA = (bf16_t*)(AR + A_OA); m.ZU = (bf16_t*)(AR + A_ZU); m.Y = (bf16_t*)(AR + A_Y);
        m.G = (bf16_t*)(AR + A_G); m.U = (bf16_t*)(AR + A_U); m.MOE = (float*)(AR + A_Z); m.MOO = (float*)(AR + A_MO_ODD); m.FO = (float*)(AR + A_G);
        m.r0 = 0; m.r1 = MP; m.bid = blockIdx.x; m.nb = gridDim.x;
        Ctx& q = ch.samp;
        q.Z = (bf16_t*)(SA + S_Z) - (size_t)MP * EP; q.LR = (bf16_t*)(SA + S_LR) - (size_t)MP * 256; q.WAG = (bf16_t*)(SA + S_WAG) - (size_t)MP * 1536; q.OA = (bf16_t*)(SA + S_OA) - (size_t)MP * D;
        q.ZU = (bf16_t*)(SA + S_ZU) - (size_t)MP * 2048; q.Y = (bf16_t*)(SA + S_Y) - (size_t)MP * D; q.G = (bf16_t*)(SA + S_G) - (size_t)MP * DFF; q.U = (bf16_t*)(SA + S_U) - (size_t)MP * DFF;
        q.MOE = (float*)(SA + S_MO) - (size_t)MP * D; q.MOO = q.MOE; q.FO = q.MOE;
        q.r0 = MP; q.r1 = M; q.bid = (int)blockIdx.x - SCAN_BLOCKS; q.nb = (int)gridDim.x - SCAN_BLOCKS;
        if ((int)blockIdx.x >= SCAN_BLOCKS) ch.sb = xcd_barrier_post(bar + 4096, (volatile LAS unsigned*)&xb_words2, gridDim.x - SCAN_BLOCKS);
        else { ch.sb.bar = bar + 4096; ch.sb.x = 0; ch.sb.st = (volatile LAS unsigned*)&xb_words2; ch.sb.G = 1; }
    }
#pragma unroll 1
    for (int L = 0; L < 4; ++L) {
        const int nops = (L & 1) ? 9 : 12;
#pragma unroll 1
        for (int op = 0; op < nops; ++op) {
            const bool ev = !(L & 1);
            run_op<false>(p, ch, L, (ev && op >= 4) ? op - 1 : op, lds, (ev && op == 4) ? 2 : 1);
            if (!(L == 3 && op == nops - 1)) xcd_barrier(xb);
        }
    }
}

extern "C" void kernel_launch(void* const* d_in, const int* in_sizes, int n_in, void* d_out, int out_size, void* d_ws, size_t ws_size, hipStream_t stream) {
    static int grid_blocks = 0;
    if (!grid_blocks) {
        if (n_in != N_IN || (size_t)out_size != O_END || ws_size < WS_NEED) {
            fprintf(stderr, "kernel_launch: unexpected shapes: n_in %d out %d (want %zu) ws %zu (need %zu)\n", n_in, out_size, (size_t)O_END, ws_size, (size_t)WS_NEED);
            if (ws_size < WS_NEED) return;
        }
        int dev = 0, cus = 0, per_cu = 0;
        hipGetDevice(&dev);
        hipDeviceGetAttribute(&cus, hipDeviceAttributeMultiprocessorCount, dev);
        hipOccupancyMaxActiveBlocksPerMultiprocessor(&per_cu, mega, NT, 0);
        if (per_cu > 2) per_cu = 2;
        if (per_cu < 1) per_cu = 1;
        grid_blocks = cus * per_cu;
        if (grid_blocks != 512) { fprintf(stderr, "kernel_launch: this kernel's phase program is laid out for 512 resident workgroups (256 CUs x 2); the device offers %d: nothing launched\n", grid_blocks); grid_blocks = -1; }
        fprintf(stderr, "kernel_launch: cus %d per_cu %d grid %d ws_need %zu ws %zu\n", cus, per_cu, grid_blocks, (size_t)WS_NEED, ws_size);
    }
    if (grid_blocks < 0) return;
    P p{};
    for (int i = 0; i < N_IN; ++i) p.in[i] = (const float*)d_in[i];
    p.out = (float*)d_out; p.ws = (char*)d_ws;
    void* args[] = {&p};
    if (hipMemsetAsync((char*)d_ws + W_BAR, 0, 32768, stream) != hipSuccess) fprintf(stderr, "kernel_launch: memset of the barrier words failed\n");
    hipError_t e = hipLaunchCooperativeKernel((void*)mega, dim3(grid_blocks), dim3(NT), args, 0, stream);
    if (e != hipSuccess) fprintf(stderr, "cooperative launch failed: %s (grid %d)\n", hipGetErrorString(e), grid_blocks);
}
```

```cpp
#include <hip/hip_runtime.h>
#include <hip/hip_cooperative_groups.h>
#include <cstdio>
namespace cg = cooperative_groups;

typedef unsigned short bf16_t;
typedef short bf16x8 __attribute__((ext_vector_type(8)));
typedef float f32x16 __attribute__((ext_vector_type(16)));

#ifndef REP
#define REP 0
#endif
constexpr int NT = 256;
constexpr int D = 1024, SEQ = 8192, NBAT = 2, MP = NBAT * SEQ, MS = 128, M = MP + MS;
constexpr int EP = 2560, DFF = 2816, ZBW = 1792;
constexpr int LDS_BYTES = 73728;

enum { I_XP = 0, I_XS, I_CK, I_CV, I_WKV, I_SHIFT, I_CONV, I_NMPRE, I_NMPOST, I_NFPRE, I_NFPOST, I_WINE, I_SINK, I_MU, I_W0, I_W2, I_A0, I_A2, I_G2,
       I_KK, I_KA, I_RK, I_GNG, I_GNB, I_WOUTE, I_WINO, I_LNG, I_LNB, I_SGUW, I_SGUB, I_WOUTO, I_WG, I_WU, I_CW, I_CB, I_WD, N_IN };
constexpr size_t O_YP = 0, O_YS = O_YP + (size_t)MP * D, O_WKP = O_YS + (size_t)MS * D, O_WVP = O_WKP + 2 * 2 * 128 * 128, O_WKS = O_WVP + 2 * 2 * 128 * 128,
                 O_WVS = O_WKS + 2 * 128 * 128, O_SP = O_WVS + 2 * 128 * 128, O_SS = O_SP + 2 * 2 * 8 * 4096, O_SHP = O_SS + (size_t)2 * 128 * 8 * 4096,
                 O_SHS = O_SHP + 2 * 2 * ZBW, O_SGV = O_SHS + 2 * 128 * ZBW, O_CP = O_SGV + 2 * 128 * 1024, O_CS = O_CP + 4 * 2 * 2 * DFF, O_END = O_CS + (size_t)4 * 128 * 2 * DFF;
constexpr size_t al(size_t x) { return (x + 255) & ~(size_t)255; }
constexpr size_t W_WINE = 0, W_WOUTE = W_WINE + (size_t)2 * EP * D * 2, W_WINO = W_WOUTE + (size_t)2 * D * D * 2, W_WOUTO = W_WINO + (size_t)2 * 2048 * D * 2,
                 W_WGU = W_WOUTO + (size_t)2 * D * D * 2, W_WDN = W_WGU + (size_t)4 * 2 * DFF * D * 2, W_WLR = W_WDN + (size_t)4 * D * DFF * 2,
                 W_TRIL = W_WLR + (size_t)2 * 1536 * 256 * 2, W_ROPE = W_TRIL + (size_t)2 * 8 * 128 * 128 * 2, W_XN = al(W_ROPE + (size_t)8193 * 32 * 2 * 4),
                 W_AR = al(W_XN + (size_t)M * D * 2);
constexpr size_t A_Z = 0, A_LR = al(A_Z + (size_t)M * EP * 2), A_WAG = al(A_LR + (size_t)M * 256 * 2), A_OA = al(A_WAG + (size_t)M * 1536 * 2), A_EVEN_END = A_OA + (size_t)M * D * 2;
constexpr size_t A_ZU = 0, A_Y = al(A_ZU + (size_t)M * 2048 * 2), A_MO_ODD = al(A_Y + (size_t)M * D * 2);
constexpr size_t A_G = 0, A_U = al(A_G + (size_t)M * DFF * 2), A_FFN_END = A_U + (size_t)M * DFF * 2;
constexpr size_t W_BAR = al(W_AR + A_FFN_END);
constexpr size_t W_SAMP = W_BAR + 32768;
constexpr size_t S_Z = 0, S_LR = S_Z + (size_t)MS * EP * 2, S_WAG = S_LR + (size_t)MS * 256 * 2, S_OA = S_WAG + (size_t)MS * 1536 * 2, S_ZU = S_OA + (size_t)MS * D * 2,
                 S_Y = S_ZU + (size_t)MS * 2048 * 2, S_G = S_Y + (size_t)MS * D * 2, S_U = S_G + (size_t)MS * DFF * 2, S_MO = S_U + (size_t)MS * DFF * 2, S_END = S_MO + (size_t)MS * D * 4;
constexpr size_t W_SCN = al(W_SAMP + S_END);
constexpr size_t WS_NEED = W_SCN + (size_t)16 * 7 * 4096 * 4;

struct P { const float* in[N_IN]; float* out; char* ws; };
struct Ctx { bf16_t *Z, *LR, *WAG, *OA, *ZU, *Y, *G, *U; float *MOE, *MOO, *FO; int r0, r1, bid, nb; };

__device__ __forceinline__ int opaque_tid() { int t = threadIdx.x; asm volatile("" : "+v"(t)); return t; }
__device__ __forceinline__ int opaque_bid() { int t = blockIdx.x; asm volatile("" : "+s"(t)); return t; }
#define TIDX opaque_tid()
#define BIDX opaque_bid()
__device__ __forceinline__ bf16_t f2bf(float f) { unsigned u = __float_as_uint(f); u += 0x7fffu + ((u >> 16) & 1u); return (bf16_t)(u >> 16); }
__device__ __forceinline__ float bf2f(bf16_t h) { return __uint_as_float(((unsigned)h) << 16); }
__device__ __forceinline__ unsigned pk2(float a, float b) { return (unsigned)f2bf(a) | ((unsigned)f2bf(b) << 16); }
__device__ __forceinline__ float lo16(unsigned u) { return __uint_as_float(u << 16); }
__device__ __forceinline__ float hi16(unsigned u) { return __uint_as_float(u & 0xffff0000u); }
__device__ __forceinline__ float wave_sum(float v) {
#pragma unroll
    for (int o = 32; o > 0; o >>= 1) v += __shfl_xor(v, o);
    return v;
}
__device__ __forceinline__ float wave_max(float v) {
#pragma unroll
    for (int o = 32; o > 0; o >>= 1) v = fmaxf(v, __shfl_xor(v, o));
    return v;
}
__device__ __forceinline__ float sigmoidf_(float x) { return __builtin_amdgcn_rcpf(1.f + __expf(-x)); }
__device__ __forceinline__ float tanh_fast(float x) { return 1.f - 2.f * __builtin_amdgcn_rcpf(1.f + __expf(2.f * x)); }
__device__ __forceinline__ float gelu_erf(float v) {
    const float t = __builtin_amdgcn_rcpf(fabsf(v) * 0.2316418882f + 1.0f);
    float q = t * 0.5307027145f + (-0.7265760135f); q = q * t + 0.7107068705f; q = q * t + (-0.142248368f); q = q * t + 0.127414796f; q = q * t;
    const float m = v * (q * __builtin_amdgcn_exp2f((v * v) * (-0.72134752044f)));
    return v < 0.f ? m : v - m;
}
__device__ __forceinline__ float gelu_tanh(float x) { const float u2 = 1.5957691216057308f * (x + 0.044715f * x * x * x); return x * __builtin_amdgcn_rcpf(1.f + __expf(-u2)); }
template <int CTRL> __device__ __forceinline__ float dpp_add(float x) {
    int y = __builtin_amdgcn_update_dpp(0, __float_as_int(x), CTRL, 0xf, 0xf, false);
    return x + __int_as_float(y);
}
__device__ __forceinline__ float row16_sum(float x) {
    x = dpp_add<0xB1>(x); x = dpp_add<0x4E>(x); x = dpp_add<0x141>(x); x = dpp_add<0x140>(x); return x;
}


#define XB_TMO      128
#define XB_XCNT(j)  (256  + 64 * (j))
#define XB_XSUB(j)  (1280 + 64 * (j))
#define XB_XGEN(j)  (2304 + 64 * (j))
#define XB_TOP      3328
#define XB_TOPGEN   3392
#define XCD_BAR_WORDS 3456
#define XB_SPIN_CAP (1u << 20)
#define LAS __attribute__((address_space(3)))
__device__ __forceinline__ unsigned xb_ld(unsigned* p)              { return __hip_atomic_load(p, __ATOMIC_RELAXED, __HIP_MEMORY_SCOPE_AGENT); }
__device__ __forceinline__ unsigned xb_add(unsigned* p, unsigned v) { return __hip_atomic_fetch_add(p, v, __ATOMIC_RELAXED, __HIP_MEMORY_SCOPE_AGENT); }
__device__ __forceinline__ unsigned xb_xcc_id() { return (unsigned)__builtin_amdgcn_s_getreg((3 << 11) | 20) & 0xFu; }
#define XB_SPIN(cond, bar) do { unsigned _sp = 0; while (cond) { __builtin_amdgcn_s_sleep(1); \
    if ((++_sp & 255u) == 0u) { if (xb_ld(&(bar)[XB_TMO])) break; if (_sp > XB_SPIN_CAP) { atomicAdd(&(bar)[XB_TMO], 1u); break; } } } } while (0)
struct XcdBarrier { unsigned* bar; unsigned x; volatile LAS unsigned* st; unsigned G; };
__device__ __forceinline__ XcdBarrier xcd_barrier_post(unsigned* bar, volatile LAS unsigned* st, unsigned G) {
    XcdBarrier b; b.bar = bar; b.x = xb_xcc_id(); b.st = st; b.G = G;
    if (threadIdx.x == 0) (void)xb_add(&bar[XB_XCNT(b.x)], 1u);
    return b;
}
__device__ __forceinline__ void xcd_barrier_complete(unsigned* bar, unsigned x, unsigned G, unsigned& nloc, unsigned& nx) {
    unsigned sum, cnt, mine, sp = 0u;
    for (;;) {
        sum = 0u; cnt = 0u; mine = 0u;
#pragma unroll
        for (unsigned j = 0; j < 16; ++j) { const unsigned c = xb_ld(&bar[XB_XCNT(j)]); sum += c; cnt += (c > 0u) ? 1u : 0u; mine = (j == x) ? c : mine; }
        if (sum == G) break;
        __builtin_amdgcn_s_sleep(1);
        if ((++sp & 255u) == 0u) { if (xb_ld(&bar[XB_TMO])) break; if (sp > XB_SPIN_CAP) { atomicAdd(&bar[XB_TMO], 1u); break; } }
    }
    nloc = mine > 0u ? mine : 1u; nx = cnt > 0u ? cnt : 1u;
}
__device__ __forceinline__ void xcd_barrier(const XcdBarrier& b) {
    asm volatile("s_waitcnt vmcnt(0)" ::: "memory");
    __syncthreads();
    if (threadIdx.x == 0) {
        unsigned* bar = b.bar;
        __builtin_amdgcn_s_waitcnt(0);
        unsigned nloc = b.st[0], nx = b.st[1];
        if (nloc == 0u) { xcd_barrier_complete(bar, b.x, b.G, nloc, nx); b.st[0] = nloc; b.st[1] = nx; }
        const unsigned old = xb_add(&bar[XB_XSUB(b.x)], 1u);
        const unsigned gen = old / nloc;
        if (old + 1u == (gen + 1u) * nloc) {
            __builtin_amdgcn_fence(__ATOMIC_RELEASE, "agent");
            asm volatile("s_waitcnt vmcnt(0)" ::: "memory");
            const unsigned og = xb_add(&bar[XB_TOP], 1u);
            const unsigned tg = og / nx;
            if (og + 1u == (tg + 1u) * nx) xb_add(&bar[XB_TOPGEN], 1u);
            else XB_SPIN(xb_ld(&bar[XB_TOPGEN]) == tg, bar);
            __builtin_amdgcn_fence(__ATOMIC_ACQUIRE, "agent");
            xb_add(&bar[XB_XGEN(b.x)], 1u);
            asm volatile("s_waitcnt vmcnt(0)" ::: "memory");
        } else {
            XB_SPIN(xb_ld(&bar[XB_XGEN(b.x)]) == gen, bar);
            __builtin_amdgcn_fence(__ATOMIC_ACQUIRE, "agent");
            asm volatile("s_waitcnt vmcnt(0)" ::: "memory");
        }
    }
    __syncthreads();
}

__device__ __forceinline__ void rownorm_store(const float (&hv)[16], const float* g, bf16_t* xnrow, int lane) {
    float ss = 0.f;
#pragma unroll
    for (int e = 0; e < 16; ++e) ss += hv[e] * hv[e];
    ss = wave_sum(ss);
    const float rs = rsqrtf(ss * (1.f / D) + 1e-6f);
#pragma unroll
    for (int q = 0; q < 4; ++q) {
        const int c = lane * 4 + 256 * q;
        const float4 gv = *(const float4*)(g + c);
        uint2 o; o.x = pk2(hv[4 * q] * rs * gv.x, hv[4 * q + 1] * rs * gv.y); o.y = pk2(hv[4 * q + 2] * rs * gv.z, hv[4 * q + 3] * rs * gv.w);
        *(uint2*)(xnrow + c) = o;
    }
}

__device__ __forceinline__ void p0_phase(const P& p, char* lds) {
    const int tid = TIDX, lane = tid & 63, wave = tid >> 6;
    float* tl = (float*)lds;
    constexpr int TR_ITEMS = 11776;
    for (int it = BIDX; it < TR_ITEMS; it += gridDim.x) {
        const float* src; bf16_t* dst; int K, N; int r = it;
        if (r < 1280) { int jl = r / 640; r %= 640; src = p.in[I_WINE] + (size_t)jl * D * EP; dst = (bf16_t*)(p.ws + W_WINE) + (size_t)jl * EP * D; K = D; N = EP; }
        else if ((r -= 1280) < 512) { int jl = r / 256; r %= 256; src = p.in[I_WOUTE] + (size_t)jl * D * D; dst = (bf16_t*)(p.ws + W_WOUTE) + (size_t)jl * D * D; K = D; N = D; }
        else if ((r -= 512) < 1024) { int jl = r / 512; r %= 512; src = p.in[I_WINO] + (size_t)jl * D * 2048; dst = (bf16_t*)(p.ws + W_WINO) + (size_t)jl * 2048 * D; K = D; N = 2048; }
        else if ((r -= 1024) < 512) { int jl = r / 256; r %= 256; src = p.in[I_WOUTO] + (size_t)jl * D * D; dst = (bf16_t*)(p.ws + W_WOUTO) + (size_t)jl * D * D; K = D; N = D; }
        else if ((r -= 512) < 2816) { int L = r / 704; r %= 704; src = p.in[I_WG] + (size_t)L * D * DFF; dst = (bf16_t*)(p.ws + W_WGU) + (size_t)L * 2 * DFF * D; K = D; N = DFF; }
        else if ((r -= 2816) < 2816) { int L = r / 704; r %= 704; src = p.in[I_WU] + (size_t)L * D * DFF; dst = (bf16_t*)(p.ws + W_WGU) + (size_t)L * 2 * DFF * D + (size_t)DFF * D; K = D; N = DFF; }
        else { r -= 2816; int L = r / 704; r %= 704; src = p.in[I_WD] + (size_t)L * DFF * D; dst = (bf16_t*)(p.ws + W_WDN) + (size_t)L * D * DFF; K = DFF; N = D; }
        const int nb = N / 64, k0 = (r / nb) * 64, n0 = (r % nb) * 64;
#pragma unroll
        for (int q = 0; q < 4; ++q) {
            const int row = (tid >> 4) + 16 * q, c4 = (tid & 15) * 4;
            const float4 v = *(const float4*)(src + (size_t)(k0 + row) * N + n0 + c4);
            tl[row * 65 + c4] = v.x; tl[row * 65 + c4 + 1] = v.y; tl[row * 65 + c4 + 2] = v.z; tl[row * 65 + c4 + 3] = v.w;
        }
        __syncthreads();
#pragma unroll
        for (int q = 0; q < 2; ++q) {
            const int ch = tid + 256 * q, n = ch >> 3, k8 = ch & 7;
            uint4 o;
            o.x = pk2(tl[(k8 * 8 + 0) * 65 + n], tl[(k8 * 8 + 1) * 65 + n]); o.y = pk2(tl[(k8 * 8 + 2) * 65 + n], tl[(k8 * 8 + 3) * 65 + n]);
            o.z = pk2(tl[(k8 * 8 + 4) * 65 + n], tl[(k8 * 8 + 5) * 65 + n]); o.w = pk2(tl[(k8 * 8 + 6) * 65 + n], tl[(k8 * 8 + 7) * 65 + n]);
            *(uint4*)(dst + (size_t)(n0 + n) * K + k0 + k8 * 8) = o;
        }
        __syncthreads();
    }
    const int gt = BIDX * NT + tid, gs = gridDim.x * NT;
    {
        bf16_t* wlr = (bf16_t*)(p.ws + W_WLR);
        for (int e = gt; e < 2 * 1536 * 256; e += gs) {
            const int jl = e / (1536 * 256), n = (e / 256) % 1536, k = e & 255;
            float v = 0.f;
            if (n < 512) { if (k < 64) v = p.in[I_W2][(size_t)jl * 64 * 512 + k * 512 + n]; }
            else if (n < 1024) { if (k >= 64 && k < 128) v = p.in[I_A2][(size_t)jl * 64 * 512 + (k - 64) * 512 + (n - 512)]; }
            else { if (k >= 128) v = p.in[I_G2][(size_t)jl * 128 * 512 + (k - 128) * 512 + (n - 1024)]; }
            wlr[e] = f2bf(v);
        }
        bf16_t* tr = (bf16_t*)(p.ws + W_TRIL);
        for (int e = gt; e < 2 * 8 * 128 * 128; e += gs) { const int t = (e >> 7) & 127, s = e & 127; tr[e] = f2bf(s <= t ? p.in[I_SGUW][e] : 0.f); }
        float* rope = (float*)(p.ws + W_ROPE);
        for (int e = gt; e < 8193 * 32; e += gs) {
            const int pos = e >> 5, i = e & 31;
            double inv = 1.0; for (int q = 0; q < i; ++q) inv *= 0.7498942093324559;
            double x = (double)pos * inv;
            const double TWO_PI = 6.283185307179586;
            double n = rint(x / TWO_PI); x -= n * TWO_PI;
            double qd = rint(x / 1.5707963267948966); double r = x - qd * 1.5707963267948966; int qi = ((int)qd) & 3;
            double r2 = r * r;
            double sn = r * (1.0 + r2 * (-1.0 / 6 + r2 * (1.0 / 120 + r2 * (-1.0 / 5040 + r2 * (1.0 / 362880 + r2 * (-1.0 / 39916800 + r2 * (1.0 / 6227020800.0)))))));
            double cs = 1.0 + r2 * (-0.5 + r2 * (1.0 / 24 + r2 * (-1.0 / 720 + r2 * (1.0 / 40320 + r2 * (-1.0 / 3628800 + r2 * (1.0 / 479001600.0))))));
            double c, s;
            if (qi == 0) { c = cs; s = sn; } else if (qi == 1) { c = -sn; s = cs; } else if (qi == 2) { c = -cs; s = -sn; } else { c = sn; s = -cs; }
            rope[e] = (float)c; rope[8193 * 32 + e] = (float)s;
        }
    }
    for (int row = BIDX * 4 + wave; row < M; row += gridDim.x * 4) {
        const float* xr = row < MP ? p.in[I_XP] + (size_t)row * D : p.in[I_XS] + (size_t)(row - MP) * D;
        float hv[16];
#pragma unroll
        for (int q = 0; q < 4; ++q) { const float4 v = *(const float4*)(xr + lane * 4 + 256 * q); hv[4 * q] = v.x; hv[4 * q + 1] = v.y; hv[4 * q + 2] = v.z; hv[4 * q + 3] = v.w; }
        rownorm_store(hv, p.in[I_NMPRE], (bf16_t*)(p.ws + W_XN) + (size_t)row * D, lane);
    }
}

typedef float f32x4v __attribute__((ext_vector_type(4)));
__device__ __forceinline__ void rownorm_phase(const P& p, const Ctx& cx, const float* mo, const float* gpost, const float* gnext, bool first = false) {
    const int lane = TIDX & 63, wave = TIDX >> 6;
    const int stride = cx.nb * 4;
    f32x4v gp[4], gn[4];
#pragma unroll
    for (int q = 0; q < 4; ++q) { gp[q] = *(const f32x4v*)(gpost + lane * 4 + 256 * q); gn[q] = gnext ? *(const f32x4v*)(gnext + lane * 4 + 256 * q) : (f32x4v){0.f, 0.f, 0.f, 0.f}; }
    for (int row = cx.r0 + cx.bid * 4 + wave; row < cx.r1; row += 2 * stride) {
        const int rowb = row + stride; const bool hasb = rowb < cx.r1; const int rb = hasb ? rowb : row;
        f32x4v ma[4], ha[4], mb[4], hb[4];
        float* hra = p.out + (size_t)row * D + lane * 4; float* hrb = p.out + (size_t)rb * D + lane * 4;
#pragma unroll
        for (int q = 0; q < 4; ++q) { ma[q] = *(const f32x4v*)(mo + (size_t)row * D + lane * 4 + 256 * q); mb[q] = *(const f32x4v*)(mo + (size_t)rb * D + lane * 4 + 256 * q); }
        const float* hsa = first ? (row < MP ? p.in[I_XP] + (size_t)row * D : p.in[I_XS] + (size_t)(row - MP) * D) + lane * 4 : hra;
        const float* hsb = first ? (rb < MP ? p.in[I_XP] + (size_t)rb * D : p.in[I_XS] + (size_t)(rb - MP) * D) + lane * 4 : hrb;
#pragma unroll
        for (int q = 0; q < 4; ++q) { ha[q] = *(const f32x4v*)(hsa + 256 * q); hb[q] = *(const f32x4v*)(hsb + 256 * q); }
        float sa = 0.f, sb = 0.f;
#pragma unroll
        for (int q = 0; q < 4; ++q) { const f32x4v a2 = ma[q] * ma[q], b2 = mb[q] * mb[q]; sa += (a2.x + a2.y) + (a2.z + a2.w); sb += (b2.x + b2.y) + (b2.z + b2.w); }
#pragma unroll
        for (int o = 32; o > 0; o >>= 1) { sa += __shfl_xor(sa, o); sb += __shfl_xor(sb, o); }
        const float rsa = rsqrtf(sa * (1.f / D) + 1e-6f), rsb = rsqrtf(sb * (1.f / D) + 1e-6f);
        float ta = 0.f, tb = 0.f;
#pragma unroll
        for (int q = 0; q < 4; ++q) {
            ha[q] = ha[q] + ma[q] * rsa * gp[q]; hb[q] = hb[q] + mb[q] * rsb * gp[q];
            *(f32x4v*)(hra + 256 * q) = ha[q]; if (hasb) *(f32x4v*)(hrb + 256 * q) = hb[q];
            const f32x4v a2 = ha[q] * ha[q], b2 = hb[q] * hb[q]; ta += (a2.x + a2.y) + (a2.z + a2.w); tb += (b2.x + b2.y) + (b2.z + b2.w);
        }
        if (gnext) {
#pragma unroll
            for (int o = 32; o > 0; o >>= 1) { ta += __shfl_xor(ta, o); tb += __shfl_xor(tb, o); }
            const float ra = rsqrtf(ta * (1.f / D) + 1e-6f), rbb = rsqrtf(tb * (1.f / D) + 1e-6f);
            bf16_t* xa = (bf16_t*)(p.ws + W_XN) + (size_t)row * D + lane * 4; bf16_t* xb = (bf16_t*)(p.ws + W_XN) + (size_t)rb * D + lane * 4;
#pragma unroll
            for (int q = 0; q < 4; ++q) {
                const f32x4v ya = ha[q] * ra * gn[q], yb = hb[q] * rbb * gn[q];
                uint2 oa; oa.x = pk2(ya.x, ya.y); oa.y = pk2(ya.z, ya.w); *(uint2*)(xa + 256 * q) = oa;
                if (hasb) { uint2 ob; ob.x = pk2(yb.x, yb.y); ob.y = pk2(yb.z, yb.w); *(uint2*)(xb + 256 * q) = ob; }
            }
        }
    }
}

constexpr int BM = 128, BN = 128, BK = 64, LROW = 144  , OPB = 128 * LROW  , STG = 2 * OPB;
enum { EPI_F32 = 0, EPI_EVENIN, EPI_LR, EPI_GU, EPI_ODDIN };
struct EA { float* c32; bf16_t* o16; bf16_t* o16b; int layer; int ksplit; };

template <int EPI>
__device__ __forceinline__ void gemm_epilogue(const P& p, const f32x16 (&acc)[2][2], int m0, int n0, int wm, int wn, int lane, const EA& ea, int N) {
    const int h = lane >> 5, lr = lane & 31;
    const int jl = ea.layer >> 1;
#pragma unroll
    for (int i = 0; i < 2; ++i) {
        const int m = m0 + wm * 64 + i * 32 + lr;
        const int hb = n0 + wn * 64;
        float v[2][16];
#pragma unroll
        for (int j = 0; j < 2; ++j)
#pragma unroll
            for (int e = 0; e < 16; ++e) v[j][e] = acc[i][j][e];
        if (EPI == EPI_EVENIN) {
            const bool prompt = m < MP; const int t = m & (SEQ - 1), b = m >> 13, bs = m - MP;
            if (hb < 640) {
                const int pos = prompt ? t : SEQ;
                const float* rc = (const float*)(p.ws + W_ROPE) + (size_t)pos * 32; const float* rsn = rc + 8193 * 32;
#pragma unroll
                for (int g = 0; g < 4; ++g) {
                    const float4 c4 = *(const float4*)(rc + 8 * g + 4 * h), s4 = *(const float4*)(rsn + 8 * g + 4 * h);
                    const float cc[4] = {c4.x, c4.y, c4.z, c4.w}, sn[4] = {s4.x, s4.y, s4.z, s4.w};
#pragma unroll
                    for (int e = 0; e < 4; ++e) { const float x1 = v[0][4 * g + e], x2 = v[1][4 * g + e]; v[0][4 * g + e] = x1 * cc[e] - x2 * sn[e]; v[1][4 * g + e] = x2 * cc[e] + x1 * sn[e]; }
                }
            }
#pragma unroll
            for (int j = 0; j < 2; ++j)
#pragma unroll
                for (int g = 0; g < 4; ++g) {
                    const int dc = j * 32 + 8 * g + 4 * h;
                    uint2 o; o.x = pk2(v[j][4 * g], v[j][4 * g + 1]); o.y = pk2(v[j][4 * g + 2], v[j][4 * g + 3]);
                    *(uint2*)(ea.o16 + (size_t)m * EP + hb + dc) = o;
                    const float4 f4 = make_float4(v[j][4 * g], v[j][4 * g + 1], v[j][4 * g + 2], v[j][4 * g + 3]);
                    if (hb >= 512 && hb < 768) {
                        const int kvh = ((hb - 512) >> 6) & 1; const bool isv = hb >= 640;
                        if (prompt) { if (t >= SEQ - 128) *(float4*)(p.out + (isv ? O_WVP : O_WKP) + ((size_t)((jl * 2 + b) * 128 + (t - (SEQ - 128))) * 2 + kvh) * 64 + dc) = f4; }
                        else *(float4*)(p.out + (isv ? O_WVS : O_WKS) + ((size_t)(jl * 128 + bs) * 2 + kvh) * 64 + dc) = f4;
                    } else if (hb >= 768) {
                        const int zc = hb - 768 + dc;
                        if (prompt) { if (t == SEQ - 1) *(float4*)(p.out + O_SHP + (size_t)(jl * 2 + b) * ZBW + zc) = f4; }
                        else {
                            *(float4*)(p.out + O_SHS + (size_t)(jl * 128 + bs) * ZBW + zc) = f4;
                            if (zc >= 1536) {
                                const float4 pv = *(const float4*)(p.in[I_SHIFT] + (size_t)(jl * 128 + bs) * ZBW + zc), mu4 = *(const float4*)(p.in[I_MU] + jl * ZBW + zc);
                                const float pr[4] = {pv.x, pv.y, pv.z, pv.w}, mm[4] = {mu4.x, mu4.y, mu4.z, mu4.w}; float lo[4];
                                const int c = zc - 1536;
                                const float vq[4] = {f4.x, f4.y, f4.z, f4.w};
#pragma unroll
                                for (int e = 0; e < 4; ++e) { const float zs = vq[e] + (pr[e] - vq[e]) * mm[e]; lo[e] = c < 64 ? tanh_fast(zs) : (c < 128 ? zs : sigmoidf_(zs)); }
                                uint2 ol; ol.x = pk2(lo[0], lo[1]); ol.y = pk2(lo[2], lo[3]);
                                *(uint2*)(ea.o16b + (size_t)m * 256 + c) = ol;
                            }
                        }
                    }
                }
        } else {
#pragma unroll
            for (int j = 0; j < 2; ++j)
#pragma unroll
                for (int g = 0; g < 4; ++g) {
                    const int col = hb + j * 32 + 8 * g + 4 * h;
                    float x0 = v[j][4 * g], x1 = v[j][4 * g + 1], x2 = v[j][4 * g + 2], x3 = v[j][4 * g + 3];
                    if (EPI == EPI_F32) {
                        float* cp = ea.c32 + (size_t)m * N + col;
                        if (ea.ksplit > 1) { atomicAdd(cp, x0); atomicAdd(cp + 1, x1); atomicAdd(cp + 2, x2); atomicAdd(cp + 3, x3); }
                        else *(float4*)cp = make_float4(x0, x1, x2, x3);
                    } else if (EPI == EPI_ODDIN) {
                        uint2 o; o.x = pk2(gelu_erf(x0), gelu_erf(x1)); o.y = pk2(gelu_erf(x2), gelu_erf(x3));
                        *(uint2*)(ea.o16 + (size_t)m * 2048 + col) = o;
                    } else if (EPI == EPI_LR) {
                        float xs[4] = {x0, x1, x2, x3};
                        if (col < 512) {
                            const float4 w0 = *(const float4*)(p.in[I_W0] + jl * 512 + col); const float ww[4] = {w0.x, w0.y, w0.z, w0.w};
#pragma unroll
                            for (int e = 0; e < 4; ++e) xs[e] = 1.f - __expf(-0.606531f * sigmoidf_(xs[e] + ww[e]));
                        } else if (col < 1024) {
                            const float4 a0 = *(const float4*)(p.in[I_A0] + jl * 512 + col - 512); const float aa[4] = {a0.x, a0.y, a0.z, a0.w};
#pragma unroll
                            for (int e = 0; e < 4; ++e) xs[e] = sigmoidf_(xs[e] + aa[e]);
                        }
                        uint2 o; o.x = pk2(xs[0], xs[1]); o.y = pk2(xs[2], xs[3]);
                        *(uint2*)(ea.o16 + (size_t)m * 1536 + col) = o;
                    } else if (EPI == EPI_GU) {
                        uint2 o; o.x = pk2(x0, x1); o.y = pk2(x2, x3);
                        if (col < DFF) {
                            *(uint2*)(ea.o16 + (size_t)m * DFF + col) = o;
                            const int L = ea.layer;
                            if (m < MP) { const int t = m & (SEQ - 1), b = m >> 13; if (t >= SEQ - 2) *(float4*)(p.out + O_CP + ((size_t)(L * 2 + b) * 2 + (t - (SEQ - 2))) * DFF + col) = make_float4(x0, x1, x2, x3); }
                            else { const int bs = m - MP; const size_t base = ((size_t)(L * 128 + bs) * 2) * DFF + col;
                                *(float4*)(p.out + O_CS + base + DFF) = make_float4(x0, x1, x2, x3);
                                *(float4*)(p.out + O_CS + base) = *(const float4*)(p.in[I_CONV] + base + DFF); }
                        } else *(uint2*)(ea.o16b + (size_t)m * DFF + col - DFF) = o;
                    }
                }
        }
    }
}

typedef unsigned u32x4 __attribute__((ext_vector_type(4)));
struct Stg { u32x4 a0, a1, a2, a3, b0, b1, b2, b3; };
__device__ __forceinline__ void stg_load(Stg& r, const bf16_t* ga, const bf16_t* gb, size_t sa, size_t sb) {
    r.a0 = *(const u32x4*)(ga); r.a1 = *(const u32x4*)(ga + sa); r.a2 = *(const u32x4*)(ga + 2 * sa); r.a3 = *(const u32x4*)(ga + 3 * sa);
    r.b0 = *(const u32x4*)(gb); r.b1 = *(const u32x4*)(gb + sb); r.b2 = *(const u32x4*)(gb + 2 * sb); r.b3 = *(const u32x4*)(gb + 3 * sb);
}
__device__ __forceinline__ void stg_store(const Stg& r, char* w) {
    *(u32x4*)(w) = r.a0; *(u32x4*)(w + 32 * LROW) = r.a1; *(u32x4*)(w + 64 * LROW) = r.a2; *(u32x4*)(w + 96 * LROW) = r.a3;
    *(u32x4*)(w + OPB) = r.b0; *(u32x4*)(w + OPB + 32 * LROW) = r.b1; *(u32x4*)(w + OPB + 64 * LROW) = r.b2; *(u32x4*)(w + OPB + 96 * LROW) = r.b3;
}
__device__ __forceinline__ void gemm_ktile(f32x16 (&acc)[2][2], const char* sA, const char* sB) {
    __builtin_amdgcn_s_setprio(1);
#pragma unroll
    for (int ks = 0; ks < 4; ++ks) {
        bf16x8 xa[2], wb[2];
#pragma unroll
        for (int i = 0; i < 2; ++i) xa[i] = *(const bf16x8*)(sA + i * 32 * LROW + ks * 32);
#pragma unroll
        for (int j = 0; j < 2; ++j) wb[j] = *(const bf16x8*)(sB + j * 32 * LROW + ks * 32);
#pragma unroll
        for (int i = 0; i < 2; ++i)
#pragma unroll
            for (int j = 0; j < 2; ++j) acc[i][j] = __builtin_amdgcn_mfma_f32_32x32x16_bf16(wb[j], xa[i], acc[i][j], 0, 0, 0);
    }
    __builtin_amdgcn_s_setprio(0);
}
template <int EPI>
__device__ __forceinline__ void gemm_phase(const P& p, const bf16_t* __restrict__ A, int lda, const bf16_t* __restrict__ Bt, int N, int K, char* lds, EA ea, const Ctx& cx) {
    const int tid = TIDX, lane = tid & 63, wave = tid >> 6, wm = wave >> 1, wn = wave & 1;
    const int ks_n = ea.ksplit, ntn = N / BN, mt0 = cx.r0 / BM, ntiles = ((cx.r1 - cx.r0) / BM) * ntn * ks_n, nk = K / BK / ks_n;
    const int lrow = tid >> 3, lc8 = tid & 7;
    const size_t sa = (size_t)32 * lda, sb = (size_t)32 * K;
    for (int tile = cx.bid; tile < ntiles; tile += cx.nb) {
        const int kpart = tile % ks_n, t2 = tile / ks_n;
        int mt, nt;
        if (cx.r0 == 0 && (cx.nb & 7) == 0) {
            const int x = cx.bid & 7, per = cx.nb >> 3, i = (cx.bid >> 3) + per * ((tile - cx.bid) / cx.nb);
            const int mi = i & 7, rest = i >> 3, nn = rest % ntn, mg = rest / ntn;
            mt = 16 * x + 8 * mg + mi; nt = nn;
        } else { mt = mt0 + t2 / ntn; nt = t2 % ntn; }
        const int m0 = mt * BM, n0 = nt * BN;
        const bf16_t* ga = A + (size_t)(m0 + lrow) * lda + lc8 * 8 + kpart * nk * BK;
        const bf16_t* gb = Bt + (size_t)(n0 + lrow) * K + lc8 * 8 + kpart * nk * BK;
        Stg r0, r1;
        stg_load(r0, ga, gb, sa, sb);
        stg_load(r1, ga + BK, gb + BK, sa, sb);
        f32x16 acc[2][2];
#pragma unroll
        for (int i = 0; i < 2; ++i)
#pragma unroll
            for (int j = 0; j < 2; ++j)
#pragma unroll
                for (int e = 0; e < 16; ++e) acc[i][j][e] = 0.f;
        char* wA = lds + lrow * LROW + lc8 * 16;
        stg_store(r0, wA);
        __syncthreads();
        const char* sA0 = lds + (wm * 64 + (lane & 31)) * LROW + (lane >> 5) * 16;
        const char* sB0 = lds + OPB + (wn * 64 + (lane & 31)) * LROW + (lane >> 5) * 16;
        for (int kt = 0; kt < nk; kt += 2) {
            if (kt + 2 < nk) stg_load(r0, ga + (kt + 2) * BK, gb + (kt + 2) * BK, sa, sb);
            __builtin_amdgcn_sched_barrier(0);
            gemm_ktile(acc, sA0, sB0);
            stg_store(r1, wA + STG);
            __syncthreads();
            if (kt + 3 < nk) stg_load(r1, ga + (kt + 3) * BK, gb + (kt + 3) * BK, sa, sb);
            __builtin_amdgcn_sched_barrier(0);
            gemm_ktile(acc, sA0 + STG, sB0 + STG);
            if (kt + 2 < nk) stg_store(r0, wA);
            __syncthreads();
        }
        gemm_epilogue<EPI>(p, acc, m0, n0, wm, wn, lane, ea, N);
    }
}

__device__ __forceinline__ void lr_phase(const P& p, const Ctx& cx, int jl) {
    const bf16_t* Z = cx.Z; bf16_t* LR = cx.LR;
    const int gt = cx.bid * NT + TIDX, gs = cx.nb * NT;
    for (int it = gt; it < (cx.r1 - cx.r0) * 32; it += gs) {
        const int m = cx.r0 + (it >> 5), c8 = it & 31, zc = 1536 + c8 * 8;
        const uint4 cur = *(const uint4*)(Z + (size_t)m * EP + 768 + zc);
        float pv[8];
        if (m < MP) {
            if ((m & (SEQ - 1)) == 0) { for (int e = 0; e < 8; ++e) pv[e] = 0.f; }
            else { const uint4 pr = *(const uint4*)(Z + (size_t)(m - 1) * EP + 768 + zc); pv[0] = lo16(pr.x); pv[1] = hi16(pr.x); pv[2] = lo16(pr.y); pv[3] = hi16(pr.y); pv[4] = lo16(pr.z); pv[5] = hi16(pr.z); pv[6] = lo16(pr.w); pv[7] = hi16(pr.w); }
        } else { const float* st = p.in[I_SHIFT] + (size_t)(jl * 128 + (m - MP)) * ZBW + zc; for (int e = 0; e < 8; ++e) pv[e] = st[e]; }
        const float cv[8] = {lo16(cur.x), hi16(cur.x), lo16(cur.y), hi16(cur.y), lo16(cur.z), hi16(cur.z), lo16(cur.w), hi16(cur.w)};
        const float* mu = p.in[I_MU] + jl * ZBW + zc;
        float o[8];
#pragma unroll
        for (int e = 0; e < 8; ++e) { const float zs = cv[e] + (pv[e] - cv[e]) * mu[e]; o[e] = c8 < 8 ? tanh_fast(zs) : (c8 < 16 ? zs : sigmoidf_(zs)); }
        uint4 ov; ov.x = pk2(o[0], o[1]); ov.y = pk2(o[2], o[3]); ov.z = pk2(o[4], o[5]); ov.w = pk2(o[6], o[7]);
        *(uint4*)(LR + (size_t)m * 256 + c8 * 8) = ov;
    }
}

__device__ __forceinline__ float zs_val(const P& p, const bf16_t* Z, int jl, int m, int c) {
    const float cur = bf2f(Z[(size_t)m * EP + 768 + c]);
    float prev;
    if (m < MP) prev = (m & (SEQ - 1)) == 0 ? 0.f : bf2f(Z[(size_t)(m - 1) * EP + 768 + c]);
    else prev = p.in[I_SHIFT][(size_t)(jl * 128 + (m - MP)) * ZBW + c];
    return cur + (prev - cur) * p.in[I_MU][jl * ZBW + c];
}

constexpr int TC = 32;
typedef float f32x2 __attribute__((ext_vector_type(2)));
typedef float f32x4 __attribute__((ext_vector_type(4)));
struct ScanRaw { u32x4 cr, ck, cv, pr, pk, pv, ep, av; };
__device__ __forceinline__ void scan_load(ScanRaw& R, const bf16_t* Z, const bf16_t* WAG, int m, int t, int c) {
    const bf16_t* zr = Z + (size_t)m * EP + 768;
    R.cr = *(const u32x4*)(zr + c); R.ck = *(const u32x4*)(zr + 512 + c); R.cv = *(const u32x4*)(zr + 1024 + c);
    R.pr = (u32x4){0u, 0u, 0u, 0u}; R.pk = R.pr; R.pv = R.pr;
    if (t > 0) { R.pr = *(const u32x4*)(zr - EP + c); R.pk = *(const u32x4*)(zr - EP + 512 + c); R.pv = *(const u32x4*)(zr - EP + 1024 + c); }
    R.ep = *(const u32x4*)(WAG + (size_t)m * 1536 + c); R.av = *(const u32x4*)(WAG + (size_t)m * 1536 + 512 + c);
}
constexpr int NCH = 5, SCAN_P1 = 256, SCAN_P2 = 256, SCAN_BLOCKS = 256;
__device__ __forceinline__ int chunk_begin(int c) { return c >= NCH ? SEQ : (c == 0 ? 0 : 2080 + (c - 1) * 1536); }
enum { SC_FULL = 0, SC_DUAL = 3 };
template <int mode>
__device__ __forceinline__ void scan_task(const P& p, const Ctx& cx, int jl, char* lds, int seq, int rg, int chunk) {
    const bf16_t* Z = cx.Z; const bf16_t* WAG = cx.WAG; bf16_t* OA = cx.OA;
    float* SEND0 = (float*)(p.ws + W_SCN); float* PM = SEND0 + 16 * 4096; float* LOC = PM + 16 * (NCH - 2) * 4096;
    const int b = seq >> 3, hd = seq & 7;
    const int tid = TIDX, lane = tid & 63, wave = tid >> 6;
    const int rowl = wave * 4 + (lane >> 4), row = rg * 16 + rowl, c4 = (lane & 15) * 4;
    float* sW = (float*)lds; float* sKK = sW + TC * 64; float* sBB = sKK + TC * 64; float* sK2 = sBB + TC * 64; float* sR = sK2 + TC * 64; float* sV = sR + TC * 64;
    float* sQ = sV + TC * 64;
    f32x4 x = {0.f, 0.f, 0.f, 0.f};
    f32x2 p01 = {(c4 == row) ? 1.f : 0.f, (c4 + 1 == row) ? 1.f : 0.f}, p23 = {(c4 + 2 == row) ? 1.f : 0.f, (c4 + 3 == row) ? 1.f : 0.f};
    if (mode == SC_FULL && chunk > 0) {
        x = *(const f32x4*)(SEND0 + (size_t)seq * 4096 + row * 64 + c4);
        for (int cc = 1; cc < chunk; ++cc) {
            *(f32x4*)(sQ + rowl * 64 + c4) = x;
            __syncthreads();
            const float* pm = PM + ((size_t)seq * (NCH - 2) + (cc - 1)) * 4096 + c4;
            f32x4 acc = *(const f32x4*)(LOC + ((size_t)seq * (NCH - 2) + (cc - 1)) * 4096 + row * 64 + c4);
#pragma unroll 8
            for (int j = 0; j < 64; ++j) { const float a = sQ[rowl * 64 + j]; const f32x4 pv = *(const f32x4*)(pm + j * 64); acc += pv * a; }
            __syncthreads();
            x = acc;
        }
    }
    f32x2 s01 = x.lo, s23 = x.hi;
    const int ptt = tid >> 3, pj0 = (tid & 7) * 8, pc = hd * 64 + pj0;
    const float* mu = p.in[I_MU] + jl * ZBW;
    float mur[8], muk[8], muv[8], kkw[8], kaw[8];
#pragma unroll
    for (int e = 0; e < 8; ++e) { mur[e] = mu[pc + e]; muk[e] = mu[512 + pc + e]; muv[e] = mu[1024 + pc + e]; kkw[e] = p.in[I_KK][jl * 512 + pc + e]; kaw[e] = p.in[I_KA][jl * 512 + pc + e]; }
    const int tb = chunk_begin(chunk), te = chunk_begin(chunk + 1);
    ScanRaw R;
    scan_load(R, Z, WAG, b * SEQ + tb + ptt, tb + ptt, pc);
    const float vscale = 1.f;
    for (int t0 = tb; t0 < te; t0 += TC) {
        {
            const unsigned crr[4] = {R.cr.x, R.cr.y, R.cr.z, R.cr.w}, ckk[4] = {R.ck.x, R.ck.y, R.ck.z, R.ck.w}, cvv[4] = {R.cv.x, R.cv.y, R.cv.z, R.cv.w};
            const unsigned prr[4] = {R.pr.x, R.pr.y, R.pr.z, R.pr.w}, pkk[4] = {R.pk.x, R.pk.y, R.pk.z, R.pk.w}, pv4[4] = {R.pv.x, R.pv.y, R.pv.z, R.pv.w};
            const unsigned epp[4] = {R.ep.x, R.ep.y, R.ep.z, R.ep.w}, avv[4] = {R.av.x, R.av.y, R.av.z, R.av.w};
            float rr[8], kx[8], vx[8], kkr[8], aa[8], ee[8]; float ssq = 0.f;
#pragma unroll
            for (int e = 0; e < 8; ++e) {
                const int w_ = e >> 1; const bool hi = e & 1;
                const float r_c = hi ? hi16(crr[w_]) : lo16(crr[w_]), r_p = hi ? hi16(prr[w_]) : lo16(prr[w_]);
                const float k_c = hi ? hi16(ckk[w_]) : lo16(ckk[w_]), k_p = hi ? hi16(pkk[w_]) : lo16(pkk[w_]);
                const float v_c = hi ? hi16(cvv[w_]) : lo16(cvv[w_]), v_p = hi ? hi16(pv4[w_]) : lo16(pv4[w_]);
                rr[e] = r_c + (r_p - r_c) * mur[e]; kx[e] = k_c + (k_p - k_c) * muk[e]; vx[e] = (v_c + (v_p - v_c) * muv[e]) * vscale;
                ee[e] = hi ? hi16(epp[w_]) : lo16(epp[w_]); aa[e] = hi ? hi16(avv[w_]) : lo16(avv[w_]);
                kkr[e] = kx[e] * kkw[e]; ssq += kkr[e] * kkr[e];
            }
            ssq += __shfl_xor(ssq, 1); ssq += __shfl_xor(ssq, 2); ssq += __shfl_xor(ssq, 4);
            const float inv = 1.f / fmaxf(sqrtf(ssq), 1e-12f);
            float ow[8], okk[8], obb[8], ok2[8];
#pragma unroll
            for (int e = 0; e < 8; ++e) { const float kkn = kkr[e] * inv; ow[e] = 1.f - ee[e]; okk[e] = kkn; obb[e] = kkn * aa[e]; ok2[e] = kx[e] * (1.f + (aa[e] - 1.f) * kaw[e]); }
            const int o = ptt * 64 + pj0;
            *(float4*)(sW + o) = make_float4(ow[0], ow[1], ow[2], ow[3]); *(float4*)(sW + o + 4) = make_float4(ow[4], ow[5], ow[6], ow[7]);
            *(float4*)(sKK + o) = make_float4(okk[0], okk[1], okk[2], okk[3]); *(float4*)(sKK + o + 4) = make_float4(okk[4], okk[5], okk[6], okk[7]);
            *(float4*)(sBB + o) = make_float4(obb[0], obb[1], obb[2], obb[3]); *(float4*)(sBB + o + 4) = make_float4(obb[4], obb[5], obb[6], obb[7]);
            *(float4*)(sK2 + o) = make_float4(ok2[0], ok2[1], ok2[2], ok2[3]); *(float4*)(sK2 + o + 4) = make_float4(ok2[4], ok2[5], ok2[6], ok2[7]);
            *(float4*)(sR + o) = make_float4(rr[0], rr[1], rr[2], rr[3]); *(float4*)(sR + o + 4) = make_float4(rr[4], rr[5], rr[6], rr[7]);
            *(float4*)(sV + o) = make_float4(vx[0], vx[1], vx[2], vx[3]); *(float4*)(sV + o + 4) = make_float4(vx[4], vx[5], vx[6], vx[7]);
        }
        __syncthreads();
        if (t0 + TC < te) scan_load(R, Z, WAG, b * SEQ + t0 + TC + ptt, t0 + TC + ptt, pc);
        {
            const float* base = sW + c4;
            float* qdst = ((lane & 3) == 0) ? (sQ + rowl * 4 + ((lane & 15) >> 2)) : (sQ + TC * 64 + lane);
            const int qstep = ((lane & 3) == 0) ? 64 : 0;
            const float* vb = sV + row;
            f32x4 kk = *(const f32x4*)(base + TC * 64), w = *(const f32x4*)(base), bb = *(const f32x4*)(base + 2 * TC * 64), k2 = *(const f32x4*)(base + 3 * TC * 64), r = *(const f32x4*)(base + 4 * TC * 64);
            float vi = vb[0];
            f32x4 kk1 = *(const f32x4*)(base + TC * 64 + 64), w1 = *(const f32x4*)(base + 64), bb1 = *(const f32x4*)(base + 2 * TC * 64 + 64), k21 = *(const f32x4*)(base + 3 * TC * 64 + 64), r1 = *(const f32x4*)(base + 4 * TC * 64 + 64);
            float vi1 = vb[64];
#pragma unroll 16
            for (int tt = 0; tt < TC; ++tt) {
                const int tn = (tt + 2 < TC) ? tt + 2 : TC - 1;
                const f32x4 nkk = *(const f32x4*)(base + TC * 64 + tn * 64), nw = *(const f32x4*)(base + tn * 64), nbb = *(const f32x4*)(base + 2 * TC * 64 + tn * 64),
                            nk2 = *(const f32x4*)(base + 3 * TC * 64 + tn * 64), nr = *(const f32x4*)(base + 4 * TC * 64 + tn * 64);
                const float nvi = vb[tn * 64];
                const f32x2 viv = {vi, vi};
                const f32x2 tp = s01 * kk.lo + s23 * kk.hi;
                float pp = tp.x + tp.y;
                const f32x2 t01 = s01 * w.lo + viv * k2.lo, t23 = s23 * w.hi + viv * k2.hi;
                if (mode == SC_DUAL) {
                    const f32x2 tq = p01 * kk.lo + p23 * kk.hi;
                    float pq = tq.x + tq.y;
                    const f32x2 u01 = p01 * w.lo, u23 = p23 * w.hi;
                    pq = row16_sum(pq);
                    const f32x2 sap = {-pq, -pq};
                    p01 = sap * bb.lo + u01; p23 = sap * bb.hi + u23;
                }
                pp = row16_sum(pp);
                const f32x2 sav = {-pp, -pp};
                s01 = sav * bb.lo + t01; s23 = sav * bb.hi + t23;
                if (mode == SC_FULL) {
                    const f32x2 uq = s01 * r.lo + s23 * r.hi;
                    float q = uq.x + uq.y;
                    q = dpp_add<0xB1>(q); q = dpp_add<0x4E>(q);
                    qdst[tt * qstep] = q;
                }
                kk = kk1; w = w1; bb = bb1; k2 = k21; r = r1; vi = vi1;
                kk1 = nkk; w1 = nw; bb1 = nbb; k21 = nk2; r1 = nr; vi1 = nvi;
            }
        }
        __syncthreads();
        if (mode == SC_FULL) {
            const int tt = tid >> 3, r2 = (tid & 7) * 2; const int m = b * SEQ + t0 + tt;
            const float4 qa = *(const float4*)(sQ + (tt * 16 + r2) * 4), qb = *(const float4*)(sQ + (tt * 16 + r2 + 1) * 4);
            *(unsigned*)(OA + (size_t)m * D + 512 + hd * 64 + rg * 16 + r2) = pk2((qa.x + qa.y) + (qa.z + qa.w), (qb.x + qb.y) + (qb.z + qb.w));
        }
    }
    const f32x4 fin = {s01.x, s01.y, s23.x, s23.y};
    if (mode == SC_FULL) {
        if (chunk == 0) *(f32x4*)(SEND0 + (size_t)seq * 4096 + row * 64 + c4) = fin;
        if (chunk == NCH - 1) *(f32x4*)(p.out + O_SP + ((size_t)((jl * 2 + b) * 8 + hd) * 64 + row) * 64 + c4) = fin;
    } else {
        *(f32x4*)(LOC + ((size_t)seq * (NCH - 2) + (chunk - 1)) * 4096 + row * 64 + c4) = fin;
        const f32x4 pf = {p01.x, p01.y, p23.x, p23.y};
        *(f32x4*)(PM + ((size_t)seq * (NCH - 2) + (chunk - 1)) * 4096 + row * 64 + c4) = pf;
    }
    __syncthreads();
}

__device__ __forceinline__ void attn_prompt_item(const P& p, const Ctx& cx, int jl, int item, char* lds) {
    const bf16_t* Z = cx.Z; bf16_t* OA = cx.OA;
    const int kvh = item & 1, qb = (item >> 1) & 63, b = item >> 7;
    const int tid = TIDX, lane = tid & 63, wave = tid >> 6, lr = lane & 31, h = lane >> 5;
    constexpr int KROW = 144, VROW = 528;
    char* sK = lds; char* sVt = lds + 256 * KROW;
#pragma unroll 2
    for (int q = 0; q < 8; ++q) {
        const int ch = tid + 256 * q, key = ch >> 3, c8 = ch & 7; const int tk = (qb - 1) * 128 + key;
        uint4 kv = make_uint4(0, 0, 0, 0), vv = kv;
        if (tk >= 0) { const bf16_t* zr = Z + (size_t)(b * SEQ + tk) * EP; kv = *(const uint4*)(zr + 512 + kvh * 64 + c8 * 8); vv = *(const uint4*)(zr + 640 + kvh * 64 + c8 * 8); }
        *(uint4*)(sK + key * KROW + c8 * 16) = kv;
        const unsigned vw[4] = {vv.x, vv.y, vv.z, vv.w};
#pragma unroll
        for (int e = 0; e < 8; ++e) *(bf16_t*)(sVt + (c8 * 8 + e) * VROW + key * 2) = (bf16_t)((e & 1) ? (vw[e >> 1] >> 16) : (vw[e >> 1] & 0xffff));
    }
    __syncthreads();
    const int qs = wave;
    const int qrow = b * SEQ + qb * 128 + qs * 32 + lr;
    const int qloc = qs * 32 + lr;
#pragma unroll 1
    for (int g = 0; g < 4; ++g) {
        const int qh = kvh * 4 + g;
        bf16x8 qf[4];
#pragma unroll
        for (int s = 0; s < 4; ++s) qf[s] = *(const bf16x8*)(Z + (size_t)qrow * EP + qh * 64 + s * 16 + h * 8);
        f32x16 sc[5];
#pragma unroll
        for (int u = 0; u < 5; ++u) {
#pragma unroll
            for (int e = 0; e < 16; ++e) sc[u][e] = 0.f;
#pragma unroll
            for (int s = 0; s < 4; ++s) {
                const bf16x8 kf = *(const bf16x8*)(sK + ((qs + u) * 32 + lr) * KROW + s * 32 + h * 16);
                sc[u] = __builtin_amdgcn_mfma_f32_32x32x16_bf16(kf, qf[s], sc[u], 0, 0, 0);
            }
            __builtin_amdgcn_sched_barrier(0);
        }
        const float sink = p.in[I_SINK][jl * 8 + qh];
        float mx = -3e38f;
#pragma unroll
        for (int u = 0; u < 5; ++u)
#pragma unroll
            for (int e = 0; e < 16; ++e) {
                const int kj = (qs + u) * 32 + (e & 3) + 8 * (e >> 2) + 4 * h;
                const int diff = 128 + qloc - kj;
                const bool vis = diff >= 0 && diff <= 128 && (qb > 0 || kj >= 128);
                const float sv = vis ? sc[u][e] * 0.125f : -1e30f;
                sc[u][e] = sv; mx = fmaxf(mx, sv);
            }
        mx = fmaxf(mx, __shfl_xor(mx, 32)); mx = fmaxf(mx, sink);
        float sum = 0.f;
#pragma unroll
        for (int u = 0; u < 5; ++u)
#pragma unroll
            for (int e = 0; e < 16; ++e) { const float pe = __expf(sc[u][e] - mx); sc[u][e] = pe; sum += pe; }
        sum += __shfl_xor(sum, 32);
        const float rden = 1.f / (sum + __expf(sink - mx));
        f32x16 oacc[2];
#pragma unroll
        for (int d2 = 0; d2 < 2; ++d2)
#pragma unroll
            for (int e = 0; e < 16; ++e) oacc[d2][e] = 0.f;
#pragma unroll
        for (int u = 0; u < 5; ++u)
#pragma unroll
            for (int s2 = 0; s2 < 2; ++s2) {
                union { bf16x8 v; unsigned w[4]; } pf;
#pragma unroll
                for (int e2 = 0; e2 < 4; ++e2) pf.w[e2] = pk2(sc[u][8 * s2 + 2 * e2] * rden, sc[u][8 * s2 + 2 * e2 + 1] * rden);
                const int kbase = (qs + u) * 32 + 16 * s2 + 4 * h;
#pragma unroll
                for (int d2 = 0; d2 < 2; ++d2) {
                    union { bf16x8 v; uint2 w[2]; } vf;
                    const char* vp = sVt + (d2 * 32 + lr) * VROW + kbase * 2;
                    vf.w[0] = *(const uint2*)vp; vf.w[1] = *(const uint2*)(vp + 16);
                    oacc[d2] = __builtin_amdgcn_mfma_f32_32x32x16_bf16(vf.v, pf.v, oacc[d2], 0, 0, 0);
                }
                __builtin_amdgcn_sched_barrier(0);
            }
#pragma unroll
        for (int d2 = 0; d2 < 2; ++d2)
#pragma unroll
            for (int g2 = 0; g2 < 4; ++g2) {
                uint2 o; o.x = pk2(oacc[d2][4 * g2], oacc[d2][4 * g2 + 1]); o.y = pk2(oacc[d2][4 * g2 + 2], oacc[d2][4 * g2 + 3]);
                *(uint2*)(OA + (size_t)qrow * D + qh * 64 + d2 * 32 + 8 * g2 + 4 * h) = o;
            }
    }
    __syncthreads();
}

__device__ __forceinline__ void attn_sample_item(const P& p, const Ctx& cx, int jl, int item, char* lds) {
    const bf16_t* Z = cx.Z; bf16_t* OA = cx.OA;
    const int kvh = item & 1, bs = item >> 1, m = MP + bs;
    const int tid = TIDX, lane = tid & 63, wave = tid >> 6, qh = kvh * 4 + wave;
    float* sq = (float*)lds + wave * 64; float* sp = (float*)lds + 256 + wave * 132;
    sq[lane] = bf2f(Z[(size_t)m * EP + qh * 64 + lane]);
    __syncthreads();
    const float* kc = p.in[I_CK] + ((size_t)(jl * 128 + bs) * 128) * 128 + kvh * 64;
    const float* vc = p.in[I_CV] + ((size_t)(jl * 128 + bs) * 128) * 128 + kvh * 64;
    float sc0 = 0.f, sc1 = 0.f, sc2 = 0.f;
#pragma unroll 4
    for (int d = 0; d < 64; d += 4) {
        const float4 k0 = *(const float4*)(kc + (size_t)lane * 128 + d), k1 = *(const float4*)(kc + (size_t)(lane + 64) * 128 + d);
        const float4 q4 = *(const float4*)(sq + d);
        sc0 += k0.x * q4.x + k0.y * q4.y + k0.z * q4.z + k0.w * q4.w; sc1 += k1.x * q4.x + k1.y * q4.y + k1.z * q4.z + k1.w * q4.w;
    }
    sc2 = wave_sum(bf2f(Z[(size_t)m * EP + 512 + kvh * 64 + lane]) * sq[lane]);
    sc0 *= 0.125f; sc1 *= 0.125f; sc2 *= 0.125f;
    const float sink = p.in[I_SINK][jl * 8 + qh];
    float mx = wave_max(fmaxf(sc0, sc1)); mx = fmaxf(fmaxf(mx, sc2), sink);
    const float p0 = __expf(sc0 - mx), p1 = __expf(sc1 - mx), p2 = __expf(sc2 - mx);
    const float den = wave_sum(p0 + p1) + p2 + __expf(sink - mx), rd = 1.f / den;
    sp[lane] = p0 * rd; sp[lane + 64] = p1 * rd; if (lane == 0) sp[128] = p2 * rd;
    __syncthreads();
    float o = 0.f;
#pragma unroll 32
    for (int j = 0; j < 128; ++j) o += sp[j] * vc[(size_t)j * 128 + lane];
    o += sp[128] * bf2f(Z[(size_t)m * EP + 640 + kvh * 64 + lane]);
    OA[(size_t)m * D + qh * 64 + lane] = f2bf(o);
    __syncthreads();
}

__device__ __forceinline__ void rwkv_sample_item(const P& p, const Ctx& cx, int jl, int item, char* lds) {
    const bf16_t* Z = cx.Z; const bf16_t* WAG = cx.WAG; bf16_t* OA = cx.OA;
    const int hd = item & 7, bs = item >> 3, m = MP + bs;
    const int tid = TIDX;
    float* sW = (float*)lds; float* sKK = sW + 64; float* sBB = sKK + 64; float* sK2 = sBB + 64; float* sR = sK2 + 64; float* sV = sR + 64;
    if (tid < 64) {
        const int c = hd * 64 + tid;
        const float r = zs_val(p, Z, jl, m, c), k = zs_val(p, Z, jl, m, 512 + c), v = zs_val(p, Z, jl, m, 1024 + c);
        const float eps = bf2f(WAG[(size_t)m * 1536 + c]), a = bf2f(WAG[(size_t)m * 1536 + 512 + c]);
        const float kkr = k * p.in[I_KK][jl * 512 + c];
        const float ssq = wave_sum(kkr * kkr);
        const float kkn = kkr / fmaxf(sqrtf(ssq), 1e-12f);
        sW[tid] = 1.f - eps; sKK[tid] = kkn; sBB[tid] = kkn * a; sK2[tid] = k * (1.f + (a - 1.f) * p.in[I_KA][jl * 512 + c]); sR[tid] = r; sV[tid] = v;
    }
    __syncthreads();
    const int i = tid >> 2, q = tid & 3;
    const float* sp = p.in[I_WKV] + ((size_t)((jl * 128 + bs) * 8 + hd) * 64 + i) * 64 + q * 16;
    float s[16]; float pp = 0.f;
#pragma unroll
    for (int e4 = 0; e4 < 4; ++e4) { const float4 v = *(const float4*)(sp + 4 * e4); s[4 * e4] = v.x; s[4 * e4 + 1] = v.y; s[4 * e4 + 2] = v.z; s[4 * e4 + 3] = v.w; }
#pragma unroll
    for (int e = 0; e < 16; ++e) pp += s[e] * sKK[q * 16 + e];
    pp += __shfl_xor(pp, 1); pp += __shfl_xor(pp, 2);
    const float sa = -pp, vi = sV[i];
    float qq = 0.f;
#pragma unroll
    for (int e = 0; e < 16; ++e) { const int j = q * 16 + e; s[e] = s[e] * sW[j] + sa * sBB[j] + vi * sK2[j]; qq += s[e] * sR[j]; }
    qq += __shfl_xor(qq, 1); qq += __shfl_xor(qq, 2);
    float* so = p.out + O_SS + ((size_t)((jl * 128 + bs) * 8 + hd) * 64 + i) * 64 + q * 16;
#pragma unroll
    for (int e4 = 0; e4 < 4; ++e4) *(float4*)(so + 4 * e4) = make_float4(s[4 * e4], s[4 * e4 + 1], s[4 * e4 + 2], s[4 * e4 + 3]);
    if (q == 0) OA[(size_t)m * D + 512 + hd * 64 + i] = f2bf(qq);
    __syncthreads();
}

__device__ __forceinline__ void mix_sample(const P& p, const Ctx& cx, int jl, char* lds) {
    for (int it = cx.bid; it < 256 + 1024; it += cx.nb) {
        if (it < 256) attn_sample_item(p, cx, jl, it, lds);
        else rwkv_sample_item(p, cx, jl, it - 256, lds);
    }
}

__device__ __forceinline__ void unpack8(const uint4& u, float (&o)[8]) { o[0] = lo16(u.x); o[1] = hi16(u.x); o[2] = lo16(u.y); o[3] = hi16(u.y); o[4] = lo16(u.z); o[5] = hi16(u.z); o[6] = lo16(u.w); o[7] = hi16(u.w); }
__device__ __forceinline__ void load8f(const float* p_, float (&o)[8]) { const float4 a = *(const float4*)p_, b = *(const float4*)(p_ + 4); o[0] = a.x; o[1] = a.y; o[2] = a.z; o[3] = a.w; o[4] = b.x; o[5] = b.y; o[6] = b.z; o[7] = b.w; }
__device__ __forceinline__ float group8_sum(float x) { x = dpp_add<0xB1>(x); x = dpp_add<0x4E>(x); x = dpp_add<0x141>(x); return x; }
__device__ __forceinline__ void post_phase(const P& p, const Ctx& cx, int jl) {
    if (cx.r0 == MP) { float* mo = cx.MOE + (size_t)MP * D; for (int i = cx.bid * NT + TIDX; i < MS * D / 4; i += cx.nb * NT) *(float4*)(mo + 4 * i) = make_float4(0.f, 0.f, 0.f, 0.f); }
    const bf16_t* Z = cx.Z; const bf16_t* WAG = cx.WAG; bf16_t* OA = cx.OA;
    const int tid = TIDX, lane = tid & 63, wave = tid >> 6, c = lane * 8;
    float mur[8], muk[8], muv[8], ka[8], rkw[8], gg[8], gb[8];
    load8f(p.in[I_MU] + jl * ZBW + c, mur); load8f(p.in[I_MU] + jl * ZBW + 512 + c, muk); load8f(p.in[I_MU] + jl * ZBW + 1024 + c, muv);
    load8f(p.in[I_KA] + jl * 512 + c, ka); load8f(p.in[I_RK] + jl * 512 + c, rkw); load8f(p.in[I_GNG] + jl * 512 + c, gg); load8f(p.in[I_GNB] + jl * 512 + c, gb);
    for (int m = cx.r0 + cx.bid * 4 + wave; m < cx.r1; m += cx.nb * 4) {
        const bf16_t* zr = Z + (size_t)m * EP + 768 + c;
        float r[8], k[8], v[8], pr[8], pk[8], pv[8], a[8], g[8], o[8];
        unpack8(*(const uint4*)zr, r); unpack8(*(const uint4*)(zr + 512), k); unpack8(*(const uint4*)(zr + 1024), v);
        unpack8(*(const uint4*)(WAG + (size_t)m * 1536 + 512 + c), a); unpack8(*(const uint4*)(WAG + (size_t)m * 1536 + 1024 + c), g);
        unpack8(*(const uint4*)(OA + (size_t)m * D + 512 + c), o);
        if (m < MP) {
            if ((m & (SEQ - 1)) == 0) {
#pragma unroll
                for (int e = 0; e < 8; ++e) { pr[e] = 0.f; pk[e] = 0.f; pv[e] = 0.f; }
            } else { unpack8(*(const uint4*)(zr - EP), pr); unpack8(*(const uint4*)(zr - EP + 512), pk); unpack8(*(const uint4*)(zr - EP + 1024), pv); }
        } else { const float* st = p.in[I_SHIFT] + (size_t)(jl * 128 + (m - MP)) * ZBW + c; load8f(st, pr); load8f(st + 512, pk); load8f(st + 1024, pv); }
        float rk = 0.f, so = 0.f;
#pragma unroll
        for (int e = 0; e < 8; ++e) {
            r[e] += (pr[e] - r[e]) * mur[e]; k[e] += (pk[e] - k[e]) * muk[e]; v[e] += (pv[e] - v[e]) * muv[e];
            const float k2 = k[e] * (1.f + (a[e] - 1.f) * ka[e]);
            rk += r[e] * k2 * rkw[e]; so += o[e];
        }
        rk = group8_sum(rk);
        const float mean = group8_sum(so) * (1.f / 64);
        float sv = 0.f;
#pragma unroll
        for (int e = 0; e < 8; ++e) { o[e] -= mean; sv += o[e] * o[e]; }
        const float rstd = rsqrtf(group8_sum(sv) * (1.f / 64) + 64e-5f);
        float res[8];
#pragma unroll
        for (int e = 0; e < 8; ++e) res[e] = (o[e] * rstd * gg[e] + gb[e] + rk * v[e]) * g[e];
        uint4 ov; ov.x = pk2(res[0], res[1]); ov.y = pk2(res[2], res[3]); ov.z = pk2(res[4], res[5]); ov.w = pk2(res[6], res[7]);
        *(uint4*)(OA + (size_t)m * D + 512 + c) = ov;
    }
}

__device__ __forceinline__ void sgu_ln_phase(const P& p, const Ctx& cx, int jo) {
    bf16_t* ZU = cx.ZU;
    const int lane = TIDX & 63, wave = TIDX >> 6;
    for (int m = cx.r0 + cx.bid * 4 + wave; m < cx.r1; m += cx.nb * 4) {
        bf16_t* vr = ZU + (size_t)m * 2048 + 1024;
        float x[16]; float s = 0.f;
#pragma unroll
        for (int q = 0; q < 2; ++q) { const uint4 u = *(const uint4*)(vr + lane * 8 + 512 * q);
            x[8 * q] = lo16(u.x); x[8 * q + 1] = hi16(u.x); x[8 * q + 2] = lo16(u.y); x[8 * q + 3] = hi16(u.y); x[8 * q + 4] = lo16(u.z); x[8 * q + 5] = hi16(u.z); x[8 * q + 6] = lo16(u.w); x[8 * q + 7] = hi16(u.w); }
#pragma unroll
        for (int e = 0; e < 16; ++e) s += x[e];
        const float mean = wave_sum(s) * (1.f / 1024);
        float s2 = 0.f;
#pragma unroll
        for (int e = 0; e < 16; ++e) { x[e] -= mean; s2 += x[e] * x[e]; }
        const float rstd = rsqrtf(wave_sum(s2) * (1.f / 1024) + 1e-5f);
#pragma unroll
        for (int q = 0; q < 2; ++q) {
            const int c = lane * 8 + 512 * q; float o[8];
#pragma unroll
            for (int e = 0; e < 8; ++e) o[e] = x[8 * q + e] * rstd * p.in[I_LNG][jo * 1024 + c + e] + p.in[I_LNB][jo * 1024 + c + e];
            uint4 ov; ov.x = pk2(o[0], o[1]); ov.y = pk2(o[2], o[3]); ov.z = pk2(o[4], o[5]); ov.w = pk2(o[6], o[7]);
            *(uint4*)(vr + c) = ov;
            if (m >= MP) { float* so = p.out + O_SGV + (size_t)(jo * 128 + (m - MP)) * 1024 + c; *(float4*)so = make_float4(o[0], o[1], o[2], o[3]); *(float4*)(so + 4) = make_float4(o[4], o[5], o[6], o[7]); }
        }
    }
}

template <bool SAMPLE>
__device__ __forceinline__ void sgu_phase(const P& p, const Ctx& cx, int jo, char* lds) {
    const bf16_t* ZU = cx.ZU; bf16_t* Y = cx.Y;
    const bf16_t* TR = (const bf16_t*)(p.ws + W_TRIL) + (size_t)jo * 8 * 128 * 128;
    const int tid = TIDX, lane = tid & 63, wave = tid >> 6, wm = wave >> 1, wn = wave & 1, lr = lane & 31, h = lane >> 5;
    constexpr int SROW = 272;
    char* sA = lds; char* sB = lds + 128 * SROW;
    if (!SAMPLE) for (int item = cx.bid; item < 1024; item += cx.nb) {
        const int hh = item & 7, n = (item >> 3) & 63, b = item >> 9;
        const int mbase = b * SEQ + n * 128;
#pragma unroll
        for (int q = 0; q < 8; ++q) {
            const int ch = tid + 256 * q, r = ch >> 4, c8 = ch & 15;
            *(uint4*)(sA + r * SROW + c8 * 16) = *(const uint4*)(TR + (size_t)hh * 16384 + r * 128 + c8 * 8);
            const uint4 vv = *(const uint4*)(ZU + (size_t)(mbase + r) * 2048 + 1024 + hh * 128 + c8 * 8);
            const unsigned vw[4] = {vv.x, vv.y, vv.z, vv.w};
#pragma unroll
            for (int e = 0; e < 8; ++e) *(bf16_t*)(sB + (c8 * 8 + e) * SROW + r * 2) = (bf16_t)((e & 1) ? (vw[e >> 1] >> 16) : (vw[e >> 1] & 0xffff));
        }
        __syncthreads();
        f32x16 acc[2][2];
#pragma unroll
        for (int i = 0; i < 2; ++i)
#pragma unroll
            for (int j = 0; j < 2; ++j)
#pragma unroll
                for (int e = 0; e < 16; ++e) acc[i][j][e] = 0.f;
#pragma unroll
        for (int ks = 0; ks < 8; ++ks) {
            bf16x8 xa[2], wb[2];
#pragma unroll
            for (int i = 0; i < 2; ++i) xa[i] = *(const bf16x8*)(sA + (wm * 64 + i * 32 + lr) * SROW + ks * 32 + h * 16);
#pragma unroll
            for (int j = 0; j < 2; ++j) wb[j] = *(const bf16x8*)(sB + (wn * 64 + j * 32 + lr) * SROW + ks * 32 + h * 16);
#pragma unroll
            for (int i = 0; i < 2; ++i)
#pragma unroll
                for (int j = 0; j < 2; ++j) acc[i][j] = __builtin_amdgcn_mfma_f32_32x32x16_bf16(wb[j], xa[i], acc[i][j], 0, 0, 0);
        }
#pragma unroll
        for (int i = 0; i < 2; ++i) {
            const int t = wm * 64 + i * 32 + lr; const float bias = p.in[I_SGUB][(jo * 8 + hh) * 128 + t];
#pragma unroll
            for (int j = 0; j < 2; ++j)
#pragma unroll
                for (int g = 0; g < 4; ++g) {
                    const int c = hh * 128 + wn * 64 + j * 32 + 8 * g + 4 * h;
                    const uint2 uu = *(const uint2*)(ZU + (size_t)(mbase + t) * 2048 + c);
                    uint2 o; o.x = pk2(lo16(uu.x) * (acc[i][j][4 * g] + bias), hi16(uu.x) * (acc[i][j][4 * g + 1] + bias));
                    o.y = pk2(lo16(uu.y) * (acc[i][j][4 * g + 2] + bias), hi16(uu.y) * (acc[i][j][4 * g + 3] + bias));
                    *(uint2*)(Y + (size_t)(mbase + t) * D + c) = o;
                }
        }
        __syncthreads();
    }
    const int gt = cx.bid * NT + tid, gs = cx.nb * NT;
    if (cx.r0 == MP) { float* mo = cx.MOE + (size_t)MP * D; for (int i = cx.bid * NT + tid; i < MS * D / 4; i += cx.nb * NT) *(float4*)(mo + 4 * i) = make_float4(0.f, 0.f, 0.f, 0.f); }
    if (SAMPLE) for (int it = gt; it < MS * 1024; it += gs) {
        const int m = MP + (it >> 10), c = it & 1023, hh = c >> 7;
        const float u = bf2f(ZU[(size_t)m * 2048 + c]), vn = bf2f(ZU[(size_t)m * 2048 + 1024 + c]);
        Y[(size_t)m * D + c] = f2bf(u * (p.in[I_SGUW][(size_t)(jo * 8 + hh) * 16384] * vn + p.in[I_SGUB][(jo * 8 + hh) * 128]));
    }
}

__device__ __forceinline__ void unpack8v(const u32x4& u, float (&o)[8]) { o[0] = lo16(u.x); o[1] = hi16(u.x); o[2] = lo16(u.y); o[3] = hi16(u.y); o[4] = lo16(u.z); o[5] = hi16(u.z); o[6] = lo16(u.w); o[7] = hi16(u.w); }
template <bool SAMPLE>
__device__ __forceinline__ void act_phase(const P& p, const Ctx& cx, int L) {
    const bf16_t* G = cx.G; bf16_t* U = cx.U;
    const int gt = cx.bid * NT + TIDX, gs = cx.nb * NT;
    const float* cw = p.in[I_CW] + (size_t)L * 3 * DFF; const float* cb = p.in[I_CB] + (size_t)L * DFF;
    constexpr int CG = DFF / 8, RC = 16;
    if (!SAMPLE) for (int it = gt; it < (MP / RC) * CG; it += gs) {
        const int m0 = (it / CG) * RC, c = (it % CG) * 8;
        float w0[8], w1[8], w2[8], bb[8], g1[8], g2[8];
        load8f(cw + c, w0); load8f(cw + DFF + c, w1); load8f(cw + 2 * DFF + c, w2); load8f(cb + c, bb);
        if ((m0 & (SEQ - 1)) == 0) {
#pragma unroll
            for (int e = 0; e < 8; ++e) { g1[e] = 0.f; g2[e] = 0.f; }
        } else { unpack8v(*(const u32x4*)(G + (size_t)(m0 - 1) * DFF + c), g1); unpack8v(*(const u32x4*)(G + (size_t)(m0 - 2) * DFF + c), g2); }
#pragma unroll
        for (int hf = 0; hf < RC / 8; ++hf) {
            u32x4 gq[8], uq[8];
#pragma unroll
            for (int r = 0; r < 8; ++r) { gq[r] = *(const u32x4*)(G + (size_t)(m0 + hf * 8 + r) * DFF + c); uq[r] = *(const u32x4*)(U + (size_t)(m0 + hf * 8 + r) * DFF + c); }
#pragma unroll
            for (int r = 0; r < 8; ++r) {
                float gc[8], uv[8], o[8];
                unpack8v(gq[r], gc); unpack8v(uq[r], uv);
#pragma unroll
                for (int e = 0; e < 8; ++e) { const float cv = bb[e] + w2[e] * gc[e] + w1[e] * g1[e] + w0[e] * g2[e]; o[e] = gelu_tanh(cv) * uv[e]; g2[e] = g1[e]; g1[e] = gc[e]; }
                u32x4 ov; ov.x = pk2(o[0], o[1]); ov.y = pk2(o[2], o[3]); ov.z = pk2(o[4], o[5]); ov.w = pk2(o[6], o[7]);
                *(u32x4*)(U + (size_t)(m0 + hf * 8 + r) * DFF + c) = ov;
            }
        }
    }
    if (cx.r0 == MP) { float* mo = cx.MOE + (size_t)MP * D; for (int i = cx.bid * NT + TIDX; i < MS * D / 4; i += cx.nb * NT) *(float4*)(mo + 4 * i) = make_float4(0.f, 0.f, 0.f, 0.f); }
    if (SAMPLE) for (int it = gt; it < MS * CG; it += gs) {
        const int m = MP + it / CG, c = (it % CG) * 8;
        float w0[8], w1[8], w2[8], bb[8], g1[8], g2[8], gc[8], uv[8], o[8];
        load8f(cw + c, w0); load8f(cw + DFF + c, w1); load8f(cw + 2 * DFF + c, w2); load8f(cb + c, bb);
        const float* st = p.in[I_CONV] + ((size_t)(L * 128 + (m - MP)) * 2) * DFF + c;
        load8f(st, g2); load8f(st + DFF, g1);
        unpack8v(*(const u32x4*)(G + (size_t)m * DFF + c), gc); unpack8v(*(const u32x4*)(U + (size_t)m * DFF + c), uv);
#pragma unroll
        for (int e = 0; e < 8; ++e) { const float cv = bb[e] + w2[e] * gc[e] + w1[e] * g1[e] + w0[e] * g2[e]; o[e] = gelu_tanh(cv) * uv[e]; }
        u32x4 ov; ov.x = pk2(o[0], o[1]); ov.y = pk2(o[2], o[3]); ov.z = pk2(o[4], o[5]); ov.w = pk2(o[6], o[7]);
        *(u32x4*)(U + (size_t)m * DFF + c) = ov;
    }
}

struct Chains { Ctx main, samp; XcdBarrier sb; };

template <bool SAMPLE>
__device__ __forceinline__ void run_op(const P& p, Chains& ch, int L, int op, char* lds, int pass = 1) {
    const Ctx& cx = SAMPLE ? ch.samp : ch.main;
    const int j = L >> 1; const bool even = (L & 1) == 0;
    bf16_t* XN = (bf16_t*)(p.ws + W_XN);
    EA ea; ea.c32 = nullptr; ea.o16 = nullptr; ea.o16b = nullptr; ea.layer = L; ea.ksplit = 1;
    if (even) {
        switch (op) {
        case 0: ea.o16 = cx.Z; ea.o16b = cx.LR; gemm_phase<EPI_EVENIN>(p, XN, D, (const bf16_t*)(p.ws + W_WINE) + (size_t)j * EP * D, EP, D, lds, ea, cx); return;
        case 1: lr_phase(p, cx, j); return;
        case 2: ea.o16 = cx.WAG; gemm_phase<EPI_LR>(p, cx.LR, 256, (const bf16_t*)(p.ws + W_WLR) + (size_t)j * 1536 * 256, 1536, 256, lds, ea, cx); return;
        case 3:
            if constexpr (SAMPLE) mix_sample(p, cx, j, lds);
            else {
                const int bidx = BIDX;
                if (pass == 1) {
                    if (bidx < SCAN_P1) {
                        if (bidx < 64) scan_task<SC_FULL>(p, cx, j, lds, bidx >> 2, bidx & 3, 0);
                        else { const int r = bidx - 64, r2 = r & 63; scan_task<SC_DUAL>(p, cx, j, lds, r2 >> 2, r2 & 3, 1 + (r >> 6)); }
                        return;
                    }
                } else {
                    if (bidx < SCAN_P2) { const int r2 = bidx & 63; scan_task<SC_FULL>(p, cx, j, lds, r2 >> 2, r2 & 3, 1 + (bidx >> 6)); return; }
                    for (int it = ch.samp.bid; it < 256; it += ch.samp.nb) attn_prompt_item(p, cx, j, it, lds);
                }
                if (pass == 1) {
#pragma unroll 1
                    for (int o2 = 0; o2 < 10; ++o2) { if (o2 == 1) continue;
                        run_op<true>(p, ch, L, o2, lds); if (o2 != 9) xcd_barrier(ch.sb); }
                } else {
                    run_op<true>(p, ch, L, 10, lds); xcd_barrier(ch.sb);
#pragma unroll 1
                    for (int o2 = 0; o2 < 9; ++o2) { run_op<true>(p, ch, L + 1, o2, lds); if (o2 != 8) xcd_barrier(ch.sb); }
                }
            }
            return;
        case 4: post_phase(p, cx, j); return;
        case 5: ea.c32 = cx.MOE; if (SAMPLE) ea.ksplit = 4; gemm_phase<EPI_F32>(p, cx.OA, D, (const bf16_t*)(p.ws + W_WOUTE) + (size_t)j * D * D, D, D, lds, ea, cx); return;
        case 6: rownorm_phase(p, cx, cx.MOE, p.in[I_NMPOST] + L * D, p.in[I_NFPRE] + L * D, L == 0); return;
        default: break;
        }
        op -= 7;
    } else {
        switch (op) {
        case 0: ea.o16 = cx.ZU; gemm_phase<EPI_ODDIN>(p, XN, D, (const bf16_t*)(p.ws + W_WINO) + (size_t)j * 2048 * D, 2048, D, lds, ea, cx); return;
        case 1: sgu_ln_phase(p, cx, j); return;
        case 2: sgu_phase<SAMPLE>(p, cx, j, lds); return;
        case 3: ea.c32 = cx.MOO; if (SAMPLE) ea.ksplit = 4; gemm_phase<EPI_F32>(p, cx.Y, D, (const bf16_t*)(p.ws + W_WOUTO) + (size_t)j * D * D, D, D, lds, ea, cx); return;
        case 4: rownorm_phase(p, cx, cx.MOO, p.in[I_NMPOST] + L * D, p.in[I_NFPRE] + L * D); return;
        default: break;
        }
        op -= 5;
    }
    switch (op) {
    case 0: ea.o16 = cx.G; ea.o16b = cx.U; gemm_phase<EPI_GU>(p, XN, D, (const bf16_t*)(p.ws + W_WGU) + (size_t)L * 2 * DFF * D, 2 * DFF, D, lds, ea, cx); return;
    case 1: act_phase<SAMPLE>(p, cx, L); return;
    case 2: ea.c32 = cx.FO; if (SAMPLE) ea.ksplit = 11; gemm_phase<EPI_F32>(p, cx.U, DFF, (const bf16_t*)(p.ws + W_WDN) + (size_t)L * D * DFF, D, DFF, lds, ea, cx); return;
    case 3: rownorm_phase(p, cx, cx.FO, p.in[I_NFPOST] + L * D, L < 3 ? p.in[I_NMPRE] + (L + 1) * D : nullptr); return;
    default: return;
    }
}

__global__ void __launch_bounds__(NT, 2) mega(P p_arg) {
    __shared__ __attribute__((aligned(16))) char lds[LDS_BYTES];
    cg::grid_group grid = cg::this_grid();
    const P& p = *(const P*)__builtin_amdgcn_kernarg_segment_ptr();
    __shared__ uint4 xb_words, xb_words2;
    unsigned* bar = (unsigned*)(p.ws + W_BAR);
    if (threadIdx.x == 0) { xb_words = make_uint4(0u, 0u, 0u, 0u); xb_words2 = make_uint4(0u, 0u, 0u, 0u); }
    __syncthreads();
    XcdBarrier xb = xcd_barrier_post(bar, (volatile LAS unsigned*)&xb_words, gridDim.x);
    p0_phase(p, lds);
    if (p.ws == nullptr) grid.sync();
    xcd_barrier(xb);
    Chains ch;
    {
        char* AR = p.ws + W_AR; char* SA = p.ws + W_SAMP;
        Ctx& m = ch.main;
        m.Z = (bf16_t*)(AR + A_Z); m.LR = (bf16_t*)(AR + A_LR); m.WAG = (bf16_t*)(AR + A_WAG); m.OA = (bf16_t*)(AR + A_OA); m.ZU = (bf16_t*)(AR + A_ZU); m.Y = (bf16_t*)(AR + A_Y);
        m.G = (bf16_t*)(AR + A_G); m.U = (bf16_t*)(AR + A_U); m.MOE = (float*)(AR + A_Z); m.MOO = (float*)(AR + A_MO_ODD); m.FO = (float*)(AR + A_G);
        m.r0 = 0; m.r1 = MP; m.bid = blockIdx.x; m.nb = gridDim.x;
        Ctx& q = ch.samp;
        q.Z = (bf16_t*)(SA + S_Z) - (size_t)MP * EP; q.LR = (bf16_t*)(SA + S_LR) - (size_t)MP * 256; q.WAG = (bf16_t*)(SA + S_WAG) - (size_t)MP * 1536; q.OA = (bf16_t*)(SA + S_OA) - (size_t)MP * D;
        q.ZU = (bf16_t*)(SA + S_ZU) - (size_t)MP * 2048; q.Y = (bf16_t*)(SA + S_Y) - (size_t)MP * D; q.G = (bf16_t*)(SA + S_G) - (size_t)MP * DFF; q.U = (bf16_t*)(SA + S_U) - (size_t)MP * DFF;
        q.MOE = (float*)(SA + S_MO) - (size_t)MP * D; q.MOO = q.MOE; q.FO = q.MOE;
        q.r0 = MP; q.r1 = M; q.bid = (int)blockIdx.x - SCAN_BLOCKS; q.nb = (int)gridDim.x - SCAN_BLOCKS;
        if ((int)blockIdx.x >= SCAN_BLOCKS) ch.sb = xcd_barrier_post(bar + 4096, (volatile LAS unsigned*)&xb_words2, gridDim.x - SCAN_BLOCKS);
        else { ch.sb.bar = bar + 4096; ch.sb.x = 0; ch.sb.st = (volatile LAS unsigned*)&xb_words2; ch.sb.G = 1; }
    }
#pragma unroll 1
    for (int L = 0; L < 4; ++L) {
        const int nops = (L & 1) ? 9 : 12;
#pragma unroll 1
        for (int op = 0; op < nops; ++op) {
            const bool ev = !(L & 1);
            run_op<false>(p, ch, L, (ev && op >= 4) ? op - 1 : op, lds, (ev && op == 4) ? 2 : 1);
            if (!(L == 3 && op == nops - 1)) xcd_barrier(xb);
        }
    }
}

extern "C" void kernel_launch(void* const* d_in, const int* in_sizes, int n_in, void* d_out, int out_size, void* d_ws, size_t ws_size, hipStream_t stream) {
    static int grid_blocks = 0;
    if (!grid_blocks) {
        if (n_in != N_IN || (size_t)out_size != O_END || ws_size < WS_NEED) {
            fprintf(stderr, "kernel_launch: unexpected shapes: n_in %d out %d (want %zu) ws %zu (need %zu)\n", n_in, out_size, (size_t)O_END, ws_size, (size_t)WS_NEED);
            if (ws_size < WS_NEED) return;
        }
        int dev = 0, cus = 0, per_cu = 0;
        hipGetDevice(&dev);
        hipDeviceGetAttribute(&cus, hipDeviceAttributeMultiprocessorCount, dev);
        hipOccupancyMaxActiveBlocksPerMultiprocessor(&per_cu, mega, NT, 0);
        if (per_cu > 2) per_cu = 2;
        if (per_cu < 1) per_cu = 1;
        grid_blocks = cus * per_cu;
        if (grid_blocks != 512) { fprintf(stderr, "kernel_launch: this kernel's phase program is laid out for 512 resident workgroups (256 CUs x 2); the device offers %d: nothing launched\n", grid_blocks); grid_blocks = -1; }
        fprintf(stderr, "kernel_launch: cus %d per_cu %d grid %d ws_need %zu ws %zu\n", cus, per_cu, grid_blocks, (size_t)WS_NEED, ws_size);
    }
    if (grid_blocks < 0) return;
    P p{};
    for (int i = 0; i < N_IN; ++i) p.in[i] = (const float*)d_in[i];
    p.out = (float*)d_out; p.ws = (char*)d_ws;
    void* args[] = {&p};
    if (hipMemsetAsync((char*)d_ws + W_BAR, 0, 32768, stream) != hipSuccess) fprintf(stderr, "kernel_launch: memset of the barrier words failed\n");
    hipError_t e = hipLaunchCooperativeKernel((void*)mega, dim3(grid_blocks), dim3(NT), args, 0, stream);
    if (e != hipSuccess) fprintf(stderr, "cooperative launch failed: %s (grid %d)\n", hipGetErrorString(e), grid_blocks);
}
```
